# Optimizing an MI355X kernel written in HIP

```python
import math
import jax, jax.numpy as jnp
from jax import lax
import numpy as np

D_MODEL = 2048
BATCH = 4
SEQ = 4096
DEPTH = 2

GRID_W = 64
CTX_LEN = 256
N_GROUPS = 4
D_GROUP = D_MODEL // N_GROUPS
D_IN = 13 * D_GROUP
N_MOD = 6
RMS_EPS = 1e-6

HY_ORDER = 2
HY_EMB = 33
HY_FFN = 64
HY_TARGET = 1e-2
HY_STRONG_DECAY_PCT = 0.3
HY_WEAK_DECAY_PCT = 1.5
HY_MIN_DECAY = math.log(HY_TARGET) / HY_WEAK_DECAY_PCT
HY_MAX_DECAY = math.log(HY_TARGET) / HY_STRONG_DECAY_PCT

RG_HEADS = 8
RG_CONV = 4
RG_C = 8.0

RW_HEAD = 64
RW_HEADS = D_GROUP // RW_HEAD
RW_DECAY_LORA = 64
RW_A_LORA = 64
RW_V_LORA = 32
RW_G_LORA = 128
RW_GN_EPS = 64e-5

RT_HEADS = 4
RT_DK = D_GROUP // RT_HEADS
RT_DV = D_GROUP // RT_HEADS
RT_CHUNK = 128
RT_GN_EPS = 1e-6
ROPE_BASE = 10000.0

N_EXPERTS = 32
TOP_K = 4
D_EXPERT = D_MODEL // 2
SWIGLU_LIMIT = 7.0
SWIGLU_ALPHA = 1.702

kernel_name = "hybrid_prefix_dit_trunk"


def rms_norm(x, w):
    xf = x.astype(jnp.float32)
    y = xf * lax.rsqrt(jnp.mean(xf * xf, axis=-1, keepdims=True) + RMS_EPS)
    return (y * w.astype(jnp.float32)).astype(x.dtype)


def modulate(x, w, shift, scale):
    return rms_norm(x, w) * (1 + scale) + shift


def shift_prev(x, n):
    if n == 0:
        return x
    return jnp.pad(x, ((0, 0), (n, 0), (0, 0)))[:, : x.shape[1]]


def shift_next(x, n):
    return jnp.pad(x, ((0, 0), (0, n), (0, 0)))[:, n:]


def linrec_combine(lhs, rhs):
    a1, b1 = lhs
    a2, b2 = rhs
    return a1 * a2, a2 * b1 + b2


def rope_2d(x, rows, cols):
    half = x.shape[-1] // 2
    quarter = half // 2
    inv = jnp.power(ROPE_BASE, -jnp.arange(quarter, dtype=jnp.float32) / quarter)

    def rot(xp, pos):
        ang = pos[:, None] * inv[None, :]
        cos = jnp.cos(ang)[None, :, None, :]
        sin = jnp.sin(ang)[None, :, None, :]
        x1, x2 = xp[..., :quarter], xp[..., quarter:]
        return jnp.concatenate([x1 * cos - x2 * sin, x1 * sin + x2 * cos], axis=-1)

    return jnp.concatenate([rot(x[..., :half], rows), rot(x[..., half:], cols)], axis=-1)


def bidirectional(fn, ctx_in, lat_in, state0, dir_params):
    out_c, out_l = 0.0, 0.0
    for d in range(2):
        p = tuple(a[d] for a in dir_params)
        flip = (lambda t: jnp.flip(t, axis=1)) if d == 1 else (lambda t: t)
        oc, s_ctx = fn(tuple(flip(t) for t in ctx_in), state0, p, d)
        ol, _ = fn(tuple(flip(t) for t in lat_in), s_ctx, p, d)
        out_c = out_c + flip(oc)
        out_l = out_l + flip(ol)
    return out_c, out_l


def hyena_filter_spectrum(L, w1, b1, w2, b2, w3, b3, w4, freq):
    f32 = jnp.float32
    t = jnp.linspace(0.0, 1.0, L, dtype=f32)[:, None]
    bands = (HY_EMB - 1) // 2
    fr = jnp.linspace(1e-4, bands - 1, bands, dtype=f32)
    ang = (2.0 * math.pi / L) * jnp.arange(L, dtype=f32)[:, None] * fr[None, :]
    z = jnp.concatenate([t, jnp.cos(ang), -jnp.sin(ang)], axis=-1)
    h = jnp.sin(freq * (z @ w1 + b1))
    h = jnp.sin(freq * (h @ w2 + b2))
    h = jnp.sin(freq * (h @ w3 + b3))
    h = (h @ w4).reshape(L, 2, HY_ORDER, D_GROUP)
    deltas = jnp.abs(jnp.linspace(HY_MIN_DECAY, HY_MAX_DECAY, D_GROUP, dtype=f32))
    h = h * jnp.exp(-t * deltas)[:, None, None, :]
    taps = jnp.concatenate(
        [h[:, 0], jnp.zeros((1, HY_ORDER, D_GROUP), f32), h[:0:-1, 1]], axis=0)
    taps = taps / jnp.sum(jnp.abs(taps), axis=0, keepdims=True)
    return jnp.fft.rfft(taps, axis=0)


def hyena_mixer(u, short_w, short_b, fw1, fb1, fw2, fb2, fw3, fb3, fw4, ffreq, bias):
    L = u.shape[1]
    u = short_w[0] * shift_prev(u, 1) + short_w[1] * u + short_w[2] * shift_next(u, 1) + short_b
    v, x1, x2 = jnp.split(u, 3, axis=-1)
    spec = hyena_filter_spectrum(L, fw1, fb1, fw2, fb2, fw3, fb3, fw4, ffreq)
    z = v
    for o, gate in enumerate((x1, x2)):
        zf = jnp.fft.rfft(z, n=2 * L, axis=1)
        z = jnp.fft.irfft(zf * spec[None, :, o], n=2 * L, axis=1)[:, :L] + bias[o] * z
        z = gate * z
    return z


def rglru_direction(inp, h0, p, d):
    (xb,) = inp
    conv_w, conv_b, wa, ba, wx, bx, lam = p
    xc = conv_b + sum(conv_w[j] * shift_prev(xb, RG_CONV - 1 - j) for j in range(RG_CONV))
    B_, L = xb.shape[0], xb.shape[1]
    xh = xc.reshape(B_, L, RG_HEADS, -1)
    r = jax.nn.sigmoid(jnp.einsum('blhi,hij->blhj', xh, wa).reshape(B_, L, -1) + ba)
    i = jax.nn.sigmoid(jnp.einsum('blhi,hij->blhj', xh, wx).reshape(B_, L, -1) + bx)
    log_a = -RG_C * r * jax.nn.softplus(-lam)
    a = jnp.exp(log_a)
    b = jnp.sqrt(-jnp.expm1(2.0 * log_a)) * (i * xc)
    a_cum, h = lax.associative_scan(linrec_combine, (a, b), axis=1)
    h = h + a_cum * h0[:, None, :]
    return h, h[:, -1]


def rglru_mixer(s_ctx, s_lat, conv_w, conv_b, wa, ba, wx, bx, lam):
    xc_, gc_ = jnp.split(s_ctx, 2, axis=-1)
    xl_, gl_ = jnp.split(s_lat, 2, axis=-1)
    h0 = jnp.zeros((s_ctx.shape[0], D_GROUP), jnp.float32)
    oc, ol = bidirectional(rglru_direction, (xc_,), (xl_,), h0,
                           (conv_w, conv_b, wa, ba, wx, bx, lam))
    return oc * jax.nn.gelu(gc_), ol * jax.nn.gelu(gl_)


def rwkv_mixer(s_ctx, s_lat, vf_ctx, vf_lat, vmix, mu, w0, w1, w2, a0, a1, a2,
               g1, g2, k_k, k_a, r_k, ln_w, ln_b):
    def prep(s, vfirst):
        r, k, v, z = jnp.split(s, 4, axis=-1)
        if vmix is None:
            vfirst = v
        else:
            v0, v1, v2 = vmix
            v = v + (vfirst - v) * jax.nn.sigmoid(v0 + (z @ v1) @ v2)
        g = jax.nn.sigmoid(z @ g1) @ g2
        return (r, k, v, z), g, vfirst

    in_c, g_c, vf_c = prep(s_ctx, vf_ctx)
    in_l, g_l, vf_l = prep(s_lat, vf_lat)

    def direction(inp, S0, p, d):
        mu_d, w0_d, w1_d, w2_d, a0_d, a1_d, a2_d = p
        r, k, v, z = [s + (shift_prev(s, 1) - s) * mu_d[j] for j, s in enumerate(inp)]
        w_log = -jax.nn.softplus(-(w0_d + jnp.tanh(z @ w1_d) @ w2_d)) - 0.5
        decay = jnp.exp(-jnp.exp(w_log))
        a = jax.nn.sigmoid(a0_d + (z @ a1_d) @ a2_d)
        B_, L = r.shape[0], r.shape[1]
        heads = lambda t: t.reshape(B_, L, RW_HEADS, RW_HEAD)
        kk = heads(k * k_k)
        kk = kk / jnp.maximum(jnp.sqrt(jnp.sum(kk * kk, axis=-1, keepdims=True)), 1e-12)
        k = k * (1 + (a - 1) * k_a)
        rh, wh, kh, vh, ah = (heads(t) for t in (r, decay, k, v, a))
        xs = tuple(jnp.moveaxis(t, 1, 0) for t in (rh, wh, kh, vh, kk, kk * ah))

        def step(S, xt):
            r_t, w_t, k_t, v_t, kk_t, kka_t = xt
            S = (S * w_t[..., None, :]
                 - jnp.einsum('bhij,bhj->bhi', S, kk_t)[..., None] * kka_t[..., None, :]
                 + v_t[..., None] * k_t[..., None, :])
            return S, jnp.einsum('bhij,bhj->bhi', S, r_t)

        S_fin, y = lax.scan(step, S0, xs)
        y = jnp.moveaxis(y, 0, 1)
        m = jnp.mean(y, axis=-1, keepdims=True)
        var = jnp.mean(jnp.square(y - m), axis=-1, keepdims=True)
        y = ((y - m) * lax.rsqrt(var + RW_GN_EPS)).reshape(B_, L, -1) * ln_w + ln_b
        bonus = (jnp.sum(rh * kh * r_k, axis=-1, keepdims=True) * vh).reshape(B_, L, -1)
        return y + bonus, S_fin

    S0 = jnp.zeros((s_ctx.shape[0], RW_HEADS, RW_HEAD, RW_HEAD), jnp.float32)
    oc, ol = bidirectional(direction, in_c, in_l, S0, (mu, w0, w1, w2, a0, a1, a2))
    return oc * g_c, ol * g_l, vf_c, vf_l


def retention_direction(inp, S0, p, d):
    q, k, v = inp
    (decay_raw,) = p
    B_, L, H, dk = q.shape
    dv = v.shape[-1]
    n = L // RT_CHUNK
    qc = q.reshape(B_, n, RT_CHUNK, H, dk)
    kc = k.reshape(B_, n, RT_CHUNK, H, dk)
    vc = v.reshape(B_, n, RT_CHUNK, H, dv)
    lg = -jax.nn.softplus(decay_raw.astype(jnp.float32))
    idx = jnp.arange(RT_CHUNK, dtype=jnp.float32)
    diff = idx[:, None] - idx[None, :]
    keep = diff > 0 if d == 1 else diff >= 0
    dmask = jnp.where(keep, jnp.exp(jnp.where(keep, diff, 0.0)[None] * lg[:, None, None]), 0.0)
    inner = jnp.einsum('bnihd,bnjhd->bnhij', qc, kc) * dmask[None, None]
    inner = jnp.einsum('bnhij,bnjhe->bnihe', inner, vc)
    k_dec = jnp.exp((RT_CHUNK - 1 - idx)[:, None] * lg[None, :])
    kv = jnp.einsum('bnjhd,bnjhe->nbhde', kc * k_dec[:, :, None], vc)
    chunk_dec = jnp.exp(RT_CHUNK * lg)[None, :, None, None]

    def step(S, kv_n):
        return chunk_dec * S + kv_n, S

    S_fin, S_prev = lax.scan(step, S0, kv)
    q_dec = jnp.exp((idx + 1.0)[:, None] * lg[None, :])
    cross = jnp.einsum('bnihd,nbhde->bnihe', qc * q_dec[:, :, None], S_prev)
    return (inner + cross).reshape(B_, L, H, dv), S_fin


def retention_mixer(s_ctx, s_lat, rows, cols, decay_raw, gn_w):
    def prep(s, rotate):
        q, k, v, g = jnp.split(s, 4, axis=-1)
        B_, L = s.shape[0], s.shape[1]
        q = q.reshape(B_, L, RT_HEADS, RT_DK)
        k = k.reshape(B_, L, RT_HEADS, RT_DK)
        v = v.reshape(B_, L, RT_HEADS, RT_DV)
        if rotate:
            q, k = rope_2d(q, rows, cols), rope_2d(k, rows, cols)
        return (q, k * RT_DK ** -0.5, v), g

    in_c, g_c = prep(s_ctx, False)
    in_l, g_l = prep(s_lat, True)
    S0 = jnp.zeros((s_ctx.shape[0], RT_HEADS, RT_DK, RT_DV), jnp.float32)
    oc, ol = bidirectional(retention_direction, in_c, in_l, S0, (decay_raw,))

    def finish(o, g):
        m = jnp.mean(o, axis=-1, keepdims=True)
        var = jnp.mean(jnp.square(o - m), axis=-1, keepdims=True)
        o = ((o - m) * lax.rsqrt(var + RT_GN_EPS)).reshape(o.shape[0], o.shape[1], -1)
        return o * gn_w * jax.nn.silu(g)

    return finish(oc, g_c), finish(ol, g_l)


def moe(h, router_w, router_b, w_gu, b_gu, w_dn, b_dn):
    f32 = jnp.float32
    t = h.reshape(-1, h.shape[-1])
    logits = t.astype(f32) @ router_w.astype(f32) + router_b.astype(f32)
    vals, idx = lax.top_k(logits, TOP_K)
    probs = jax.nn.softmax(vals, axis=-1)
    gate = jnp.sum(jax.nn.one_hot(idx, N_EXPERTS, dtype=f32) * probs[..., None], axis=1)
    out = jnp.zeros(t.shape, f32)
    for e in range(N_EXPERTS):
        gu = (t @ w_gu[e]).astype(f32) + b_gu[e]
        glu = jnp.minimum(gu[:, :D_EXPERT], SWIGLU_LIMIT)
        lin = jnp.clip(gu[:, D_EXPERT:], -SWIGLU_LIMIT, SWIGLU_LIMIT)
        act = glu * jax.nn.sigmoid(SWIGLU_ALPHA * glu) * (lin + 1.0)
        y = (act.astype(t.dtype) @ w_dn[e]).astype(f32) + b_dn[e]
        out = out + gate[:, e:e + 1] * y
    return out.reshape(h.shape).astype(h.dtype)


def setup_inputs(seed: int = 0) -> dict:
    key = jax.random.key(seed)
    keys = iter(jax.random.split(key, 64))
    f32 = jnp.float32
    G, D, E, F, NL = D_GROUP, D_MODEL, N_EXPERTS, D_EXPERT, DEPTH

    def normal(shape, scale):
        return jax.random.normal(next(keys), shape, f32) * scale

    def uniform(shape, lo, hi):
        return jax.random.uniform(next(keys), shape, f32, lo, hi)

    def near(shape, centre, noise=0.02):
        return centre + normal(shape, noise)

    lam_s = uniform((NL, 2, G), 0.9, 0.999) ** (1.0 / RG_C)
    rg_lambda = jnp.log(lam_s) - jnp.log1p(-lam_s)
    neg_log_gamma = -np.log1p(-np.power(2.0, -5.0 - np.arange(RT_HEADS)))
    rt_base = jnp.asarray(np.log(np.expm1(neg_log_gamma)), f32)

    return {
        'x': normal((BATCH, SEQ, D), 1.0),
        'c': normal((BATCH, D), 1.0),
        'ctx': normal((BATCH, CTX_LEN, D), 1.0),
        'c_ctx': normal((D,), 1.0),
        'ada_w': normal((NL, D, N_MOD * D), 0.5 * D ** -0.5),
        'ada_b': normal((NL, N_MOD * D), 0.02),
        'norm1_w': near((NL, D), 1.0),
        'norm2_w': near((NL, D), 1.0),
        'w_in': normal((NL, D, D_IN), D ** -0.5),
        'w_out': normal((NL, N_GROUPS * G, D), (N_GROUPS * G) ** -0.5),
        'hy_short_w': normal((NL, 3, 3 * G), 3 ** -0.5),
        'hy_short_b': normal((NL, 3 * G), 0.02),
        'hy_f_w1': normal((NL, HY_EMB, HY_FFN), HY_EMB ** -0.5),
        'hy_f_b1': normal((NL, HY_FFN), 0.1),
        'hy_f_w2': normal((NL, HY_FFN, HY_FFN), HY_FFN ** -0.5),
        'hy_f_b2': normal((NL, HY_FFN), 0.1),
        'hy_f_w3': normal((NL, HY_FFN, HY_FFN), HY_FFN ** -0.5),
        'hy_f_b3': normal((NL, HY_FFN), 0.1),
        'hy_f_w4': normal((NL, HY_FFN, 2 * HY_ORDER * G), HY_FFN ** -0.5),
        'hy_f_freq': near((NL, HY_FFN), 1.0, 0.05),
        'hy_bias': normal((NL, HY_ORDER, G), 1.0),
        'rg_conv_w': normal((NL, 2, RG_CONV, G), RG_CONV ** -0.5),
        'rg_conv_b': normal((NL, 2, G), 0.02),
        'rg_wa': normal((NL, 2, RG_HEADS, G // RG_HEADS, G // RG_HEADS), (G // RG_HEADS) ** -0.5),
        'rg_ba': normal((NL, 2, G), 0.02),
        'rg_wx': normal((NL, 2, RG_HEADS, G // RG_HEADS, G // RG_HEADS), (G // RG_HEADS) ** -0.5),
        'rg_bx': normal((NL, 2, G), 0.02),
        'rg_lambda': rg_lambda,
        'rw_mu': uniform((NL, 2, 4, G), 0.0, 1.0),
        'rw_w0': uniform((NL, 2, G), -6.5, -1.5),
        'rw_w1': normal((NL, 2, G, RW_DECAY_LORA), G ** -0.5),
        'rw_w2': normal((NL, 2, RW_DECAY_LORA, G), 0.1 * RW_DECAY_LORA ** -0.5),
        'rw_a0': normal((NL, 2, G), 0.1),
        'rw_a1': normal((NL, 2, G, RW_A_LORA), G ** -0.5),
        'rw_a2': normal((NL, 2, RW_A_LORA, G), 0.1 * RW_A_LORA ** -0.5),
        'rw_g1': normal((NL, G, RW_G_LORA), G ** -0.5),
        'rw_g2': normal((NL, RW_G_LORA, G), RW_G_LORA ** -0.5),
        'rw_k_k': near((NL, G), 0.85, 0.05),
        'rw_k_a': near((NL, G), 1.0, 0.05),
        'rw_r_k': normal((NL, RW_HEADS, RW_HEAD), 0.1),
        'rw_ln_w': near((NL, G), 1.0),
        'rw_ln_b': normal((NL, G), 0.02),
        'rw_v0': near((NL - 1, G), 1.0, 0.05),
        'rw_v1': normal((NL - 1, G, RW_V_LORA), G ** -0.5),
        'rw_v2': normal((NL - 1, RW_V_LORA, G), 0.1 * RW_V_LORA ** -0.5),
        'rt_decay': rt_base + normal((NL, 2, RT_HEADS), 0.05),
        'rt_gn_w': near((NL, G), 1.0),
        'moe_router_w': normal((NL, D, E), D ** -0.5),
        'moe_router_b': normal((NL, E), 0.01),
        'moe_w_gu': normal((NL, E, D, 2 * F), D ** -0.5),
        'moe_b_gu': normal((NL, E, 2 * F), 0.02),
        'moe_w_dn': normal((NL, E, F, D), F ** -0.5),
        'moe_b_dn': normal((NL, E, D), 0.02),
        'final_norm_w': near((D,), 1.0),
    }


def reference(x, c, ctx, c_ctx, ada_w, ada_b, norm1_w, norm2_w, w_in, w_out,
              hy_short_w, hy_short_b, hy_f_w1, hy_f_b1, hy_f_w2, hy_f_b2, hy_f_w3, hy_f_b3,
              hy_f_w4, hy_f_freq, hy_bias,
              rg_conv_w, rg_conv_b, rg_wa, rg_ba, rg_wx, rg_bx, rg_lambda,
              rw_mu, rw_w0, rw_w1, rw_w2, rw_a0, rw_a1, rw_a2, rw_g1, rw_g2, rw_k_k, rw_k_a,
              rw_r_k, rw_ln_w, rw_ln_b, rw_v0, rw_v1, rw_v2,
              rt_decay, rt_gn_w,
              moe_router_w, moe_router_b, moe_w_gu, moe_b_gu, moe_w_dn, moe_b_dn,
              final_norm_w):
    f32 = jnp.float32
    dt = x.dtype
    G = D_GROUP
    L = x.shape[1]
    n_ctx = ctx.shape[1]
    ROWS = L // GRID_W
    rows = jnp.repeat(jnp.arange(ROWS, dtype=f32), GRID_W)
    cols = jnp.tile(jnp.arange(GRID_W, dtype=f32), ROWS)
    cond_lat = jax.nn.silu(c.astype(f32))[:, None, :]
    cond_ctx = jax.nn.silu(c_ctx.astype(f32))[None, None, :]
    xl, xc = x, ctx.astype(dt)
    vf_c = vf_l = None

    for l in range(DEPTH):
        last = l == DEPTH - 1
        aw = ada_w[l].astype(f32)
        mod_l = jnp.split((cond_lat @ aw + ada_b[l]).astype(dt), N_MOD, axis=-1)
        mod_c = jnp.split((cond_ctx @ aw + ada_b[l]).astype(dt), N_MOD, axis=-1)

        hl = modulate(xl, norm1_w[l], mod_l[0], mod_l[1])
        hc = modulate(xc, norm1_w[l], mod_c[0], mod_c[1])
        ul = (hl @ w_in[l]).astype(f32)
        uc = (hc @ w_in[l]).astype(f32)
        hy_p = (hy_short_w[l], hy_short_b[l], hy_f_w1[l], hy_f_b1[l], hy_f_w2[l], hy_f_b2[l],
                hy_f_w3[l], hy_f_b3[l], hy_f_w4[l], hy_f_freq[l], hy_bias[l])
        hy_l = hyena_mixer(ul[..., : 3 * G], *hy_p)
        rg_c, rg_l = rglru_mixer(uc[..., 3 * G: 5 * G], ul[..., 3 * G: 5 * G],
                                 rg_conv_w[l], rg_conv_b[l], rg_wa[l], rg_ba[l],
                                 rg_wx[l], rg_bx[l], rg_lambda[l])
        vmix = None if l == 0 else (rw_v0[l - 1], rw_v1[l - 1], rw_v2[l - 1])
        rw_c, rw_l, vf_c, vf_l = rwkv_mixer(uc[..., 5 * G: 9 * G], ul[..., 5 * G: 9 * G],
                                            vf_c, vf_l, vmix, rw_mu[l], rw_w0[l], rw_w1[l],
                                            rw_w2[l], rw_a0[l], rw_a1[l], rw_a2[l], rw_g1[l],
                                            rw_g2[l], rw_k_k[l], rw_k_a[l], rw_r_k[l],
                                            rw_ln_w[l], rw_ln_b[l])
        rt_c, rt_l = retention_mixer(uc[..., 9 * G:], ul[..., 9 * G:], rows, cols,
                                     rt_decay[l], rt_gn_w[l])
        yl = jnp.concatenate([hy_l, rg_l, rw_l, rt_l], axis=-1).astype(dt) @ w_out[l]
        xl = xl + mod_l[2] * yl
        if not last:
            hy_c = hyena_mixer(uc[..., : 3 * G], *hy_p)
            yc = jnp.concatenate([hy_c, rg_c, rw_c, rt_c], axis=-1).astype(dt) @ w_out[l]
            xc = xc + mod_c[2] * yc

        moe_p = (moe_router_w[l], moe_router_b[l], moe_w_gu[l], moe_b_gu[l],
                 moe_w_dn[l], moe_b_dn[l])
        hl = modulate(xl, norm2_w[l], mod_l[3], mod_l[4])
        if last:
            xl = xl + mod_l[5] * moe(hl, *moe_p)
        else:
            hc = modulate(xc, norm2_w[l], mod_c[3], mod_c[4])
            f = moe(jnp.concatenate([hc, hl], axis=1), *moe_p)
            xc = xc + mod_c[5] * f[:, :n_ctx]
            xl = xl + mod_l[5] * f[:, n_ctx:]

    return rms_norm(xl, final_norm_w)
```

```cpp
#ifdef CPU_TEST
#include <cmath>
#include <cstdio>
#include <cstdlib>
#include <cstring>
#include <cstdint>
#include <vector>
#define DEV static inline
struct float4 { float x, y, z, w; };
struct uint4 { unsigned x, y, z, w; };
#else
#include <hip/hip_runtime.h>
#include <cstdio>
#include <cstdint>
#define DEV __device__ __forceinline__
#endif

#ifndef NB
#define NB 4
#endif
#ifndef SEQ
#define SEQ 4096
#endif
#ifndef CTX
#define CTX 256
#endif
constexpr int D = 2048, G = 512, DIN = 13 * G, NMOD = 6, DEPTH = 2;
constexpr int TL = NB * SEQ, TC = NB * CTX, T = TL + TC, SCANL = CTX + SEQ;
constexpr int NE = 32, TOPK = 4, FE = 1024;
constexpr int RTC = 128, NCHUNK = T / RTC, NCH_C = CTX / RTC, NCH_L = SEQ / RTC;
constexpr int MAXTILES = (T * TOPK) / 256 + NE, MAXSLOT = MAXTILES * 256;
constexpr int U_HY = 0, U_RG = 3 * G, U_RW = 5 * G, U_RT = 9 * G;
constexpr int ADA_KS = 8;
static_assert(TL % 256 == 0 && TC % 256 == 0 && SEQ % 128 == 0 && CTX % 128 == 0, "tile shapes");

enum { I_x, I_c, I_ctx, I_c_ctx, I_ada_w, I_ada_b, I_norm1_w, I_norm2_w, I_w_in, I_w_out, I_hy_short_w, I_hy_short_b, I_hy_f_w1, I_hy_f_b1, I_hy_f_w2, I_hy_f_b2,
       I_hy_f_w3, I_hy_f_b3, I_hy_f_w4, I_hy_f_freq, I_hy_bias, I_rg_conv_w, I_rg_conv_b, I_rg_wa, I_rg_ba, I_rg_wx, I_rg_bx, I_rg_lambda, I_rw_mu, I_rw_w0, I_rw_w1,
       I_rw_w2, I_rw_a0, I_rw_a1, I_rw_a2, I_rw_g1, I_rw_g2, I_rw_k_k, I_rw_k_a, I_rw_r_k, I_rw_ln_w, I_rw_ln_b, I_rw_v0, I_rw_v1, I_rw_v2, I_rt_decay, I_rt_gn_w,
       I_moe_router_w, I_moe_router_b, I_moe_w_gu, I_moe_b_gu, I_moe_w_dn, I_moe_b_dn, I_final_norm_w, N_IN };

constexpr size_t al256(size_t x) { return (x + 255) & ~(size_t)255; }
constexpr size_t O_CTL = 0;
constexpr size_t CTL_BYTES = 1u << 20;
constexpr size_t O_MODS = CTL_BYTES;
constexpr size_t O_ADAP = O_MODS + al256((size_t)2 * (NB + 1) * 12288 * 4);
constexpr size_t O_X = O_ADAP + al256((size_t)ADA_KS * 2 * (NB + 1) * 12288 * 4);
constexpr size_t O_A1 = O_X + al256((size_t)T * D * 4);
constexpr size_t O_U = O_A1 + al256((size_t)T * D * 2);
constexpr size_t O_CAT = O_U + al256((size_t)T * DIN * 2);
constexpr size_t O_WIN = O_CAT + al256((size_t)T * D * 2);
constexpr size_t O_WOUT = O_WIN + al256((size_t)2 * DIN * D * 2);
constexpr size_t O_WGU = O_WOUT + al256((size_t)2 * D * D * 2);
constexpr size_t O_WDN = O_WGU + al256((size_t)2 * NE * 2048 * 2048 * 2);
constexpr size_t O_HYA = O_WDN + al256((size_t)2 * NE * 2048 * 1024 * 2);
constexpr size_t O_HYB = O_HYA + al256((size_t)3 * SEQ * 64 * 4);
constexpr size_t O_TAPS = O_HYB + al256((size_t)3 * SEQ * 64 * 4);
constexpr size_t O_NRM = O_TAPS + al256((size_t)3 * SEQ * 2048 * 4);
constexpr size_t O_ROWSS = O_NRM + al256((size_t)3 * 2 * 512 * 4);
constexpr size_t O_VFIRST = O_ROWSS + al256((size_t)T * 4);
constexpr size_t O_LOGITS = O_VFIRST + al256((size_t)T * G * 4);
constexpr size_t O_TOPE = O_LOGITS + al256((size_t)T * NE * 4);
constexpr size_t O_TOPP = O_TOPE + al256((size_t)T * 4 * 4);
constexpr size_t O_TOPPOS = O_TOPP + al256((size_t)T * 4 * 4);
constexpr size_t O_TOKSLOT = O_TOPPOS + al256((size_t)T * 4 * 4);
constexpr size_t O_SLOTTOK = O_TOKSLOT + al256((size_t)T * 4 * 4);
constexpr size_t O_SLOTP = O_SLOTTOK + al256((size_t)MAXSLOT * 4);
constexpr size_t O_TILEE = O_SLOTP + al256((size_t)MAXSLOT * 4);
constexpr size_t O_SCR = O_TILEE + al256((size_t)(MAXTILES + 64) * 4);
constexpr size_t SZ_TG = al256((size_t)T * G * 4), SZ_2TG = al256((size_t)2 * T * G * 4);
constexpr size_t O_HYU = O_SCR;
constexpr size_t O_HZ1 = O_HYU + al256((size_t)T * 1536 * 4);
constexpr size_t O_RGXC = O_HZ1 + SZ_TG;
constexpr size_t O_RGA = O_RGXC + SZ_2TG, O_RGB = O_RGA + SZ_2TG, O_RGH = O_RGB + SZ_2TG;
constexpr size_t O_RWV = O_RGH + SZ_2TG, O_RWG = O_RWV + SZ_TG;
constexpr size_t O_LH = O_RWG + SZ_TG;
constexpr size_t O_LHW = O_LH + al256((size_t)T * 160 * 4);
constexpr size_t O_SR = O_LHW + al256((size_t)2 * T * 128 * 4);
constexpr size_t O_SW = O_SR + SZ_2TG, O_SK = O_SW + SZ_2TG, O_SV = O_SK + SZ_2TG, O_SKKR = O_SV + SZ_2TG, O_SA = O_SKKR + SZ_2TG, O_SKK = O_SA + SZ_2TG,
                 O_SKKA = O_SKK + SZ_2TG, O_SY = O_SKKA + SZ_2TG;
constexpr size_t O_RQ = O_SY + SZ_2TG, O_RK = O_RQ + SZ_TG;
constexpr size_t O_SC = O_RK + SZ_TG;
constexpr size_t SZ_SC = al256((size_t)NCHUNK * 4 * 128 * 128 * 4);
constexpr size_t O_KV = O_SC + SZ_SC, O_SPREV = O_KV + 2 * SZ_SC;
constexpr size_t O_RO = O_SPREV + 2 * SZ_SC;
constexpr size_t O_MIXEND = O_RO + SZ_TG;
constexpr size_t O_AG = O_SCR;
constexpr size_t O_ACT = O_AG + al256((size_t)MAXSLOT * D * 2);
constexpr size_t O_OSLOT = O_ACT + al256((size_t)MAXSLOT * FE * 2);
constexpr size_t O_MOEEND = O_OSLOT + al256((size_t)MAXSLOT * D * 4);
constexpr size_t WS_END = O_MIXEND > O_MOEEND ? O_MIXEND : O_MOEEND;
constexpr int CW_COUNTS = 64;
constexpr int CW_BAR = 4096;

struct P { const float* in[N_IN]; float* out; unsigned char* ws; int lo, hi; };
#ifdef CPU_TEST
#define PREF const P&
#else
#define PREF const __attribute__((address_space(4))) P&
#endif
#define WSF(off) ((float*)(p.ws + (off)))
#define WSI(off) ((int*)(p.ws + (off)))
#define WSH(off) ((unsigned short*)(p.ws + (off)))

DEV unsigned short f2bf(float f) { unsigned u; memcpy(&u, &f, 4); u += 0x7fffu + ((u >> 16) & 1u); return (unsigned short)(u >> 16); }
DEV float bf2f(unsigned short h) { unsigned u = ((unsigned)h) << 16; float f; memcpy(&f, &u, 4); return f; }
DEV float sigm(float x) { return 1.0f / (1.0f + expf(-x)); }
DEV float siluf(float x) { return x * sigm(x); }
DEV float softplusf(float x) { return fmaxf(x, 0.f) + log1pf(expf(-fabsf(x))); }
DEV float gelu_tanh(float x) { return 0.5f * x * (1.0f + tanhf(0.7978845608028654f * (x + 0.044715f * x * x * x))); }
DEV int tok_t(int m) { return m < TL ? m % SEQ : (m - TL) % CTX; }
DEV int tok_len(int m) { return m < TL ? SEQ : CTX; }
DEV int mod_row(int m) { return m < TL ? m / SEQ : NB; }
DEV int tok_prev(int m, int d, int k) { const int t = tok_t(m); if (d == 0) return t - k >= 0 ? m - k : -1; return t + k < tok_len(m) ? m + k : -1; }
DEV int scan_tok(int d, int b, int pp) { if (pp < CTX) { const int tc = d == 0 ? pp : CTX - 1 - pp; return TL + b * CTX + tc; } const int q = pp - CTX; return b * SEQ + (d == 0 ? q : SEQ - 1 - q); }
DEV float ldu(PREF p, int m, int col) { return bf2f(WSH(O_U)[(size_t)m * DIN + col]); }
DEV const float* modp(PREF p, int l, int row, int which) { return WSF(O_MODS) + ((size_t)(l * (NB + 1) + row) * NMOD + which) * D; }

DEV void st_copy_x(PREF p, int, long g) { const long n4 = (long)TL * D / 4; const float4* s = g < n4 ? (const float4*)p.in[I_x] + g : (const float4*)p.in[I_ctx] + (g - n4); ((float4*)WSF(O_X))[g] = *s; }
constexpr long N_copy_x = (long)T * D / 4;

DEV void st_ada_part(PREF p, int, long g) {
    const int c4 = (int)(g % 3072), ks = (int)((g / 3072) % ADA_KS), l = (int)(g / (3072 * ADA_KS));
    float acc[NB + 1][4];
#pragma unroll
    for (int r = 0; r <= NB; ++r) { acc[r][0] = acc[r][1] = acc[r][2] = acc[r][3] = 0.f; }
    const float* aw = p.in[I_ada_w] + (size_t)l * D * 12288;
    for (int k = ks * (D / ADA_KS); k < (ks + 1) * (D / ADA_KS); ++k) {
        const float4 w = *(const float4*)(aw + (size_t)k * 12288 + c4 * 4);
#pragma unroll
        for (int r = 0; r <= NB; ++r) { const float cv = siluf(r < NB ? p.in[I_c][r * D + k] : p.in[I_c_ctx][k]); acc[r][0] += cv * w.x; acc[r][1] += cv * w.y; acc[r][2] += cv * w.z; acc[r][3] += cv * w.w; }
    }
#pragma unroll
    for (int r = 0; r <= NB; ++r) { float4 o; o.x = acc[r][0]; o.y = acc[r][1]; o.z = acc[r][2]; o.w = acc[r][3];
        *(float4*)(WSF(O_ADAP) + ((size_t)(ks * 2 + l) * (NB + 1) + r) * 12288 + c4 * 4) = o; }
}
constexpr long N_ada_part = 2L * ADA_KS * 3072;
DEV void st_ada_red(PREF p, int, long g) {
    const int col = (int)(g % 12288), r = (int)((g / 12288) % (NB + 1)), l = (int)(g / (12288 * (NB + 1)));
    float s = p.in[I_ada_b][l * 12288 + col];
    for (int ks = 0; ks < ADA_KS; ++ks) s += WSF(O_ADAP)[((size_t)(ks * 2 + l) * (NB + 1) + r) * 12288 + col];
    WSF(O_MODS)[(size_t)(l * (NB + 1) + r) * 12288 + col] = s;
}
constexpr long N_ada_red = 2L * (NB + 1) * 12288;

DEV void cvt_one(const float* W, int K, int N, unsigned short* WT, long g, int permute_gu) {
    const int n = (int)(g % N), k8 = (int)(g / N);
    unsigned short o[8];
#pragma unroll
    for (int j = 0; j < 8; ++j) o[j] = f2bf(W[(size_t)(k8 * 8 + j) * N + n]);
    int nd = n;
    if (permute_gu) { const int bj = n / 1024, r = n % 1024, pn = r / 128, j = r % 128; nd = pn * 256 + bj * 128 + j; }
    uint4 v; memcpy(&v, o, 16);
    *(uint4*)(WT + (size_t)nd * K + k8 * 8) = v;
}
DEV void st_cvt_win(PREF p, int, long g) { const long per = (long)D / 8 * DIN; const int l = (int)(g / per); cvt_one(p.in[I_w_in] + (size_t)l * D * DIN, D, DIN, WSH(O_WIN) + (size_t)l * DIN * D, g % per, 0); }
constexpr long N_cvt_win = 2L * (D / 8) * DIN;
DEV void st_cvt_wout(PREF p, int, long g) { const long per = (long)D / 8 * D; const int l = (int)(g / per); cvt_one(p.in[I_w_out] + (size_t)l * D * D, D, D, WSH(O_WOUT) + (size_t)l * D * D, g % per, 0); }
constexpr long N_cvt_wout = 2L * (D / 8) * D;
DEV void st_cvt_wgu(PREF p, int, long g) { const long per = (long)D / 8 * 2048; const int le = (int)(g / per); cvt_one(p.in[I_moe_w_gu] + (size_t)le * D * 2048, D, 2048, WSH(O_WGU) + (size_t)le * 2048 * D, g % per, 1); }
constexpr long N_cvt_wgu = 2L * NE * (D / 8) * 2048;
DEV void st_cvt_wdn(PREF p, int, long g) { const long per = (long)FE / 8 * D; const int le = (int)(g / per); cvt_one(p.in[I_moe_w_dn] + (size_t)le * FE * D, FE, D, WSH(O_WDN) + (size_t)le * D * FE, g % per, 0); }
constexpr long N_cvt_wdn = 2L * NE * (FE / 8) * D;

DEV void st_rowss(PREF p, int, long g) { const float4* x = (const float4*)(WSF(O_X) + (size_t)g * D); float s = 0.f; for (int i = 0; i < D / 4; ++i) { const float4 v = x[i]; s += v.x * v.x + v.y * v.y + v.z * v.z + v.w * v.w; } WSF(O_ROWSS)[g] = s; }
DEV float modval(PREF p, int l, int m, int c, int which) {
    const float rinv = 1.0f / sqrtf(WSF(O_ROWSS)[m] * (1.0f / D) + 1e-6f);
    const float nw = (which == 0 ? p.in[I_norm1_w] : p.in[I_norm2_w])[l * D + c];
    const int r = mod_row(m);
    return WSF(O_X)[(size_t)m * D + c] * rinv * nw * (1.0f + modp(p, l, r, which + 1)[c]) + modp(p, l, r, which)[c];
}
DEV void st_mod1(PREF p, int l, long g) { const int m = (int)(g / D), c = (int)(g % D); WSH(O_A1)[g] = f2bf(modval(p, l, m, c, 0)); }
DEV void st_mod2(PREF p, int l, long g) { const int m = (int)(g / D), c = (int)(g % D); WSH(O_A1)[g] = f2bf(modval(p, l, m, c, 3)); }

DEV int hv_layer(int vi) { return vi == 1 ? 1 : 0; }
DEV int hv_len(int vi) { return vi == 2 ? CTX : SEQ; }
DEV void st_hy_h1(PREF p, int, long g) {
    const int j = (int)(g % 64), n = (int)((g / 64) % SEQ), vi = (int)(g / (64 * SEQ)); const int L = hv_len(vi), l = hv_layer(vi); if (n >= L) return;
    const float* w1 = p.in[I_hy_f_w1] + l * 33 * 64;
    const float t = (float)n / (float)(L - 1);
    float s = t * w1[j];
    for (int i = 0; i < 16; ++i) { const float fr = 1e-4f + (float)i * ((15.0f - 1e-4f) / 15.0f); const float ang = (6.283185307179586f / (float)L) * (float)n * fr;
        s += cosf(ang) * w1[(1 + i) * 64 + j] - sinf(ang) * w1[(17 + i) * 64 + j]; }
    WSF(O_HYA)[((size_t)vi * SEQ + n) * 64 + j] = sinf(p.in[I_hy_f_freq][l * 64 + j] * (s + p.in[I_hy_f_b1][l * 64 + j]));
}
DEV void hy_hidden(PREF p, long g, const float* src, float* dst, int wi, int bi) {
    const int j = (int)(g % 64), n = (int)((g / 64) % SEQ), vi = (int)(g / (64 * SEQ)); const int L = hv_len(vi), l = hv_layer(vi); if (n >= L) return;
    const float* w = p.in[wi] + l * 64 * 64; const float* h = src + ((size_t)vi * SEQ + n) * 64;
    float s = 0.f; for (int i = 0; i < 64; ++i) s += h[i] * w[i * 64 + j];
    dst[((size_t)vi * SEQ + n) * 64 + j] = sinf(p.in[I_hy_f_freq][l * 64 + j] * (s + p.in[bi][l * 64 + j]));
}
DEV void st_hy_h2(PREF p, int, long g) { hy_hidden(p, g, WSF(O_HYA), WSF(O_HYB), I_hy_f_w2, I_hy_f_b2); }
DEV void st_hy_h3(PREF p, int, long g) { hy_hidden(p, g, WSF(O_HYB), WSF(O_HYA), I_hy_f_w3, I_hy_f_b3); }
constexpr long N_hy_h = 3L * SEQ * 64;
DEV void st_hy_raw(PREF p, int, long g) {
    const int col = (int)(g % 2048), n = (int)((g / 2048) % SEQ), vi = (int)(g / (2048L * SEQ)); const int L = hv_len(vi), l = hv_layer(vi); if (n >= L) return;
    const float* w4 = p.in[I_hy_f_w4] + (size_t)l * 64 * 2048; const float* h = WSF(O_HYA) + ((size_t)vi * SEQ + n) * 64;
    float s = 0.f; for (int i = 0; i < 64; ++i) s += h[i] * w4[i * 2048 + col];
    const int c = col % 512; const float t = (float)n / (float)(L - 1);
    const float dmin = -3.0701134573253944f, dmax = -15.350567286626973f;
    const float delta = fabsf(dmin + (float)c * ((dmax - dmin) / 511.0f));
    WSF(O_TAPS)[((size_t)vi * SEQ + n) * 2048 + col] = s * expf(-t * delta);
}
constexpr long N_hy_raw = 3L * SEQ * 2048;
DEV void st_hy_nrm(PREF p, int, long g) {
    const int c = (int)(g % 512), o = (int)((g / 512) % 2), vi = (int)(g / 1024); const int L = hv_len(vi);
    const float* tp = WSF(O_TAPS) + (size_t)vi * SEQ * 2048; float s = 0.f;
    for (int n = 0; n < L; ++n) { s += fabsf(tp[(size_t)n * 2048 + o * 512 + c]); if (n >= 1) s += fabsf(tp[(size_t)n * 2048 + 1024 + o * 512 + c]); }
    WSF(O_NRM)[g] = s;
}
constexpr long N_hy_nrm = 3L * 2 * 512;
DEV void st_hy_scale(PREF p, int, long g) {
    const int col = (int)(g % 2048), n = (int)((g / 2048) % SEQ), vi = (int)(g / (2048L * SEQ)); if (n >= hv_len(vi)) return;
    WSF(O_TAPS)[g] /= WSF(O_NRM)[vi * 1024 + ((col / 512) % 2) * 512 + col % 512];
}
DEV void st_hy_short(PREF p, int l, long g) {
    const int c = (int)(g % 1536), m = (int)(g / 1536); if (l == 1 && m >= TL) return;
    const float* sw = p.in[I_hy_short_w] + l * 3 * 1536; const int pm = tok_prev(m, 0, 1), nm = tok_prev(m, 1, 1);
    float s = sw[1536 + c] * ldu(p, m, c) + p.in[I_hy_short_b][l * 1536 + c];
    if (pm >= 0) s += sw[c] * ldu(p, pm, c);
    if (nm >= 0) s += sw[2 * 1536 + c] * ldu(p, nm, c);
    WSF(O_HYU)[g] = s;
}
constexpr long N_hy_short = (long)T * 1536;
constexpr int HTT = 16;
constexpr long N_hy_conv_l = (long)NB * (SEQ / HTT) * 512, N_hy_conv_c = (long)NB * (CTX / HTT) * 512;
DEV void st_hy_conv(PREF p, int l, int o, long g) {
    int c, tt, b, L, vi, m0;
    if (g < N_hy_conv_l) { c = (int)(g % 512); tt = (int)((g / 512) % (SEQ / HTT)); b = (int)(g / (512 * (SEQ / HTT))); L = SEQ; vi = l; m0 = b * SEQ; }
    else { if (l == 1) return; g -= N_hy_conv_l; c = (int)(g % 512); tt = (int)((g / 512) % (CTX / HTT)); b = (int)(g / (512 * (CTX / HTT))); L = CTX; vi = 2; m0 = TL + b * CTX; }
    const float* tp = WSF(O_TAPS) + (size_t)vi * SEQ * 2048 + o * 512 + c;
    const float* zin = o == 0 ? WSF(O_HYU) + c : WSF(O_HZ1) + c; const int zs = o == 0 ? 1536 : 512;
    const int t0 = tt * HTT;
    float acc[HTT];
#pragma unroll
    for (int i = 0; i < HTT; ++i) acc[i] = 0.f;
    for (int s0 = 0; s0 < L; s0 += HTT) {
        float w[2 * HTT - 1], z[HTT];
#pragma unroll
        for (int q = 0; q < 2 * HTT - 1; ++q) { const int d = t0 - s0 + (q - (HTT - 1)); w[q] = (d >= 0) ? (d < L ? tp[(size_t)d * 2048] : 0.f) : (-d < L ? tp[(size_t)(-d) * 2048 + 1024] : 0.f); }
#pragma unroll
        for (int j = 0; j < HTT; ++j) z[j] = zin[(size_t)(m0 + s0 + j) * zs];
#pragma unroll
        for (int i = 0; i < HTT; ++i)
#pragma unroll
            for (int j = 0; j < HTT; ++j) acc[i] += w[i - j + HTT - 1] * z[j];
    }
    const float bias = p.in[I_hy_bias][l * 1024 + o * 512 + c];
#pragma unroll
    for (int i = 0; i < HTT; ++i) { const int m = m0 + t0 + i; const float zt = zin[(size_t)m * zs]; const float gate = WSF(O_HYU)[(size_t)m * 1536 + (o + 1) * 512 + c];
        const float r = gate * (acc[i] + bias * zt);
        if (o == 0) WSF(O_HZ1)[(size_t)m * 512 + c] = r; else WSH(O_CAT)[(size_t)m * D + c] = f2bf(r); }
}
DEV void st_hy_conv0(PREF p, int l, long g) { st_hy_conv(p, l, 0, g); }
DEV void st_hy_conv1(PREF p, int l, long g) { st_hy_conv(p, l, 1, g); }
constexpr long N_hy_conv = N_hy_conv_l + N_hy_conv_c;

constexpr long N_dmc = 2L * T * G;
DEV void st_rg_conv(PREF p, int l, long g) {
    const int c = (int)(g % G), m = (int)((g / G) % T), d = (int)(g / ((long)G * T));
    const float* cw = p.in[I_rg_conv_w] + (size_t)(l * 2 + d) * 4 * G;
    float s = p.in[I_rg_conv_b][(l * 2 + d) * G + c];
    for (int j = 0; j < 4; ++j) { const int pm = tok_prev(m, d, 3 - j); if (pm >= 0) s += cw[j * G + c] * ldu(p, pm, U_RG + c); }
    WSF(O_RGXC)[g] = s;
}
DEV void st_rg_gate(PREF p, int l, long g) {
    const int c = (int)(g % G), m = (int)((g / G) % T), d = (int)(g / ((long)G * T)); const int h = c / 64, j = c % 64;
    const float* xc = WSF(O_RGXC) + ((size_t)d * T + m) * G + h * 64;
    const float* wa = p.in[I_rg_wa] + ((size_t)(l * 2 + d) * 8 + h) * 4096; const float* wx = p.in[I_rg_wx] + ((size_t)(l * 2 + d) * 8 + h) * 4096;
    float sa = p.in[I_rg_ba][(l * 2 + d) * G + c], sx = p.in[I_rg_bx][(l * 2 + d) * G + c];
    for (int i = 0; i < 64; ++i) { sa += xc[i] * wa[i * 64 + j]; sx += xc[i] * wx[i * 64 + j]; }
    const float r = sigm(sa), ig = sigm(sx);
    const float log_a = -8.0f * r * softplusf(-p.in[I_rg_lambda][(l * 2 + d) * G + c]);
    WSF(O_RGA)[g] = expf(log_a);
    WSF(O_RGB)[g] = sqrtf(-expm1f(2.0f * log_a)) * (ig * xc[j]);
}
DEV void st_rg_scan(PREF p, int, long g) {
    const int c = (int)(g % G), b = (int)((g / G) % NB), d = (int)(g / (G * NB));
    float h = 0.f;
    for (int pp = 0; pp < SCANL; ++pp) { const size_t i = ((size_t)d * T + scan_tok(d, b, pp)) * G + c; h = WSF(O_RGA)[i] * h + WSF(O_RGB)[i]; WSF(O_RGH)[i] = h; }
}
constexpr long N_rg_scan = 2L * NB * G;
DEV void st_rg_out(PREF p, int l, long g) {
    const int c = (int)(g % G), m = (int)(g / G); if (l == 1 && m >= TL) return;
    const float h = WSF(O_RGH)[(size_t)m * G + c] + WSF(O_RGH)[((size_t)T + m) * G + c];
    WSH(O_CAT)[(size_t)m * D + G + c] = f2bf(h * gelu_tanh(ldu(p, m, U_RG + G + c)));
}
constexpr long N_mc = (long)T * G;

DEV void st_rw_lh(PREF p, int l, long g) {
    const int j = (int)(g % 160), m = (int)(g / 160);
    float s = 0.f;
    if (j < 32) { if (l == 0) return; const float* v1 = p.in[I_rw_v1] + (size_t)(l - 1) * G * 32; for (int c = 0; c < G; ++c) s += ldu(p, m, U_RW + 3 * G + c) * v1[c * 32 + j]; }
    else { const float* g1 = p.in[I_rw_g1] + (size_t)l * G * 128; for (int c = 0; c < G; ++c) s += ldu(p, m, U_RW + 3 * G + c) * g1[c * 128 + (j - 32)]; s = sigm(s); }
    WSF(O_LH)[g] = s;
}
constexpr long N_rw_lh = (long)T * 160;
DEV void st_rw_vg(PREF p, int l, long g) {
    const int c = (int)(g % G), m = (int)(g / G);
    const float* lh = WSF(O_LH) + (size_t)m * 160;
    float v = ldu(p, m, U_RW + 2 * G + c);
    if (l == 0) WSF(O_VFIRST)[g] = v;
    else { const float* v2 = p.in[I_rw_v2] + (size_t)(l - 1) * 32 * G; float s = p.in[I_rw_v0][(l - 1) * G + c]; for (int j = 0; j < 32; ++j) s += lh[j] * v2[j * G + c]; v = v + (WSF(O_VFIRST)[g] - v) * sigm(s); }
    WSF(O_RWV)[g] = v;
    const float* g2 = p.in[I_rw_g2] + (size_t)l * 128 * G; float s = 0.f; for (int j = 0; j < 128; ++j) s += lh[32 + j] * g2[j * G + c];
    WSF(O_RWG)[g] = s;
}
DEV void st_rw_lhw(PREF p, int l, long g) {
    const int j = (int)(g % 128), m = (int)((g / 128) % T), d = (int)(g / (128L * T));
    const int pm = tok_prev(m, d, 1); const float* mu = p.in[I_rw_mu] + ((size_t)(l * 2 + d) * 4 + 3) * G;
    const float* w = j < 64 ? p.in[I_rw_w1] + (size_t)(l * 2 + d) * G * 64 + j : p.in[I_rw_a1] + (size_t)(l * 2 + d) * G * 64 + (j - 64);
    float s = 0.f;
    for (int c = 0; c < G; ++c) { const float z = ldu(p, m, U_RW + 3 * G + c), zp = pm >= 0 ? ldu(p, pm, U_RW + 3 * G + c) : 0.f; s += (z + (zp - z) * mu[c]) * w[c * 64]; }
    WSF(O_LHW)[g] = j < 64 ? tanhf(s) : s;
}
constexpr long N_rw_lhw = 2L * T * 128;
DEV void st_rw_tok(PREF p, int l, long g) {
    const int c = (int)(g % G), m = (int)((g / G) % T), d = (int)(g / ((long)G * T)); const int ld = l * 2 + d;
    const float* lhw = WSF(O_LHW) + ((size_t)d * T + m) * 128;
    const float* w2 = p.in[I_rw_w2] + (size_t)ld * 64 * G; const float* a2 = p.in[I_rw_a2] + (size_t)ld * 64 * G;
    float wl = p.in[I_rw_w0][ld * G + c], al = p.in[I_rw_a0][ld * G + c];
    for (int j = 0; j < 64; ++j) { wl += lhw[j] * w2[j * G + c]; al += lhw[64 + j] * a2[j * G + c]; }
    const float w_log = -softplusf(-wl) - 0.5f; const float dec = expf(-expf(w_log)); const float a = sigm(al);
    const int pm = tok_prev(m, d, 1); const float* mu = p.in[I_rw_mu] + (size_t)ld * 4 * G;
    const float r0 = ldu(p, m, U_RW + c), k0 = ldu(p, m, U_RW + G + c), v0 = WSF(O_RWV)[(size_t)m * G + c];
    const float rp = pm >= 0 ? ldu(p, pm, U_RW + c) : 0.f, kp = pm >= 0 ? ldu(p, pm, U_RW + G + c) : 0.f, vp = pm >= 0 ? WSF(O_RWV)[(size_t)pm * G + c] : 0.f;
    const float rs = r0 + (rp - r0) * mu[c], ks = k0 + (kp - k0) * mu[G + c], vs = v0 + (vp - v0) * mu[2 * G + c];
    WSF(O_SR)[g] = rs; WSF(O_SW)[g] = dec; WSF(O_SV)[g] = vs; WSF(O_SA)[g] = a;
    WSF(O_SK)[g] = ks * (1.0f + (a - 1.0f) * p.in[I_rw_k_a][l * G + c]);
    WSF(O_SKKR)[g] = ks * p.in[I_rw_k_k][l * G + c];
}
DEV void st_rw_kk(PREF p, int, long g) {
    const int c = (int)(g % G); const float* kr = WSF(O_SKKR) + (g - c) + (c / 64) * 64;
    float s = 0.f; for (int i = 0; i < 64; ++i) s += kr[i] * kr[i];
    const float kk = WSF(O_SKKR)[g] / fmaxf(sqrtf(s), 1e-12f);
    WSF(O_SKK)[g] = kk; WSF(O_SKKA)[g] = kk * WSF(O_SA)[g];
}
DEV void st_rw_scan(PREF p, int, long g) {
    const int i = (int)(g % 64), h = (int)((g / 64) % 8), b = (int)((g / 512) % NB), d = (int)(g / (512 * NB));
    float S[64];
#pragma unroll
    for (int j = 0; j < 64; ++j) S[j] = 0.f;
    for (int pp = 0; pp < SCANL; ++pp) {
        const size_t base = ((size_t)d * T + scan_tok(d, b, pp)) * G + h * 64;
        const float* kk = WSF(O_SKK) + base; const float* kka = WSF(O_SKKA) + base; const float* w = WSF(O_SW) + base; const float* k = WSF(O_SK) + base; const float* r = WSF(O_SR) + base;
        const float v = WSF(O_SV)[base + i];
        float sa = 0.f;
#pragma unroll
        for (int j = 0; j < 64; ++j) sa += S[j] * kk[j];
        float y = 0.f;
#pragma unroll
        for (int j = 0; j < 64; ++j) { S[j] = S[j] * w[j] - sa * kka[j] + v * k[j]; y += S[j] * r[j]; }
        WSF(O_SY)[base + i] = y;
    }
}
constexpr long N_rw_scan = 2L * NB * 512;
DEV void st_rw_out(PREF p, int l, long g) {
    const int c = (int)(g % G), m = (int)(g / G); if (l == 1 && m >= TL) return; const int h0 = (c / 64) * 64;
    float tot = 0.f;
    for (int d = 0; d < 2; ++d) {
        const size_t base = ((size_t)d * T + m) * G + h0;
        const float* y = WSF(O_SY) + base; const float* r = WSF(O_SR) + base; const float* k = WSF(O_SK) + base;
        float mean = 0.f, bon = 0.f;
        for (int i = 0; i < 64; ++i) { mean += y[i]; bon += r[i] * k[i] * p.in[I_rw_r_k][l * G + h0 + i]; }
        mean *= (1.0f / 64.0f);
        float var = 0.f; for (int i = 0; i < 64; ++i) { const float dd = y[i] - mean; var += dd * dd; }
        var *= (1.0f / 64.0f);
        tot += (y[c - h0] - mean) / sqrtf(var + 64e-5f) * p.in[I_rw_ln_w][l * G + c] + p.in[I_rw_ln_b][l * G + c] + bon * WSF(O_SV)[base + (c - h0)];
    }
    WSH(O_CAT)[(size_t)m * D + 2 * G + c] = f2bf(tot * WSF(O_RWG)[(size_t)m * G + c]);
}

DEV float rt_lg(PREF p, int l, int d, int h) { return -softplusf(p.in[I_rt_decay][(l * 2 + d) * 4 + h]); }
DEV void st_rt_prep(PREF p, int, long g) {
    const int c = (int)(g % G), m = (int)(g / G); const int e = c % 128;
    float q = ldu(p, m, U_RT + c), k = ldu(p, m, U_RT + G + c);
    if (m < TL) {
        const int t = m % SEQ; const int half = e / 64, eh = e % 64, i = eh % 32; const float pos = half == 0 ? (float)(t / 64) : (float)(t % 64);
        const float ang = pos * powf(10000.0f, -(float)i / 32.0f); const float cs = cosf(ang), sn = sinf(ang);
        const int cp = eh < 32 ? c + 32 : c - 32;
        const float qp = ldu(p, m, U_RT + cp), kp = ldu(p, m, U_RT + G + cp);
        if (eh < 32) { q = q * cs - qp * sn; k = k * cs - kp * sn; } else { q = qp * sn + q * cs; k = kp * sn + k * cs; }
    }
    WSF(O_RQ)[g] = q; WSF(O_RK)[g] = k * 0.08838834764831845f;
}
DEV void st_rt_score(PREF p, int, long g) {
    const int j = (int)(g % 128), i = (int)((g / 128) % 128), h = (int)((g / 16384) % 4), ch = (int)(g / 65536);
    const float* q = WSF(O_RQ) + (size_t)(ch * 128 + i) * G + h * 128; const float* k = WSF(O_RK) + (size_t)(ch * 128 + j) * G + h * 128;
    float s = 0.f; for (int e = 0; e < 128; ++e) s += q[e] * k[e];
    WSF(O_SC)[g] = s;
}
constexpr long N_rt_score = (long)NCHUNK * 4 * 128 * 128;
DEV void st_rt_kv(PREF p, int l, long g) {
    const int e = (int)(g % 128), dd = (int)((g / 128) % 128), h = (int)((g / 16384) % 4), ch = (int)((g / 65536) % NCHUNK), d = (int)(g / (65536L * NCHUNK));
    const float lg = rt_lg(p, l, d, h); float s = 0.f;
    for (int j = 0; j < 128; ++j) { const int m = ch * 128 + j; const float dec = expf(lg * (float)(d == 0 ? 127 - j : j)); s += dec * WSF(O_RK)[(size_t)m * G + h * 128 + dd] * ldu(p, m, U_RT + 2 * G + h * 128 + e); }
    WSF(O_KV)[g] = s;
}
constexpr long N_rt_kv = 2L * N_rt_score;
DEV int rt_scan_chunk(int d, int b, int n) {
    if (n < NCH_C) return TL / 128 + b * NCH_C + (d == 0 ? n : NCH_C - 1 - n);
    const int q = n - NCH_C; return b * NCH_L + (d == 0 ? q : NCH_L - 1 - q);
}
DEV void st_rt_state(PREF p, int l, long g) {
    const int de = (int)(g % 16384), h = (int)((g / 16384) % 4), b = (int)((g / 65536) % NB), d = (int)(g / (65536L * NB));
    const float cdec = expf(128.0f * rt_lg(p, l, d, h)); float S = 0.f;
    for (int n = 0; n < NCH_C + NCH_L; ++n) { const size_t i = (((size_t)d * NCHUNK + rt_scan_chunk(d, b, n)) * 4 + h) * 16384 + de; WSF(O_SPREV)[i] = S; S = cdec * S + WSF(O_KV)[i]; }
}
constexpr long N_rt_state = 2L * NB * 4 * 16384;
DEV void st_rt_out(PREF p, int l, long g) {
    const int c = (int)(g % G), m = (int)(g / G); const int h = c / 128, e = c % 128, ch = m / 128, i = m % 128;
    const float lg0 = rt_lg(p, l, 0, h), lg1 = rt_lg(p, l, 1, h);
    const float* sc = WSF(O_SC) + (((size_t)ch * 4 + h) * 128 + i) * 128;
    float o = 0.f;
    for (int j = 0; j < 128; ++j) { const float w = j <= i ? expf(lg0 * (float)(i - j)) : expf(lg1 * (float)(j - i)); o += w * sc[j] * ldu(p, ch * 128 + j, U_RT + 2 * G + h * 128 + e); }
    const float* q = WSF(O_RQ) + (size_t)m * G + h * 128;
    const float* s0 = WSF(O_SPREV) + (((size_t)0 * NCHUNK + ch) * 4 + h) * 16384 + e; const float* s1 = WSF(O_SPREV) + (((size_t)1 * NCHUNK + ch) * 4 + h) * 16384 + e;
    float c0 = 0.f, c1 = 0.f; for (int dd = 0; dd < 128; ++dd) { c0 += q[dd] * s0[dd * 128]; c1 += q[dd] * s1[dd * 128]; }
    WSF(O_RO)[g] = o + expf(lg0 * (float)(i + 1)) * c0 + expf(lg1 * (float)(128 - i)) * c1;
}
DEV void st_rt_fin(PREF p, int l, long g) {
    const int c = (int)(g % G), m = (int)(g / G); if (l == 1 && m >= TL) return; const float* o = WSF(O_RO) + (size_t)m * G + (c / 128) * 128;
    float mean = 0.f; for (int i = 0; i < 128; ++i) mean += o[i]; mean *= (1.0f / 128.0f);
    float var = 0.f; for (int i = 0; i < 128; ++i) { const float dd = o[i] - mean; var += dd * dd; } var *= (1.0f / 128.0f);
    WSH(O_CAT)[(size_t)m * D + 3 * G + c] = f2bf((o[c % 128] - mean) / sqrtf(var + 1e-6f) * p.in[I_rt_gn_w][l * G + c] * siluf(ldu(p, m, U_RT + 3 * G + c)));
}

DEV int moe_ntok(int l) { return l == DEPTH - 1 ? TL : T; }
DEV void st_moe_logit(PREF p, int l, long g) {
    const int e = (int)(g % NE), m = (int)(g / NE); if (m >= moe_ntok(l)) return;
    const float* rw = p.in[I_moe_router_w] + (size_t)l * D * NE + e; float s = p.in[I_moe_router_b][l * NE + e];
    for (int k = 0; k < D; ++k) s += modval(p, l, m, k, 3) * rw[k * NE];
    WSF(O_LOGITS)[g] = s;
}
constexpr long N_moe_logit = (long)T * NE;
DEV int atomic_inc(int* a) {
#ifdef CPU_TEST
    return __sync_fetch_and_add(a, 1);
#else
    return atomicAdd(a, 1);
#endif
}
DEV void st_moe_topk(PREF p, int l, long g) {
    if (g < MAXSLOT) { WSI(O_SLOTTOK)[g] = 0; WSF(O_SLOTP)[g] = 0.f; }
    const int m = (int)g; if (m >= moe_ntok(l)) return;
    const float* lg = WSF(O_LOGITS) + (size_t)m * NE;
    int idx[4]; float val[4]; unsigned used = 0u;
#pragma unroll
    for (int k = 0; k < 4; ++k) { int bi = -1; float bv = 0.f; for (int e = 0; e < NE; ++e) { if (used & (1u << e)) continue; const float v = lg[e]; if (bi < 0 || v > bv) { bi = e; bv = v; } } idx[k] = bi; val[k] = bv; used |= 1u << bi; }
    float ex[4], sum = 0.f;
#pragma unroll
    for (int k = 0; k < 4; ++k) { ex[k] = expf(val[k] - val[0]); sum += ex[k]; }
#pragma unroll
    for (int k = 0; k < 4; ++k) { WSI(O_TOPE)[m * 4 + k] = idx[k]; WSF(O_TOPP)[m * 4 + k] = ex[k] / sum; WSI(O_TOPPOS)[m * 4 + k] = atomic_inc((int*)(p.ws + O_CTL) + CW_COUNTS + l * NE + idx[k]); }
}
constexpr long N_moe_topk = MAXSLOT > T ? MAXSLOT : T;
DEV void st_moe_slots(PREF p, int l, long g) {
    const int* cnt = (const int*)(p.ws + O_CTL) + CW_COUNTS + l * NE;
    if (g == 0) { int nt = 0; for (int e = 0; e < NE; ++e) { const int n = (cnt[e] + 255) / 256; for (int i = 0; i < n; ++i) WSI(O_TILEE)[nt + i] = e; nt += n; } WSI(O_TILEE)[MAXTILES] = nt; }
    const int m = (int)(g / 4); if (m >= moe_ntok(l)) return;
    const int e = WSI(O_TOPE)[g]; int base = 0; for (int i = 0; i < e; ++i) base += ((cnt[i] + 255) / 256) * 256;
    const int slot = base + WSI(O_TOPPOS)[g];
    WSI(O_SLOTTOK)[slot] = m; WSF(O_SLOTP)[slot] = WSF(O_TOPP)[g]; WSI(O_TOKSLOT)[g] = slot;
}
constexpr long N_moe_slots = (long)T * 4;
DEV void st_moe_gather(PREF p, int, long g) {
    const int c8 = (int)(g % (D / 8)), slot = (int)(g / (D / 8)); if (slot >= WSI(O_TILEE)[MAXTILES] * 256) return;
    ((uint4*)WSH(O_AG))[g] = ((const uint4*)WSH(O_A1))[(size_t)WSI(O_SLOTTOK)[slot] * (D / 8) + c8];
}
constexpr long N_moe_gather = (long)MAXSLOT * (D / 8);
DEV void st_moe_comb(PREF p, int l, long g) {
    const int c = (int)(g % D), m = (int)(g / D); if (m >= moe_ntok(l)) return;
    float s = 0.f; for (int k = 0; k < 4; ++k) s += WSF(O_OSLOT)[(size_t)WSI(O_TOKSLOT)[m * 4 + k] * D + c];
    WSF(O_X)[g] += modp(p, l, mod_row(m), 5)[c] * s;
}
DEV void st_final(PREF p, int, long g) {
    const int c = (int)(g % D), m = (int)(g / D);
    p.out[g] = WSF(O_X)[g] / sqrtf(WSF(O_ROWSS)[m] * (1.0f / D) + 1e-6f) * p.in[I_final_norm_w][c];
}

#ifndef CPU_TEST
namespace pg8 {
#define PG8_LAS __attribute__((address_space(3)))
typedef unsigned short bf16_t;
typedef short bf16x8 __attribute__((ext_vector_type(8)));
typedef float f32x4 __attribute__((ext_vector_type(4)));
typedef unsigned u32x4 __attribute__((ext_vector_type(4)));
constexpr int BM = 256, BK = 64, HALF = 128, HTB = HALF * BK * 2  , STAGE_BYTES = 8 * HTB, NXCD = 8, WGM = 8;

__host__ __device__ __forceinline__ int lds_byte(int r, int c) { const int st = (r >> 4) * 2 + (c >> 5), rr = r & 15, cc = c & 31, ob = rr * 64 + cc * 2; return st * 1024 + (ob ^ (((ob >> 9) & 1) << 5)); }
__host__ __device__ __forceinline__ void stage_rc(int b, int& R, int& C) { const int st = b / 1024, sb = b % 1024, swz = sb ^ (((sb >> 9) & 1) << 5); R = (st >> 1) * 16 + swz / 64; C = (st & 1) * 32 + (swz % 64) / 2; }
__host__ __device__ __forceinline__ int perm32(int rho) { const int n = rho >> 4, i = rho & 15; return 8 * (i >> 2) + 4 * n + (i & 3); }
struct Unit { int pm, pn; };
struct Gemm { const bf16_t* A; const bf16_t* Bt; int M, N, K; };
struct StaticOrder {
    int nM, nN, nwg, G, c;
    __host__ __device__ void init(int M, int N, int G_, int c_) { nM = M / BM; nN = N / BM; nwg = nM * nN; G = G_; c = c_; }
    __host__ __device__ bool next(int i, Unit& u) const {
        const long L = (long)i * G + c; if (L >= nwg) return false;
        int wgid = (int)L; { const int q = nwg / NXCD, r = nwg % NXCD, xcd = wgid % NXCD, off = wgid / NXCD; wgid = (xcd < r ? xcd * (q + 1) : r * (q + 1) + (xcd - r) * q) + off; }
        const int nig = WGM * nN, gid = wgid / nig, fm = gid * WGM, gsz = (nM - fm) < WGM ? (nM - fm) : WGM;
        u.pm = fm + ((wgid % nig) % gsz); u.pn = (wgid % nig) / gsz; return true;
    }
    __device__ __forceinline__ void a_ready(const Unit&) const {}
    __device__ __forceinline__ void done(const Unit&) const {}
};
__device__ __forceinline__ unsigned cvt_pk_bf16(float lo, float hi) { unsigned r; asm volatile("v_cvt_pk_bf16_f32 %0, %1, %2" : "=v"(r) : "v"(lo), "v"(hi)); return r; }
template <class Epi, class Sched, bool STAMP = false>
__device__ __forceinline__ void gemm_phase(PG8_LAS unsigned char* lds, const Gemm g, const Sched& S, const Epi& E, unsigned long long* stamps) {
    const int tid = threadIdx.x, wid = __builtin_amdgcn_readfirstlane(tid >> 6), lane = tid & 63, wr = wid >> 2, wc = wid & 3, fr = lane & 15, fq = lane >> 4;
    const int K = g.K, nt = K / BK;
    int ts_lo = 0, ts_hi = 0, nts = 0; const unsigned long long rt_entry = STAMP ? (unsigned long long)wall_clock64() : 0ull;
#define PG8_STAMP() do { if (STAMP && wid == 0 && nts < 64) { const unsigned long long _c = (unsigned long long)clock64(); \
        ts_lo = (lane == nts) ? (int)(unsigned)_c : ts_lo; ts_hi = (lane == nts) ? (int)(unsigned)(_c >> 32) : ts_hi; ++nts; } } while (0)
    PG8_STAMP();
    unsigned voffA[2], voffB[2];
#pragma unroll
    for (int i = 0; i < 2; ++i) { int R, C; stage_rc(tid * 16 + i * 8192, R, C); const int Rb = Epi::PERM ? ((R & ~31) + perm32(R & 31)) : R;
        voffA[i] = (unsigned)(R * K + C) * 2u; voffB[i] = (unsigned)(Rb * K + C) * 2u; }
    const size_t kstep = (size_t)(BK * 2);
    const size_t hstep = (size_t)HALF * K * 2;
    const size_t tstep = 2 * hstep;
    const unsigned ldsw = (unsigned)wid * 1024u;
    const int aoff = lds_byte(wr * 64 + fr, fq * 8), boff = lds_byte(wc * 32 + fr, fq * 8);
#define PG8_SA(b, h) (((b) * 2 + (h)) * HTB)
#define PG8_SB(b, h) ((4 + (b) * 2 + (h)) * HTB)
#define PG8_STAGE(bufoff, gbase, voff) do { _Pragma("unroll") for (int _i = 0; _i < 2; ++_i) \
        __builtin_amdgcn_global_load_lds((const unsigned*)((const char*)(gbase) + (voff)[_i]), (PG8_LAS unsigned*)(lds + (bufoff) + ldsw + _i * 8192), 16, 0, 0); } while (0)
#define PG8_LDA(dst, b, h) do { _Pragma("unroll") for (int m = 0; m < 4; ++m) _Pragma("unroll") for (int k = 0; k < 2; ++k) dst[m][k] = *(const PG8_LAS bf16x8*)(lds + PG8_SA(b, h) + aoff + m * 2048 + k * 1024); } while (0)
#define PG8_LDB(dst, b, h) do { _Pragma("unroll") for (int n = 0; n < 2; ++n) _Pragma("unroll") for (int k = 0; k < 2; ++k) dst[n][k] = *(const PG8_LAS bf16x8*)(lds + PG8_SB(b, h) + boff + n * 2048 + k * 1024); } while (0)
#define PG8_MMA(ai, bj, At, Bt) do { __builtin_amdgcn_s_setprio(1); _Pragma("unroll") for (int m = 0; m < 4; ++m) _Pragma("unroll") for (int n = 0; n < 2; ++n) _Pragma("unroll") for (int k = 0; k < 2; ++k) \
        acc[ai][bj][m][n] = __builtin_amdgcn_mfma_f32_16x16x32_bf16(Bt[n][k], At[m][k], acc[ai][bj][m][n], 0, 0, 0); __builtin_amdgcn_s_setprio(0); } while (0)
#define PG8_WAIT_V(n) asm volatile("s_waitcnt vmcnt(" #n ")" ::: "memory")
#define PG8_WAIT_L(n) asm volatile("s_waitcnt lgkmcnt(" #n ")" ::: "memory")
#define PG8_BAR __builtin_amdgcn_s_barrier()
#define PG8_SCHED __builtin_amdgcn_sched_barrier(0)
    Unit cur, nxt; int ui = 0;
    if (!S.next(0, cur)) return;
    f32x4 acc[2][2][4][2];
#pragma unroll
    for (int a = 0; a < 2; ++a)
#pragma unroll
        for (int b = 0; b < 2; ++b)
#pragma unroll
            for (int m = 0; m < 4; ++m)
#pragma unroll
                for (int n = 0; n < 2; ++n) acc[a][b][m][n] = (f32x4){0.f, 0.f, 0.f, 0.f};
    bf16x8 At[4][2], B0[2][2], B1[2][2];
    const char* cA = (const char*)g.A + (size_t)cur.pm * tstep; const char* cB = (const char*)g.Bt + (size_t)cur.pn * tstep;
    S.a_ready(cur);
    PG8_STAGE(PG8_SB(0, 0), cB, voffB); PG8_STAGE(PG8_SA(0, 0), cA, voffA); PG8_STAGE(PG8_SB(0, 1), cB + hstep, voffB); PG8_STAGE(PG8_SA(0, 1), cA + hstep, voffA);
    if (wr == 1) PG8_BAR;
    PG8_WAIT_V(4); PG8_BAR;
    PG8_STAGE(PG8_SB(1, 0), cB + kstep, voffB); PG8_STAGE(PG8_SA(1, 0), cA + kstep, voffA); PG8_STAGE(PG8_SB(1, 1), cB + hstep + kstep, voffB);
    PG8_WAIT_V(6); PG8_BAR;
    PG8_STAMP();
    for (;;) {
        const bool has_next = S.next(ui + 1, nxt);
        const char* nA = has_next ? (const char*)g.A + (size_t)nxt.pm * tstep : cA; const char* nB = has_next ? (const char*)g.Bt + (size_t)nxt.pn * tstep : cB;
        for (int t = 0; t < nt; t += 2) {
            const bool last = (t == nt - 2);
            const char* a1 = cA + (size_t)(t + 1) * kstep;
            const char* a2 = last ? nA : cA + (size_t)(t + 2) * kstep; const char* b2 = last ? nB : cB + (size_t)(t + 2) * kstep;
            const char* a3 = a2 + kstep; const char* b3 = b2 + kstep;
            if (last && has_next) S.a_ready(nxt);
            PG8_LDB(B0, 0, 0); PG8_SCHED; PG8_LDA(At, 0, 0); PG8_STAGE(PG8_SA(1, 1), a1 + hstep, voffA);
            PG8_WAIT_L(8); PG8_BAR; PG8_WAIT_L(0); PG8_MMA(0, 0, At, B0); PG8_BAR; PG8_SCHED;
            PG8_LDB(B1, 0, 1); PG8_STAGE(PG8_SB(0, 0), b2, voffB);
            PG8_BAR; PG8_WAIT_L(0); PG8_MMA(0, 1, At, B1); PG8_BAR;
            PG8_LDA(At, 0, 1); PG8_STAGE(PG8_SA(0, 0), a2, voffA);
            PG8_BAR; PG8_WAIT_L(0); PG8_MMA(1, 0, At, B0); PG8_BAR; PG8_SCHED;
            PG8_STAGE(PG8_SB(0, 1), b2 + hstep, voffB);
            PG8_WAIT_V(6); PG8_BAR; PG8_MMA(1, 1, At, B1); PG8_BAR;
            PG8_LDB(B0, 1, 0); PG8_SCHED; PG8_LDA(At, 1, 0); PG8_STAGE(PG8_SA(0, 1), a2 + hstep, voffA);
            PG8_WAIT_L(8); PG8_BAR; PG8_WAIT_L(0); PG8_MMA(0, 0, At, B0); PG8_BAR; PG8_SCHED;
            PG8_LDB(B1, 1, 1); PG8_STAGE(PG8_SB(1, 0), b3, voffB);
            PG8_BAR; PG8_WAIT_L(0); PG8_MMA(0, 1, At, B1); PG8_BAR;
            PG8_LDA(At, 1, 1); PG8_STAGE(PG8_SA(1, 0), a3, voffA);
            PG8_BAR; PG8_WAIT_L(0); PG8_MMA(1, 0, At, B0); PG8_BAR; PG8_SCHED;
            PG8_STAGE(PG8_SB(1, 1), b3 + hstep, voffB);
            PG8_WAIT_V(6); PG8_BAR; PG8_MMA(1, 1, At, B1); PG8_BAR;
        }
        PG8_STAMP();
        if constexpr (!Epi::AFTER_DRAIN) { E(acc, cur, wr, wc, fr, fq); S.done(cur); }
        PG8_STAMP();
        if (!has_next) break;
#pragma unroll
        for (int a = 0; a < 2; ++a)
#pragma unroll
            for (int b = 0; b < 2; ++b)
#pragma unroll
                for (int m = 0; m < 4; ++m)
#pragma unroll
                    for (int n = 0; n < 2; ++n) acc[a][b][m][n] = (f32x4){0.f, 0.f, 0.f, 0.f};
        cur = nxt; cA = nA; cB = nB; ++ui;
    }
    PG8_WAIT_V(0);
    if (wr == 0) PG8_BAR;
    PG8_BAR;
    if constexpr (Epi::AFTER_DRAIN) { E.fused(acc, cur, wr, wc, fr, fq, lds, wid, lane); S.done(cur); }
    PG8_STAMP();
    if (STAMP && wid == 0) { stamps[lane] = lane < nts ? (((unsigned long long)(unsigned)ts_hi << 32) | (unsigned)ts_lo) : 0ull;
        if (lane == 62) stamps[62] = rt_entry; if (lane == 63) stamps[63] = (unsigned long long)wall_clock64(); }
#undef PG8_STAMP
#undef PG8_SA
#undef PG8_SB
#undef PG8_STAGE
#undef PG8_LDA
#undef PG8_LDB
#undef PG8_MMA
#undef PG8_WAIT_V
#undef PG8_WAIT_L
#undef PG8_BAR
#undef PG8_SCHED
}
}

#define LAS __attribute__((address_space(3)))
#define XB_TMO      128
#define XB_XCNT(j)  (256  + 64 * (j))
#define XB_XSUB(j)  (1280 + 64 * (j))
#define XB_XGEN(j)  (2304 + 64 * (j))
#define XB_TOP      3328
#define XB_TOPGEN   3392
#define XCD_BAR_WORDS 3456
#define XB_SPIN_CAP (1u << 24)

__device__ __forceinline__ unsigned xb_ld(unsigned* p)              { return __hip_atomic_load(p, __ATOMIC_RELAXED, __HIP_MEMORY_SCOPE_AGENT); }
__device__ __forceinline__ unsigned xb_add(unsigned* p, unsigned v) { return __hip_atomic_fetch_add(p, v, __ATOMIC_RELAXED, __HIP_MEMORY_SCOPE_AGENT); }
__device__ __forceinline__ unsigned xb_xcc_id() { return (unsigned)__builtin_amdgcn_s_getreg((3 << 11) | 20) & 0xFu; }
#define XB_SPIN(cond, bar) do { unsigned _sp = 0; while (cond) { __builtin_amdgcn_s_sleep(1); \
    if ((++_sp & 255u) == 0u) { if (xb_ld(&(bar)[XB_TMO])) break; if (_sp > XB_SPIN_CAP) { atomicAdd(&(bar)[XB_TMO], 1u); break; } } } } while (0)

struct XcdBarrier {
    unsigned* bar; unsigned x;
    volatile LAS unsigned* st;
};

__device__ __forceinline__ XcdBarrier xcd_barrier_post(unsigned* bar, volatile LAS unsigned* st) {
    XcdBarrier b; b.bar = bar; b.x = xb_xcc_id(); b.st = st;
    if (threadIdx.x == 0) (void)xb_add(&bar[XB_XCNT(b.x)], 1u);
    return b;
}
__device__ __forceinline__ void xcd_barrier_complete(unsigned* bar, unsigned x, unsigned& nloc, unsigned& nx) {
    const unsigned G = gridDim.x * gridDim.y * gridDim.z;
    unsigned sum, cnt, mine, sp = 0u;
    for (;;) {
        sum = 0u; cnt = 0u; mine = 0u;
#pragma unroll
        for (unsigned j = 0; j < 16; ++j) { const unsigned c = xb_ld(&bar[XB_XCNT(j)]); sum += c; cnt += (c > 0u) ? 1u : 0u; mine = (j == x) ? c : mine; }
        if (sum == G) break;
        __builtin_amdgcn_s_sleep(1);
        if ((++sp & 255u) == 0u) { if (xb_ld(&bar[XB_TMO])) break; if (sp > XB_SPIN_CAP) { atomicAdd(&bar[XB_TMO], 1u); break; } }
    }
    nloc = mine > 0u ? mine : 1u; nx = cnt > 0u ? cnt : 1u;
}

__device__ __forceinline__ void xcd_barrier(const XcdBarrier& b) {
    asm volatile("s_waitcnt vmcnt(0)" ::: "memory");
    __syncthreads();
    if (threadIdx.x == 0) {
        unsigned* bar = b.bar;
        __builtin_amdgcn_s_waitcnt(0);
        unsigned nloc = b.st[0], nx = b.st[1];
        if (nloc == 0u) { xcd_barrier_complete(bar, b.x, nloc, nx); b.st[0] = nloc; b.st[1] = nx; }
        const unsigned old = xb_add(&bar[XB_XSUB(b.x)], 1u);
        const unsigned gen = old / nloc;
        if (old + 1u == (gen + 1u) * nloc) {
            __builtin_amdgcn_fence(__ATOMIC_RELEASE, "agent");
            asm volatile("s_waitcnt vmcnt(0)" ::: "memory");
            const unsigned og = xb_add(&bar[XB_TOP], 1u);
            const unsigned tg = og / nx;
            if (og + 1u == (tg + 1u) * nx) xb_add(&bar[XB_TOPGEN], 1u);
            else XB_SPIN(xb_ld(&bar[XB_TOPGEN]) == tg, bar);
            __builtin_amdgcn_fence(__ATOMIC_ACQUIRE, "agent");
            xb_add(&bar[XB_XGEN(b.x)], 1u);
            asm volatile("s_waitcnt vmcnt(0)" ::: "memory");
        } else {
            XB_SPIN(xb_ld(&bar[XB_XGEN(b.x)]) == gen, bar);
            __builtin_amdgcn_fence(__ATOMIC_ACQUIRE, "agent");
            asm volatile("s_waitcnt vmcnt(0)" ::: "memory");
        }
    }
    __syncthreads();
}

namespace pg8 {
struct MoeOrder {
    const int* tile_e; int ntiles, G, c;
    __device__ __forceinline__ bool next(int i, Unit& u) const { const long L = (long)i * G + c; if (L >= (long)ntiles * 8) return false; u.pm = (int)(L >> 3); u.pn = tile_e[u.pm] * 8 + (int)(L & 7); return true; }
    __device__ __forceinline__ void a_ready(const Unit&) const {}
    __device__ __forceinline__ void done(const Unit&) const {}
};
struct EpiU {
    static constexpr bool PERM = true, AFTER_DRAIN = false;
    bf16_t* O; int ldc;
    __device__ __forceinline__ void operator()(const f32x4 (&acc)[2][2][4][2], const Unit& u, int wr, int wc, int fr, int fq) const {
        const int row0 = u.pm * BM + wr * 64 + fr, col0 = u.pn * BM + wc * 32 + 8 * fq;
#pragma unroll
        for (int ai = 0; ai < 2; ++ai)
#pragma unroll
            for (int m = 0; m < 4; ++m) { bf16_t* rowp = O + (size_t)(row0 + ai * HALF + m * 16) * ldc + col0;
#pragma unroll
                for (int bj = 0; bj < 2; ++bj) { const f32x4 v0 = acc[ai][bj][m][0], v1 = acc[ai][bj][m][1];
                    u32x4 w; w.x = cvt_pk_bf16(v0[0], v0[1]); w.y = cvt_pk_bf16(v0[2], v0[3]); w.z = cvt_pk_bf16(v1[0], v1[1]); w.w = cvt_pk_bf16(v1[2], v1[3]);
                    *(u32x4*)(rowp + bj * HALF) = w; } }
    }
};
struct EpiRes {
    static constexpr bool PERM = false, AFTER_DRAIN = false;
    float* X; const float* gate;
    __device__ __forceinline__ void operator()(const f32x4 (&acc)[2][2][4][2], const Unit& u, int wr, int wc, int fr, int fq) const {
        const int row0 = u.pm * BM + wr * 64 + fr, col0 = u.pn * BM + wc * 32 + 4 * fq;
#pragma unroll
        for (int ai = 0; ai < 2; ++ai)
#pragma unroll
            for (int m = 0; m < 4; ++m) { const int row = row0 + ai * HALF + m * 16; float* rowp = X + (size_t)row * D + col0; const float* gp = gate + (size_t)mod_row(row) * 12288 + col0;
#pragma unroll
                for (int bj = 0; bj < 2; ++bj)
#pragma unroll
                    for (int n = 0; n < 2; ++n) { const f32x4 gv = *(const f32x4*)(gp + bj * HALF + n * 16); f32x4* xp = (f32x4*)(rowp + bj * HALF + n * 16); *xp = *xp + gv * acc[ai][bj][m][n]; } }
    }
};
struct EpiAct {
    static constexpr bool PERM = true, AFTER_DRAIN = false;
    bf16_t* O; const float* bgu;
    __device__ __forceinline__ void operator()(const f32x4 (&acc)[2][2][4][2], const Unit& u, int wr, int wc, int fr, int fq) const {
        const int e = u.pn >> 3, pnl = u.pn & 7; const int row0 = u.pm * BM + wr * 64 + fr, j0 = wc * 32 + 8 * fq;
        const float* bg = bgu + (size_t)e * 2048 + pnl * 128 + j0;
        f32x4 bglu[2], blin[2];
#pragma unroll
        for (int n = 0; n < 2; ++n) { bglu[n] = *(const f32x4*)(bg + 4 * n); blin[n] = *(const f32x4*)(bg + 1024 + 4 * n); }
#pragma unroll
        for (int ai = 0; ai < 2; ++ai)
#pragma unroll
            for (int m = 0; m < 4; ++m) { bf16_t* rowp = O + (size_t)(row0 + ai * HALF + m * 16) * FE + pnl * 128 + j0;
                float r[8];
#pragma unroll
                for (int n = 0; n < 2; ++n)
#pragma unroll
                    for (int q = 0; q < 4; ++q) { float glu = acc[ai][0][m][n][q] + bglu[n][q], lin = acc[ai][1][m][n][q] + blin[n][q];
                        glu = fminf(glu, 7.0f); lin = fminf(fmaxf(lin, -7.0f), 7.0f);
                        r[n * 4 + q] = glu * (1.0f / (1.0f + __expf(-1.702f * glu))) * (lin + 1.0f); }
                u32x4 w; w.x = cvt_pk_bf16(r[0], r[1]); w.y = cvt_pk_bf16(r[2], r[3]); w.z = cvt_pk_bf16(r[4], r[5]); w.w = cvt_pk_bf16(r[6], r[7]);
                *(u32x4*)rowp = w; }
    }
};
struct EpiDown {
    static constexpr bool PERM = false, AFTER_DRAIN = false;
    float* O; const float* bdn; const float* prob;
    __device__ __forceinline__ void operator()(const f32x4 (&acc)[2][2][4][2], const Unit& u, int wr, int wc, int fr, int fq) const {
        const int e = u.pn >> 3, pnl = u.pn & 7; const int row0 = u.pm * BM + wr * 64 + fr, col0 = pnl * BM + wc * 32 + 4 * fq;
        f32x4 bv[2][2];
#pragma unroll
        for (int bj = 0; bj < 2; ++bj)
#pragma unroll
            for (int n = 0; n < 2; ++n) bv[bj][n] = *(const f32x4*)(bdn + (size_t)e * D + col0 + bj * HALF + n * 16);
#pragma unroll
        for (int ai = 0; ai < 2; ++ai)
#pragma unroll
            for (int m = 0; m < 4; ++m) { const int row = row0 + ai * HALF + m * 16; float* rowp = O + (size_t)row * D + col0; const float pr = prob[row];
#pragma unroll
                for (int bj = 0; bj < 2; ++bj)
#pragma unroll
                    for (int n = 0; n < 2; ++n) *(f32x4*)(rowp + bj * HALF + n * 16) = (acc[ai][bj][m][n] + bv[bj][n]) * pr; }
    }
};
}

constexpr int NTHREADS = 512;
constexpr int LDS_STAGE = 131072, LDS_MISC = LDS_STAGE, LDS_BYTES = LDS_STAGE + 256;
typedef void (*stage_fn)(PREF, int, long);
template <stage_fn F> __device__ __noinline__ void run_stage(PREF p, int l, long n) {
    for (long g = (long)blockIdx.x * NTHREADS + threadIdx.x; g < n; g += (long)gridDim.x * NTHREADS) F(p, l, g);
}
constexpr int PRO_PH = 7, LAYER_PH = 35, FIN_PH = 2, NPHASES = PRO_PH + DEPTH * LAYER_PH + FIN_PH;

__global__ void __launch_bounds__(NTHREADS, 2) fwd_kernel(P p_arg) {
    const __attribute__((address_space(4))) P* kp = (const __attribute__((address_space(4))) P*)__builtin_amdgcn_kernarg_segment_ptr();
    extern __shared__ __attribute__((aligned(16))) unsigned char lds[];
    LAS unsigned char* L = (LAS unsigned char*)lds;
    volatile LAS unsigned* misc = (volatile LAS unsigned*)(L + LDS_MISC);
    if (threadIdx.x < 64) misc[threadIdx.x] = 0u;
    __syncthreads();
    XcdBarrier bar = xcd_barrier_post((unsigned*)(kp->ws + O_CTL) + CW_BAR, misc);
    int ph = 0; const int lo = kp->lo, hi = kp->hi;
#define PHASE_BEGIN if (ph >= lo && ph < hi) { asm volatile("" : "+s"(kp)); PREF p = *kp;
#define PHASE_END if (ph + 1 < hi) xcd_barrier(bar); } ++ph;
#define STAGE(fn, l, n) run_stage<fn>(p, l, n)
    PHASE_BEGIN STAGE(st_copy_x, 0, N_copy_x); STAGE(st_ada_part, 0, N_ada_part); STAGE(st_cvt_win, 0, N_cvt_win); STAGE(st_cvt_wout, 0, N_cvt_wout); STAGE(st_cvt_wgu, 0, N_cvt_wgu); STAGE(st_cvt_wdn, 0, N_cvt_wdn); STAGE(st_hy_h1, 0, N_hy_h); PHASE_END
    PHASE_BEGIN STAGE(st_ada_red, 0, N_ada_red); STAGE(st_hy_h2, 0, N_hy_h); PHASE_END
    PHASE_BEGIN STAGE(st_hy_h3, 0, N_hy_h); PHASE_END
    PHASE_BEGIN STAGE(st_hy_raw, 0, N_hy_raw); PHASE_END
    PHASE_BEGIN STAGE(st_hy_nrm, 0, N_hy_nrm); PHASE_END
    PHASE_BEGIN STAGE(st_hy_scale, 0, N_hy_raw); PHASE_END
    PHASE_BEGIN STAGE(st_rowss, 0, T); PHASE_END
    for (int l = 0; l < DEPTH; ++l) {
        PHASE_BEGIN STAGE(st_mod1, l, (long)T * D); PHASE_END
        PHASE_BEGIN { pg8::Gemm g{WSH(O_A1), WSH(O_WIN) + (size_t)l * DIN * D, T, DIN, D}; pg8::StaticOrder S; S.init(T, DIN, (int)gridDim.x, (int)blockIdx.x);
            pg8::EpiU E{WSH(O_U), DIN}; pg8::gemm_phase<pg8::EpiU, pg8::StaticOrder, false>(L, g, S, E, nullptr); } PHASE_END
        PHASE_BEGIN STAGE(st_hy_short, l, N_hy_short); STAGE(st_rg_conv, l, N_dmc); STAGE(st_rw_lh, l, N_rw_lh); STAGE(st_rt_prep, l, N_mc); PHASE_END
        PHASE_BEGIN STAGE(st_hy_conv0, l, N_hy_conv); STAGE(st_rg_gate, l, N_dmc); STAGE(st_rw_vg, l, N_mc); STAGE(st_rt_score, l, N_rt_score); STAGE(st_rt_kv, l, N_rt_kv); PHASE_END
        PHASE_BEGIN STAGE(st_hy_conv1, l, N_hy_conv); STAGE(st_rg_scan, l, N_rg_scan); STAGE(st_rw_lhw, l, N_rw_lhw); STAGE(st_rt_state, l, N_rt_state); PHASE_END
        PHASE_BEGIN STAGE(st_rg_out, l, N_mc); STAGE(st_rw_tok, l, N_dmc); STAGE(st_rt_out, l, N_mc); PHASE_END
        PHASE_BEGIN STAGE(st_rw_kk, l, N_dmc); STAGE(st_rt_fin, l, N_mc); PHASE_END
        PHASE_BEGIN STAGE(st_rw_scan, l, N_rw_scan); PHASE_END
        PHASE_BEGIN STAGE(st_rw_out, l, N_mc); PHASE_END
        PHASE_BEGIN { const int M = l == DEPTH - 1 ? TL : T; pg8::Gemm g{WSH(O_CAT), WSH(O_WOUT) + (size_t)l * D * D, M, D, D}; pg8::StaticOrder S; S.init(M, D, (int)gridDim.x, (int)blockIdx.x);
            pg8::EpiRes E{WSF(O_X), modp(p, l, 0, 2)}; pg8::gemm_phase<pg8::EpiRes, pg8::StaticOrder, false>(L, g, S, E, nullptr); } PHASE_END
        PHASE_BEGIN STAGE(st_rowss, l, T); PHASE_END
        PHASE_BEGIN STAGE(st_mod2, l, (long)T * D); STAGE(st_moe_logit, l, N_moe_logit); PHASE_END
        PHASE_BEGIN STAGE(st_moe_topk, l, N_moe_topk); PHASE_END
        PHASE_BEGIN STAGE(st_moe_slots, l, N_moe_slots); PHASE_END
        PHASE_BEGIN STAGE(st_moe_gather, l, N_moe_gather); PHASE_END
        PHASE_BEGIN { pg8::Gemm g{WSH(O_AG), WSH(O_WGU) + (size_t)l * NE * 2048 * D, MAXSLOT, NE * 2048, D}; pg8::MoeOrder S{WSI(O_TILEE), WSI(O_TILEE)[MAXTILES], (int)gridDim.x, (int)blockIdx.x};
            pg8::EpiAct E{WSH(O_ACT), p.in[I_moe_b_gu] + (size_t)l * NE * 2048}; pg8::gemm_phase<pg8::EpiAct, pg8::MoeOrder, false>(L, g, S, E, nullptr); } PHASE_END
        PHASE_BEGIN { pg8::Gemm g{WSH(O_ACT), WSH(O_WDN) + (size_t)l * NE * D * FE, MAXSLOT, NE * D, FE}; pg8::MoeOrder S{WSI(O_TILEE), WSI(O_TILEE)[MAXTILES], (int)gridDim.x, (int)blockIdx.x};
            pg8::EpiDown E{WSF(O_OSLOT), p.in[I_moe_b_dn] + (size_t)l * NE * D, WSF(O_SLOTP)}; pg8::gemm_phase<pg8::EpiDown, pg8::MoeOrder, false>(L, g, S, E, nullptr); } PHASE_END
        PHASE_BEGIN STAGE(st_moe_comb, l, (long)T * D); PHASE_END
        PHASE_BEGIN STAGE(st_rowss, l, T); PHASE_END
    }
    PHASE_BEGIN STAGE(st_final, 0, (long)TL * D); PHASE_END
#undef PHASE_BEGIN
#undef PHASE_END
#undef STAGE
}

#ifndef MK_ONE_LAUNCH
#define MK_ONE_LAUNCH 1
#endif
extern "C" void kernel_launch(void* const* d_in, const int* in_sizes, int n_in, void* d_out, int out_size, void* d_ws, size_t ws_size, hipStream_t stream) {
    static int grid = 0;
    if (grid == 0) {
        if (n_in != N_IN || out_size != TL * D || ws_size < WS_END) { fprintf(stderr, "kernel_launch: unexpected shapes (n_in %d, out %d, ws %zu < %zu)\n", n_in, out_size, ws_size, (size_t)WS_END); grid = -1; return; }
        int dev = 0, cus = 0, per_cu = 0;
        if (hipGetDevice(&dev) != hipSuccess || hipDeviceGetAttribute(&cus, hipDeviceAttributeMultiprocessorCount, dev) != hipSuccess) { grid = -1; return; }
        if (hipFuncSetAttribute((const void*)fwd_kernel, hipFuncAttributeMaxDynamicSharedMemorySize, LDS_BYTES) != hipSuccess) { fprintf(stderr, "kernel_launch: hipFuncSetAttribute failed\n"); grid = -1; return; }
        if (hipOccupancyMaxActiveBlocksPerMultiprocessor(&per_cu, (const void*)fwd_kernel, NTHREADS, LDS_BYTES) != hipSuccess || per_cu < 1) fprintf(stderr, "kernel_launch: occupancy query says %d\n", per_cu);
        (void)hipGetLastError();
        grid = cus;
    }
    if (grid < 0) return;
    (void)hipMemsetAsync((char*)d_ws + O_CTL, 0, CTL_BYTES, stream);
    P p{};
    for (int i = 0; i < N_IN; ++i) p.in[i] = (const float*)d_in[i];
    p.out = (float*)d_out; p.ws = (unsigned char*)d_ws;
#if MK_ONE_LAUNCH
    p.lo = 0; p.hi = NPHASES;
    hipLaunchKernelGGL(fwd_kernel, dim3(grid), dim3(NTHREADS), LDS_BYTES, stream, p);
#else
    for (int k = 0; k < NPHASES; ++k) { p.lo = k; p.hi = k + 1; hipLaunchKernelGGL(fwd_kernel, dim3(grid), dim3(NTHREADS), LDS_BYTES, stream, p); }
#endif
    const hipError_t le = hipPeekAtLastError();
    if (le != hipSuccess) fprintf(stderr, "kernel_launch: launch failed: %s\n", hipGetErrorName(le));
}
#endif
```

```cpp
#ifdef CPU_TEST
#include <cmath>
#include <cstdio>
#include <cstdlib>
#include <cstring>
#include <cstdint>
#include <vector>
#define DEV static inline
struct float4 { float x, y, z, w; };
struct uint4 { unsigned x, y, z, w; };
#else
#include <hip/hip_runtime.h>
#include <cstdio>
#include <cstdint>
#define DEV __device__ __forceinline__
#define DEV_GPU __device__ __forceinline__
#endif

#ifndef NB
#define NB 4
#endif
#ifndef SEQ
#define SEQ 4096
#endif
#ifndef CTX
#define CTX 256
#endif
constexpr int D = 2048, G = 512, DIN = 13 * G, NMOD = 6, DEPTH = 2;
constexpr int TL = NB * SEQ, TC = NB * CTX, T = TL + TC, SCANL = CTX + SEQ;
constexpr int NE = 32, TOPK = 4, FE = 1024;
constexpr int RTC = 128, NCHUNK = T / RTC, NCH_C = CTX / RTC, NCH_L = SEQ / RTC;
constexpr int MAXTILES = (T * TOPK) / 256 + NE, MAXSLOT = MAXTILES * 256;
constexpr int U_HY = 0, U_RG = 3 * G, U_RW = 5 * G, U_RT = 9 * G;
constexpr int ADA_KS = 8;
static_assert(TL % 256 == 0 && TC % 256 == 0 && SEQ % 128 == 0 && CTX % 128 == 0, "tile shapes");

enum { I_x, I_c, I_ctx, I_c_ctx, I_ada_w, I_ada_b, I_norm1_w, I_norm2_w, I_w_in, I_w_out, I_hy_short_w, I_hy_short_b, I_hy_f_w1, I_hy_f_b1, I_hy_f_w2, I_hy_f_b2,
       I_hy_f_w3, I_hy_f_b3, I_hy_f_w4, I_hy_f_freq, I_hy_bias, I_rg_conv_w, I_rg_conv_b, I_rg_wa, I_rg_ba, I_rg_wx, I_rg_bx, I_rg_lambda, I_rw_mu, I_rw_w0, I_rw_w1,
       I_rw_w2, I_rw_a0, I_rw_a1, I_rw_a2, I_rw_g1, I_rw_g2, I_rw_k_k, I_rw_k_a, I_rw_r_k, I_rw_ln_w, I_rw_ln_b, I_rw_v0, I_rw_v1, I_rw_v2, I_rt_decay, I_rt_gn_w,
       I_moe_router_w, I_moe_router_b, I_moe_w_gu, I_moe_b_gu, I_moe_w_dn, I_moe_b_dn, I_final_norm_w, N_IN };

constexpr size_t al256(size_t x) { return (x + 255) & ~(size_t)255; }
constexpr size_t O_CTL = 0;
constexpr size_t CTL_BYTES = 1u << 20;
constexpr size_t O_MODS = CTL_BYTES;
constexpr size_t O_ADAP = O_MODS + al256((size_t)2 * (NB + 1) * 12288 * 4);
constexpr size_t O_X = O_ADAP + al256((size_t)ADA_KS * 2 * (NB + 1) * 12288 * 4);
constexpr size_t O_A1 = O_X + al256((size_t)T * D * 4);
constexpr size_t O_U = O_A1 + al256((size_t)T * D * 2);
constexpr size_t O_CAT = O_U + al256((size_t)T * DIN * 2);
constexpr size_t O_WIN = O_CAT + al256((size_t)T * D * 2);
constexpr size_t O_WOUT = O_WIN + al256((size_t)2 * DIN * D * 2);
constexpr size_t O_WGU = O_WOUT + al256((size_t)2 * D * D * 2);
constexpr size_t O_WDN = O_WGU + al256((size_t)2 * NE * 2048 * 2048 * 2);
constexpr size_t O_HYA = O_WDN + al256((size_t)2 * NE * 2048 * 1024 * 2);
constexpr size_t O_HYB = O_HYA + al256((size_t)3 * SEQ * 64 * 4);
constexpr size_t O_HYAB = O_HYB + al256((size_t)3 * SEQ * 64 * 4);
constexpr size_t O_W4T = O_HYAB + al256((size_t)3 * SEQ * 64 * 2);
constexpr size_t O_TAPS = O_W4T + al256((size_t)2 * 2048 * 64 * 2);
constexpr size_t O_TAPSC = O_TAPS + al256((size_t)3 * SEQ * 2048 * 4);
constexpr size_t O_NRM = O_TAPSC + al256((size_t)CTX * 2048 * 4);
constexpr size_t O_NRMP = O_NRM + al256((size_t)3 * 2 * 512 * 4);
constexpr size_t O_ROWSS = O_NRMP + al256((size_t)3 * 64 * 1024 * 4);
constexpr size_t O_VFIRST = O_ROWSS + al256((size_t)T * 4);
constexpr size_t O_LOGITS = O_VFIRST + al256((size_t)T * G * 4);
constexpr size_t O_TOPE = O_LOGITS + al256((size_t)T * NE * 4);
constexpr size_t O_TOPP = O_TOPE + al256((size_t)T * 4 * 4);
constexpr size_t O_TOPPOS = O_TOPP + al256((size_t)T * 4 * 4);
constexpr size_t O_TOKSLOT = O_TOPPOS + al256((size_t)T * 4 * 4);
constexpr size_t O_SLOTTOK = O_TOKSLOT + al256((size_t)T * 4 * 4);
constexpr size_t O_SLOTP = O_SLOTTOK + al256((size_t)MAXSLOT * 4);
constexpr size_t O_TILEE = O_SLOTP + al256((size_t)MAXSLOT * 4);
constexpr size_t O_RWA = O_TILEE + al256((size_t)(MAXTILES + 64) * 4);
constexpr size_t O_RCB = O_RWA + al256((size_t)2 * (NB + 1) * D * NE * 4);
constexpr size_t O_MODA = O_RCB + al256((size_t)2 * (NB + 1) * NE * 4);
constexpr size_t O_MODB = O_MODA + al256((size_t)2 * (NB + 1) * D * 4);
constexpr size_t O_RWAT = O_MODB + al256((size_t)2 * (NB + 1) * D * 4);
constexpr size_t O_LW1T = O_RWAT + al256((size_t)2 * (NB + 1) * 2 * NE * D * 2);
constexpr size_t O_LG2T = O_LW1T + al256((size_t)2 * 160 * 512 * 2);
constexpr size_t O_LV2T = O_LG2T + al256((size_t)2 * 512 * 128 * 2);
constexpr size_t O_LWA1T = O_LV2T + al256((size_t)2 * 512 * 32 * 2);
constexpr size_t O_LW2T = O_LWA1T + al256((size_t)8 * 128 * 512 * 2);
constexpr size_t O_LA2T = O_LW2T + al256((size_t)4 * 512 * 64 * 2);
constexpr size_t O_TRB = O_LA2T + al256((size_t)4 * 512 * 64 * 2);
constexpr size_t O_SCR = O_TRB + al256((size_t)2 * 2 * 512 * 8192 * 2);
constexpr size_t SZ_TG = al256((size_t)T * G * 4), SZ_2TG = al256((size_t)2 * T * G * 4);
constexpr size_t O_HYU = O_SCR;
constexpr size_t O_HZ1 = O_HYU + al256((size_t)T * 1536 * 4);
constexpr size_t O_RGXC = O_HZ1 + SZ_TG;
constexpr size_t O_RGA = O_RGXC + SZ_2TG, O_RGB = O_RGA + SZ_2TG, O_RGH = O_RGB + SZ_2TG;
constexpr size_t O_RWV = O_RGH + SZ_2TG, O_RWG = O_RWV + SZ_TG;
constexpr size_t O_LH = O_RWG + SZ_TG;
constexpr size_t O_LHW = O_LH + al256((size_t)T * 160 * 4);
constexpr size_t O_SR = O_LHW + al256((size_t)2 * T * 128 * 4);
constexpr size_t O_SW = O_SR + SZ_2TG, O_SK = O_SW + SZ_2TG, O_SV = O_SK + SZ_2TG, O_SKKR = O_SV + SZ_2TG, O_SA = O_SKKR + SZ_2TG, O_SKK = O_SA + SZ_2TG,
                 O_SKKA = O_SKK + SZ_2TG, O_SY = O_SKKA + SZ_2TG;
constexpr size_t O_RQ = O_SY + SZ_2TG, O_RK = O_RQ + SZ_TG;
constexpr size_t O_SC = O_RK + SZ_TG;
constexpr size_t SZ_SC = al256((size_t)NCHUNK * 4 * 128 * 128 * 4);
constexpr size_t O_KV = O_SC + SZ_SC, O_SPREV = O_KV + 2 * SZ_SC;
constexpr size_t O_RO = O_SPREV + 2 * SZ_SC;
constexpr size_t O_ZT = O_RO + SZ_TG;
constexpr size_t O_RWEND0 = O_ZT + al256((size_t)3 * NB * 512 * SEQ * 2);
constexpr int RWC = 16, NCK = (CTX + SEQ) / RWC, NCHAIN = 2 * NB * 8, NTASK = NCHAIN * NCK;
constexpr size_t O_CAAT = O_RWEND0, O_CABH = O_CAAT + SZ_2TG, O_CAKH = O_CABH + SZ_2TG, O_CART = O_CAKH + SZ_2TG;
constexpr size_t O_CAGC = O_CART + SZ_2TG;
constexpr size_t SZ_T256 = al256((size_t)NTASK * 256 * 4);
constexpr size_t O_CANT = O_CAGC + al256((size_t)NTASK * 64 * 4), O_CAMT = O_CANT + SZ_T256, O_CAQK = O_CAMT + SZ_T256, O_CAQB = O_CAQK + SZ_T256, O_CATT = O_CAQB + SZ_T256;
constexpr size_t O_OW1 = O_CATT + SZ_T256;
constexpr size_t O_ORT = O_OW1 + al256((size_t)NTASK * 1024 * 2);
constexpr size_t O_OTM = O_ORT + al256((size_t)NTASK * 1024 * 2);
constexpr size_t O_OQKB = O_OTM + al256((size_t)NTASK * 512 * 2);
constexpr size_t O_OKB = O_OQKB + al256((size_t)NTASK * 512 * 2);
constexpr size_t O_OVT = O_OKB + al256((size_t)NTASK * 2048 * 2);
constexpr size_t O_RQB = O_OVT + al256((size_t)NTASK * 1024 * 2);
constexpr size_t O_H2 = O_RQB + al256((size_t)T * G * 2);
constexpr size_t O_MIXEND = O_H2 + al256((size_t)2 * T * 128 * 2);
constexpr size_t O_AG = O_SCR;
constexpr size_t O_ACT = O_AG + al256((size_t)MAXSLOT * D * 2);
constexpr size_t O_OSLOT = O_ACT + al256((size_t)MAXSLOT * FE * 2);
constexpr size_t O_MOEEND = O_OSLOT + al256((size_t)MAXSLOT * D * 4);
constexpr size_t WS_END = O_MIXEND > O_MOEEND ? O_MIXEND : O_MOEEND;
constexpr int CW_COUNTS = 8192, CW_CSTR = 64;
constexpr int CW_BAR = 4096;

struct P { const float* in[N_IN]; float* out; unsigned char* ws; int lo, hi; };
#ifdef CPU_TEST
#define PREF const P&
#else
#define PREF const __attribute__((address_space(4))) P&
#endif
#define WSF(off) ((float*)(p.ws + (off)))
#define WSI(off) ((int*)(p.ws + (off)))
#define WSH(off) ((unsigned short*)(p.ws + (off)))

DEV unsigned short f2bf(float f) { unsigned u; memcpy(&u, &f, 4); u += 0x7fffu + ((u >> 16) & 1u); return (unsigned short)(u >> 16); }
DEV float bf2f(unsigned short h) { unsigned u = ((unsigned)h) << 16; float f; memcpy(&f, &u, 4); return f; }
DEV float sigm(float x) { return 1.0f / (1.0f + expf(-x)); }
DEV float siluf(float x) { return x * sigm(x); }
DEV float softplusf(float x) { return fmaxf(x, 0.f) + log1pf(expf(-fabsf(x))); }
DEV float gelu_tanh(float x) { return 0.5f * x * (1.0f + tanhf(0.7978845608028654f * (x + 0.044715f * x * x * x))); }
DEV int tok_t(int m) { return m < TL ? m % SEQ : (m - TL) % CTX; }
DEV int tok_len(int m) { return m < TL ? SEQ : CTX; }
DEV int mod_row(int m) { return m < TL ? m / SEQ : NB; }
DEV int tok_prev(int m, int d, int k) { const int t = tok_t(m); if (d == 0) return t - k >= 0 ? m - k : -1; return t + k < tok_len(m) ? m + k : -1; }
DEV int scan_tok(int d, int b, int pp) { if (pp < CTX) { const int tc = d == 0 ? pp : CTX - 1 - pp; return TL + b * CTX + tc; } const int q = pp - CTX; return b * SEQ + (d == 0 ? q : SEQ - 1 - q); }
DEV float ldu(PREF p, int m, int col) { return bf2f(WSH(O_U)[(size_t)m * DIN + col]); }
DEV const float* modp(PREF p, int l, int row, int which) { return WSF(O_MODS) + ((size_t)(l * (NB + 1) + row) * NMOD + which) * D; }

DEV void st_copy_x(PREF p, int, long g) { const long n4 = (long)TL * D / 4; const float4* s = g < n4 ? (const float4*)p.in[I_x] + g : (const float4*)p.in[I_ctx] + (g - n4); ((float4*)WSF(O_X))[g] = *s; }
constexpr long N_copy_x = (long)T * D / 4;

DEV void st_ada_part(PREF p, int, long g) {
    const int c4 = (int)(g % 3072), ks = (int)((g / 3072) % ADA_KS), l = (int)(g / (3072 * ADA_KS));
    float acc[NB + 1][4];
#pragma unroll
    for (int r = 0; r <= NB; ++r) { acc[r][0] = acc[r][1] = acc[r][2] = acc[r][3] = 0.f; }
    const float* aw = p.in[I_ada_w] + (size_t)l * D * 12288;
    for (int k = ks * (D / ADA_KS); k < (ks + 1) * (D / ADA_KS); ++k) {
        const float4 w = *(const float4*)(aw + (size_t)k * 12288 + c4 * 4);
#pragma unroll
        for (int r = 0; r <= NB; ++r) { const float cv = siluf(r < NB ? p.in[I_c][r * D + k] : p.in[I_c_ctx][k]); acc[r][0] += cv * w.x; acc[r][1] += cv * w.y; acc[r][2] += cv * w.z; acc[r][3] += cv * w.w; }
    }
#pragma unroll
    for (int r = 0; r <= NB; ++r) { float4 o; o.x = acc[r][0]; o.y = acc[r][1]; o.z = acc[r][2]; o.w = acc[r][3];
        *(float4*)(WSF(O_ADAP) + ((size_t)(ks * 2 + l) * (NB + 1) + r) * 12288 + c4 * 4) = o; }
}
constexpr long N_ada_part = 2L * ADA_KS * 3072;
DEV void st_ada_red(PREF p, int, long g) {
    const int col = (int)(g % 12288), r = (int)((g / 12288) % (NB + 1)), l = (int)(g / (12288 * (NB + 1)));
    float s = p.in[I_ada_b][l * 12288 + col];
    for (int ks = 0; ks < ADA_KS; ++ks) s += WSF(O_ADAP)[((size_t)(ks * 2 + l) * (NB + 1) + r) * 12288 + col];
    WSF(O_MODS)[(size_t)(l * (NB + 1) + r) * 12288 + col] = s;
}
constexpr long N_ada_red = 2L * (NB + 1) * 12288;

DEV void cvt_one(const float* W, int K, int N, unsigned short* WT, long g, int permute_gu) {
    const int n = (int)(g % N), k8 = (int)(g / N);
    unsigned short o[8];
#pragma unroll
    for (int j = 0; j < 8; ++j) o[j] = f2bf(W[(size_t)(k8 * 8 + j) * N + n]);
    int nd = n;
    if (permute_gu) { const int bj = n / 1024, r = n % 1024, pn = r / 128, j = r % 128; nd = pn * 256 + bj * 128 + j; }
    uint4 v; memcpy(&v, o, 16);
    *(uint4*)(WT + (size_t)nd * K + k8 * 8) = v;
}
DEV void st_cvt_win(PREF p, int, long g) { const long per = (long)D / 8 * DIN; const int l = (int)(g / per); cvt_one(p.in[I_w_in] + (size_t)l * D * DIN, D, DIN, WSH(O_WIN) + (size_t)l * DIN * D, g % per, 0); }
constexpr long N_cvt_win = 2L * (D / 8) * DIN;
DEV void st_cvt_wout(PREF p, int, long g) { const long per = (long)D / 8 * D; const int l = (int)(g / per); cvt_one(p.in[I_w_out] + (size_t)l * D * D, D, D, WSH(O_WOUT) + (size_t)l * D * D, g % per, 0); }
constexpr long N_cvt_wout = 2L * (D / 8) * D;
DEV void st_cvt_wgu(PREF p, int, long g) { const long per = (long)D / 8 * 2048; const int le = (int)(g / per); cvt_one(p.in[I_moe_w_gu] + (size_t)le * D * 2048, D, 2048, WSH(O_WGU) + (size_t)le * 2048 * D, g % per, 1); }
constexpr long N_cvt_wgu = 2L * NE * (D / 8) * 2048;
DEV void st_cvt_wdn(PREF p, int, long g) { const long per = (long)FE / 8 * D; const int le = (int)(g / per); cvt_one(p.in[I_moe_w_dn] + (size_t)le * FE * D, FE, D, WSH(O_WDN) + (size_t)le * D * FE, g % per, 0); }
constexpr long N_cvt_wdn = 2L * NE * (FE / 8) * D;

DEV void st_rowss(PREF p, int, long g) { const float4* x = (const float4*)(WSF(O_X) + (size_t)g * D); float s = 0.f; for (int i = 0; i < D / 4; ++i) { const float4 v = x[i]; s += v.x * v.x + v.y * v.y + v.z * v.z + v.w * v.w; } WSF(O_ROWSS)[g] = s; }
DEV float modval(PREF p, int l, int m, int c, int which) {
    const float rinv = 1.0f / sqrtf(WSF(O_ROWSS)[m] * (1.0f / D) + 1e-6f);
    const float nw = (which == 0 ? p.in[I_norm1_w] : p.in[I_norm2_w])[l * D + c];
    const int r = mod_row(m);
    return WSF(O_X)[(size_t)m * D + c] * rinv * nw * (1.0f + modp(p, l, r, which + 1)[c]) + modp(p, l, r, which)[c];
}
DEV void st_mod1(PREF p, int l, long g) { const int m = (int)(g / D), c = (int)(g % D); WSH(O_A1)[g] = f2bf(modval(p, l, m, c, 0)); }
DEV void st_mod2(PREF p, int l, long g) { const int m = (int)(g / D), c = (int)(g % D); WSH(O_A1)[g] = f2bf(modval(p, l, m, c, 3)); }

DEV int hv_layer(int vi) { return vi == 1 ? 1 : 0; }
DEV int hv_len(int vi) { return vi == 2 ? CTX : SEQ; }
DEV void st_hy_h1(PREF p, int, long g) {
    const int j = (int)(g % 64), n = (int)((g / 64) % SEQ), vi = (int)(g / (64 * SEQ)); const int L = hv_len(vi), l = hv_layer(vi); if (n >= L) return;
    const float* w1 = p.in[I_hy_f_w1] + l * 33 * 64;
    const float t = (float)n / (float)(L - 1);
    float s = t * w1[j];
    for (int i = 0; i < 16; ++i) { const float fr = 1e-4f + (float)i * ((15.0f - 1e-4f) / 15.0f); const float ang = (6.283185307179586f / (float)L) * (float)n * fr;
        s += cosf(ang) * w1[(1 + i) * 64 + j] - sinf(ang) * w1[(17 + i) * 64 + j]; }
    WSF(O_HYA)[((size_t)vi * SEQ + n) * 64 + j] = sinf(p.in[I_hy_f_freq][l * 64 + j] * (s + p.in[I_hy_f_b1][l * 64 + j]));
}
DEV void hy_hidden(PREF p, long g, const float* src, float* dst, int wi, int bi) {
    const int j = (int)(g % 64), n = (int)((g / 64) % SEQ), vi = (int)(g / (64 * SEQ)); const int L = hv_len(vi), l = hv_layer(vi); if (n >= L) return;
    const float* w = p.in[wi] + l * 64 * 64; const float* h = src + ((size_t)vi * SEQ + n) * 64;
    float s = 0.f; for (int i = 0; i < 64; ++i) s += h[i] * w[i * 64 + j];
    dst[((size_t)vi * SEQ + n) * 64 + j] = sinf(p.in[I_hy_f_freq][l * 64 + j] * (s + p.in[bi][l * 64 + j]));
}
DEV void st_hy_h2(PREF p, int, long g) { hy_hidden(p, g, WSF(O_HYA), WSF(O_HYB), I_hy_f_w2, I_hy_f_b2); }
DEV void st_hy_h3(PREF p, int, long g) { hy_hidden(p, g, WSF(O_HYB), WSF(O_HYA), I_hy_f_w3, I_hy_f_b3); }
constexpr long N_hy_h = 3L * SEQ * 64;
DEV void st_hy_raw(PREF p, int, long g) {
    const int n = (int)(g % SEQ), cg = (int)((g / SEQ) % 32), vi = (int)(g / (32L * SEQ)); const int L = hv_len(vi), l = hv_layer(vi); if (n >= L) return;
    const float* w4 = p.in[I_hy_f_w4] + (size_t)l * 64 * 2048 + cg * 64; const float* hp = WSF(O_HYA) + ((size_t)vi * SEQ + n) * 64;
    float h[64];
#pragma unroll
    for (int i = 0; i < 64; ++i) h[i] = hp[i];
    const float t = (float)n / (float)(L - 1);
    const float dmin = -3.0701134573253944f, dmax = -15.350567286626973f;
    for (int cc = 0; cc < 64; ++cc) { const int col = cg * 64 + cc; float s = 0.f;
#pragma unroll
        for (int i = 0; i < 64; ++i) s += h[i] * w4[i * 2048 + cc];
        const float delta = fabsf(dmin + (float)(col % 512) * ((dmax - dmin) / 511.0f));
        WSF(O_TAPS)[((size_t)vi * 2048 + col) * SEQ + n] = s * expf(-t * delta); }
}
constexpr long N_hy_raw = 3L * SEQ * 2048, N_hy_raw_thr = 3L * 32 * SEQ;
constexpr int HNP = 64;
DEV void st_hy_nrm1(PREF p, int, long g) {
    const int part = (int)(g % HNP), c = (int)((g / HNP) % 512), o = (int)((g / (HNP * 512)) % 2), vi = (int)(g / (1024 * HNP)); const int L = hv_len(vi);
    const float* tf = WSF(O_TAPS) + ((size_t)vi * 2048 + o * 512 + c) * SEQ; const float* tb = tf + (size_t)1024 * SEQ; float s = 0.f; const int per = (L + HNP - 1) / HNP;
    for (int n = part * per; n < (part + 1) * per && n < L; ++n) { s += fabsf(tf[n]); if (n >= 1) s += fabsf(tb[n]); }
    WSF(O_NRMP)[((size_t)vi * HNP + part) * 1024 + o * 512 + c] = s;
}
constexpr long N_hy_nrm1 = 3L * HNP * 1024;
DEV void st_hy_nrm(PREF p, int, long g) {
    const int oc = (int)(g % 1024), vi = (int)(g / 1024); float s = 0.f;
    for (int part = 0; part < HNP; ++part) s += WSF(O_NRMP)[((size_t)vi * HNP + part) * 1024 + oc];
    WSF(O_NRM)[g] = s;
}
constexpr long N_hy_nrm = 3L * 2 * 512;
DEV void st_hy_scale(PREF p, int, long g) {
    const int n = (int)(g % SEQ), col = (int)((g / SEQ) % 2048), vi = 2; if (n >= hv_len(vi)) return;
    WSF(O_TAPSC)[(size_t)n * 2048 + col] = WSF(O_TAPS)[(size_t)vi * 2048 * SEQ + g] / WSF(O_NRM)[vi * 1024 + ((col / 512) % 2) * 512 + col % 512];
}

DEV void st_hy_trb(PREF p, int, long g) {
    const int y = (int)(g % 8192), c = (int)((g / 8192) % 512), o = (int)((g / (8192 * 512)) % 2), vi = (int)(g / (8192L * 512 * 2));
    const int e = 4095 - y; float v = 0.f;
    if (e >= 0 && e < SEQ) v = WSF(O_TAPS)[((size_t)vi * 2048 + o * 512 + c) * SEQ + e];
    else if (e < 0 && -e < SEQ) v = WSF(O_TAPS)[((size_t)vi * 2048 + 1024 + o * 512 + c) * SEQ + (-e)];
    WSH(O_TRB)[g] = f2bf(v / WSF(O_NRM)[vi * 1024 + o * 512 + c]);
}
constexpr long N_hy_trb = 2L * 2 * 512 * 8192;
DEV void st_hy_shortT(PREF p, int l, long g) {
    const int c = (int)(g % 512), t8 = (int)((g / 512) % (SEQ / 8)), b = (int)((g / (512 * (SEQ / 8))) % NB), sidx = (int)(g / (512L * (SEQ / 8) * NB));
    const int col = sidx * 512 + c; const float* sw = p.in[I_hy_short_w] + l * 3 * 1536; const float w0 = sw[col], w1 = sw[1536 + col], w2 = sw[2 * 1536 + col], sb = p.in[I_hy_short_b][l * 1536 + col];
    float x[10];
#pragma unroll
    for (int i = 0; i < 10; ++i) { const int t = t8 * 8 - 1 + i; x[i] = (t >= 0 && t < SEQ) ? ldu(p, b * SEQ + t, col) : 0.f; }
    unsigned pk[4];
#pragma unroll
    for (int i = 0; i < 4; ++i) pk[i] = (unsigned)f2bf(w0 * x[2 * i] + w1 * x[2 * i + 1] + w2 * x[2 * i + 2] + sb) | ((unsigned)f2bf(w0 * x[2 * i + 1] + w1 * x[2 * i + 2] + w2 * x[2 * i + 3] + sb) << 16);
    uint4 v; v.x = pk[0]; v.y = pk[1]; v.z = pk[2]; v.w = pk[3];
    *(uint4*)(WSH(O_ZT) + ((size_t)(sidx * NB + b) * 512 + c) * SEQ + t8 * 8) = v;
}
constexpr long N_hy_shortT = 3L * NB * (SEQ / 8) * 512;
DEV void st_hy_short(PREF p, int l, long g) {
    const int c = (int)(g % 1536), m = (int)(g / 1536); if (l == 1 && m >= TL) return;
    const float* sw = p.in[I_hy_short_w] + l * 3 * 1536; const int pm = tok_prev(m, 0, 1), nm = tok_prev(m, 1, 1);
    float s = sw[1536 + c] * ldu(p, m, c) + p.in[I_hy_short_b][l * 1536 + c];
    if (pm >= 0) s += sw[c] * ldu(p, pm, c);
    if (nm >= 0) s += sw[2 * 1536 + c] * ldu(p, nm, c);
    WSF(O_HYU)[g] = s;
}
constexpr long N_hy_short = (long)T * 1536;
constexpr int HTT = 16;
constexpr long N_hy_conv_l = (long)NB * (SEQ / HTT) * 512, N_hy_conv_c = (long)NB * (CTX / HTT) * 512;
DEV void st_hy_conv(PREF p, int l, int o, long g) {
    int c, tt, b, L, vi, m0;
    if (g < N_hy_conv_l) { c = (int)(g % 512); tt = (int)((g / 512) % (SEQ / HTT)); b = (int)(g / (512 * (SEQ / HTT))); L = SEQ; vi = l; m0 = b * SEQ; }
    else { if (l == 1) return; g -= N_hy_conv_l; c = (int)(g % 512); tt = (int)((g / 512) % (CTX / HTT)); b = (int)(g / (512 * (CTX / HTT))); L = CTX; vi = 2; m0 = TL + b * CTX; }
    const float* tp = WSF(O_TAPSC) + o * 512 + c;
    const float* zin = o == 0 ? WSF(O_HYU) + c : WSF(O_HZ1) + c; const int zs = o == 0 ? 1536 : 512;
    const int t0 = tt * HTT;
    float acc[HTT];
#pragma unroll
    for (int i = 0; i < HTT; ++i) acc[i] = 0.f;
    for (int s0 = 0; s0 < L; s0 += HTT) {
        float w[2 * HTT - 1], z[HTT];
#pragma unroll
        for (int q = 0; q < 2 * HTT - 1; ++q) { const int d = t0 - s0 + (q - (HTT - 1)); w[q] = (d >= 0) ? (d < L ? tp[(size_t)d * 2048] : 0.f) : (-d < L ? tp[(size_t)(-d) * 2048 + 1024] : 0.f); }
#pragma unroll
        for (int j = 0; j < HTT; ++j) z[j] = zin[(size_t)(m0 + s0 + j) * zs];
#pragma unroll
        for (int i = 0; i < HTT; ++i)
#pragma unroll
            for (int j = 0; j < HTT; ++j) acc[i] += w[i - j + HTT - 1] * z[j];
    }
    const float bias = p.in[I_hy_bias][l * 1024 + o * 512 + c];
#pragma unroll
    for (int i = 0; i < HTT; ++i) { const int m = m0 + t0 + i; const float zt = zin[(size_t)m * zs]; const float gate = WSF(O_HYU)[(size_t)m * 1536 + (o + 1) * 512 + c];
        const float r = gate * (acc[i] + bias * zt);
        if (o == 0) WSF(O_HZ1)[(size_t)m * 512 + c] = r; else WSH(O_CAT)[(size_t)m * D + c] = f2bf(r); }
}
DEV void st_hy_conv0(PREF p, int l, long g) { st_hy_conv(p, l, 0, g); }
DEV void st_hy_conv1(PREF p, int l, long g) { st_hy_conv(p, l, 1, g); }
constexpr long N_hy_conv = N_hy_conv_l + N_hy_conv_c;
DEV void st_hy_short_ctx(PREF p, int l, long g) { st_hy_short(p, l, g + (long)TL * 1536); }
constexpr long N_hy_short_ctx = (long)TC * 1536;
DEV void st_hy_conv0_ctx(PREF p, int l, long g) { st_hy_conv(p, l, 0, g + N_hy_conv_l); }
DEV void st_hy_conv1_ctx(PREF p, int l, long g) { st_hy_conv(p, l, 1, g + N_hy_conv_l); }

constexpr long N_dmc = 2L * T * G;
DEV void st_rg_conv(PREF p, int l, long g) {
    const int c = (int)(g % G), m = (int)((g / G) % T), d = (int)(g / ((long)G * T));
    const float* cw = p.in[I_rg_conv_w] + (size_t)(l * 2 + d) * 4 * G;
    float s = p.in[I_rg_conv_b][(l * 2 + d) * G + c];
    for (int j = 0; j < 4; ++j) { const int pm = tok_prev(m, d, 3 - j); if (pm >= 0) s += cw[j * G + c] * ldu(p, pm, U_RG + c); }
    WSF(O_RGXC)[g] = s;
}
DEV void st_rg_gate(PREF p, int l, long g) {
    const int c = (int)(g % G), m = (int)((g / G) % T), d = (int)(g / ((long)G * T)); const int h = c / 64, j = c % 64;
    const float* xc = WSF(O_RGXC) + ((size_t)d * T + m) * G + h * 64;
    const float* wa = p.in[I_rg_wa] + ((size_t)(l * 2 + d) * 8 + h) * 4096; const float* wx = p.in[I_rg_wx] + ((size_t)(l * 2 + d) * 8 + h) * 4096;
    float sa = p.in[I_rg_ba][(l * 2 + d) * G + c], sx = p.in[I_rg_bx][(l * 2 + d) * G + c];
    for (int i = 0; i < 64; ++i) { sa += xc[i] * wa[i * 64 + j]; sx += xc[i] * wx[i * 64 + j]; }
    const float r = sigm(sa), ig = sigm(sx);
    const float log_a = -8.0f * r * softplusf(-p.in[I_rg_lambda][(l * 2 + d) * G + c]);
    WSF(O_RGA)[g] = expf(log_a);
    WSF(O_RGB)[g] = sqrtf(-expm1f(2.0f * log_a)) * (ig * xc[j]);
}
DEV void st_rg_scan(PREF p, int, long g) {
    const int c = (int)(g % G), b = (int)((g / G) % NB), d = (int)(g / (G * NB));
    float h = 0.f;
    for (int p0 = 0; p0 < SCANL; p0 += 8) {
        float a[8], bb[8]; size_t idx[8];
#pragma unroll
        for (int j = 0; j < 8; ++j) { idx[j] = ((size_t)d * T + scan_tok(d, b, p0 + j)) * G + c; a[j] = WSF(O_RGA)[idx[j]]; bb[j] = WSF(O_RGB)[idx[j]]; }
#pragma unroll
        for (int j = 0; j < 8; ++j) { h = a[j] * h + bb[j]; WSF(O_RGH)[idx[j]] = h; }
    }
}
constexpr long N_rg_scan = 2L * NB * G;
DEV void st_rg_out(PREF p, int l, long g) {
    const int c = (int)(g % G), m = (int)(g / G); if (l == 1 && m >= TL) return;
    const float h = WSF(O_RGH)[(size_t)m * G + c] + WSF(O_RGH)[((size_t)T + m) * G + c];
    WSH(O_CAT)[(size_t)m * D + G + c] = f2bf(h * gelu_tanh(ldu(p, m, U_RG + G + c)));
}
constexpr long N_mc = (long)T * G;

DEV void st_rw_lh(PREF p, int l, long g) {
    const int j = (int)(g % 160), m = (int)(g / 160);
    float s = 0.f;
    if (j < 32) { if (l == 0) return; const float* v1 = p.in[I_rw_v1] + (size_t)(l - 1) * G * 32; for (int c = 0; c < G; ++c) s += ldu(p, m, U_RW + 3 * G + c) * v1[c * 32 + j]; }
    else { const float* g1 = p.in[I_rw_g1] + (size_t)l * G * 128; for (int c = 0; c < G; ++c) s += ldu(p, m, U_RW + 3 * G + c) * g1[c * 128 + (j - 32)]; s = sigm(s); }
    WSF(O_LH)[g] = s;
}
constexpr long N_rw_lh = (long)T * 160;
DEV void st_rw_vg(PREF p, int l, long g) {
    const int c = (int)(g % G), m = (int)(g / G);
    const float* lh = WSF(O_LH) + (size_t)m * 160;
    float v = ldu(p, m, U_RW + 2 * G + c);
    if (l == 0) WSF(O_VFIRST)[g] = v;
    else { const float* v2 = p.in[I_rw_v2] + (size_t)(l - 1) * 32 * G; float s = p.in[I_rw_v0][(l - 1) * G + c]; for (int j = 0; j < 32; ++j) s += lh[j] * v2[j * G + c]; v = v + (WSF(O_VFIRST)[g] - v) * sigm(s); }
    WSF(O_RWV)[g] = v;
    const float* g2 = p.in[I_rw_g2] + (size_t)l * 128 * G; float s = 0.f; for (int j = 0; j < 128; ++j) s += lh[32 + j] * g2[j * G + c];
    WSF(O_RWG)[g] = s;
}
DEV void st_rw_lhw(PREF p, int l, long g) {
    const int j = (int)(g % 128), m = (int)((g / 128) % T), d = (int)(g / (128L * T));
    const int pm = tok_prev(m, d, 1); const float* mu = p.in[I_rw_mu] + ((size_t)(l * 2 + d) * 4 + 3) * G;
    const float* w = j < 64 ? p.in[I_rw_w1] + (size_t)(l * 2 + d) * G * 64 + j : p.in[I_rw_a1] + (size_t)(l * 2 + d) * G * 64 + (j - 64);
    float s = 0.f;
    for (int c = 0; c < G; ++c) { const float z = ldu(p, m, U_RW + 3 * G + c), zp = pm >= 0 ? ldu(p, pm, U_RW + 3 * G + c) : 0.f; s += (z + (zp - z) * mu[c]) * w[c * 64]; }
    WSF(O_LHW)[g] = j < 64 ? tanhf(s) : s;
}
constexpr long N_rw_lhw = 2L * T * 128;
DEV void st_rw_tok(PREF p, int l, long g) {
    const int c = (int)(g % G), m = (int)((g / G) % T), d = (int)(g / ((long)G * T)); const int ld = l * 2 + d;
    const float* lhw = WSF(O_LHW) + ((size_t)d * T + m) * 128;
    const float* w2 = p.in[I_rw_w2] + (size_t)ld * 64 * G; const float* a2 = p.in[I_rw_a2] + (size_t)ld * 64 * G;
    float wl = p.in[I_rw_w0][ld * G + c], al = p.in[I_rw_a0][ld * G + c];
    for (int j = 0; j < 64; ++j) { wl += lhw[j] * w2[j * G + c]; al += lhw[64 + j] * a2[j * G + c]; }
    const float w_log = -softplusf(-wl) - 0.5f; const float dec = expf(-expf(w_log)); const float a = sigm(al);
    const int pm = tok_prev(m, d, 1); const float* mu = p.in[I_rw_mu] + (size_t)ld * 4 * G;
    const float r0 = ldu(p, m, U_RW + c), k0 = ldu(p, m, U_RW + G + c), v0 = WSF(O_RWV)[(size_t)m * G + c];
    const float rp = pm >= 0 ? ldu(p, pm, U_RW + c) : 0.f, kp = pm >= 0 ? ldu(p, pm, U_RW + G + c) : 0.f, vp = pm >= 0 ? WSF(O_RWV)[(size_t)pm * G + c] : 0.f;
    const float rs = r0 + (rp - r0) * mu[c], ks = k0 + (kp - k0) * mu[G + c], vs = v0 + (vp - v0) * mu[2 * G + c];
    WSF(O_SR)[g] = rs; WSF(O_SW)[g] = dec; WSF(O_SV)[g] = vs; WSF(O_SA)[g] = a;
    WSF(O_SK)[g] = ks * (1.0f + (a - 1.0f) * p.in[I_rw_k_a][l * G + c]);
    WSF(O_SKKR)[g] = ks * p.in[I_rw_k_k][l * G + c];
}
DEV void st_rw_kk(PREF p, int, long g) {
    const int c = (int)(g % G); const float* kr = WSF(O_SKKR) + (g - c) + (c / 64) * 64;
    float s = 0.f; for (int i = 0; i < 64; ++i) s += kr[i] * kr[i];
    const float kk = WSF(O_SKKR)[g] / fmaxf(sqrtf(s), 1e-12f);
    WSF(O_SKK)[g] = kk; WSF(O_SKKA)[g] = kk * WSF(O_SA)[g];
}
DEV void st_rw_scan(PREF p, int, long g) {
    const int i = (int)(g % 64), h = (int)((g / 64) % 8), b = (int)((g / 512) % NB), d = (int)(g / (512 * NB));
    float S[64];
#pragma unroll
    for (int j = 0; j < 64; ++j) S[j] = 0.f;
    for (int pp = 0; pp < SCANL; ++pp) {
        const size_t base = ((size_t)d * T + scan_tok(d, b, pp)) * G + h * 64;
        const float* kk = WSF(O_SKK) + base; const float* kka = WSF(O_SKKA) + base; const float* w = WSF(O_SW) + base; const float* k = WSF(O_SK) + base; const float* r = WSF(O_SR) + base;
        const float v = WSF(O_SV)[base + i];
        float sa = 0.f;
#pragma unroll
        for (int j = 0; j < 64; ++j) sa += S[j] * kk[j];
        float y = 0.f;
#pragma unroll
        for (int j = 0; j < 64; ++j) { S[j] = S[j] * w[j] - sa * kka[j] + v * k[j]; y += S[j] * r[j]; }
        WSF(O_SY)[base + i] = y;
    }
}
constexpr long N_rw_scan = 2L * NB * 512;


DEV void st_lora_cvt(PREF p, int, long g) {
    long r = g;
    if (r < 2L * 160 * 512) { const int k = (int)(r % 512), n = (int)((r / 512) % 160), l = (int)(r / (160 * 512));
        float v = 0.f; if (n < 32) { if (l >= 1) v = p.in[I_rw_v1][((size_t)(l - 1) * G + k) * 32 + n]; } else v = p.in[I_rw_g1][((size_t)l * G + k) * 128 + (n - 32)];
        WSH(O_LW1T)[r] = f2bf(v); return; } r -= 2L * 160 * 512;
    if (r < 2L * 512 * 128) { const int k = (int)(r % 128), c = (int)((r / 128) % 512), l = (int)(r / (128 * 512)); WSH(O_LG2T)[r] = f2bf(p.in[I_rw_g2][((size_t)l * 128 + k) * G + c]); return; } r -= 2L * 512 * 128;
    if (r < 2L * 512 * 32) { const int k = (int)(r % 32), c = (int)((r / 32) % 512), l = (int)(r / (32 * 512)); WSH(O_LV2T)[r] = f2bf(l >= 1 ? p.in[I_rw_v2][((size_t)(l - 1) * 32 + k) * G + c] : 0.f); return; } r -= 2L * 512 * 32;
    if (r < 8L * 128 * 512) { const int k = (int)(r % 512), n = (int)((r / 512) % 128), half = (int)((r / (128 * 512)) % 2), ld = (int)(r / (2 * 128 * 512));
        const float mz = p.in[I_rw_mu][((size_t)ld * 4 + 3) * G + k]; const float wv = n < 64 ? p.in[I_rw_w1][((size_t)ld * G + k) * 64 + n] : p.in[I_rw_a1][((size_t)ld * G + k) * 64 + (n - 64)];
        WSH(O_LWA1T)[r] = f2bf(wv * (half == 0 ? 1.0f - mz : mz)); return; } r -= 8L * 128 * 512;
    if (r < 4L * 512 * 64) { const int k = (int)(r % 64), c = (int)((r / 64) % 512), ld = (int)(r / (64 * 512)); WSH(O_LW2T)[r] = f2bf(p.in[I_rw_w2][((size_t)ld * 64 + k) * G + c]); return; } r -= 4L * 512 * 64;
    if (r < 4L * 512 * 64) { const int k = (int)(r % 64), c = (int)((r / 64) % 512), ld = (int)(r / (64 * 512)); WSH(O_LA2T)[r] = f2bf(p.in[I_rw_a2][((size_t)ld * 64 + k) * G + c]); }
}
constexpr long N_lora_cvt = 2L * 160 * 512 + 2L * 512 * 128 + 2L * 512 * 32 + 8L * 128 * 512 + 8L * 512 * 64;
DEV void rw_chain_decode(int chain, int& d, int& b, int& h) { h = chain % 8; b = (chain / 8) % NB; d = chain / (8 * NB); }
DEV void st_rwc_a1(PREF p, int, long g) {
    const int c = (int)(g % 64); const long task = g / 64; const int ck = (int)(task % NCK), chain = (int)(task / NCK); int d, b, h; rw_chain_decode(chain, d, b, h);
    float gam = 1.0f;
    for (int t = 0; t < RWC; ++t) {
        const size_t base = ((size_t)d * T + scan_tok(d, b, ck * RWC + t)) * G + h * 64 + c; const size_t o = ((size_t)task * RWC + t) * 64 + c;
        WSF(O_CAAT)[o] = WSF(O_SKK)[base] * gam;
        gam *= WSF(O_SW)[base]; const float inv = 1.0f / gam;
        WSF(O_CABH)[o] = WSF(O_SKKA)[base] * inv; WSF(O_CAKH)[o] = WSF(O_SK)[base] * inv; WSF(O_CART)[o] = WSF(O_SR)[base] * gam;
    }
    WSF(O_CAGC)[g] = gam;
}
constexpr long N_rwc_a1 = (long)NTASK * 64;
DEV void st_rwc_a2(PREF p, int, long g) {
    const int j = (int)(g % 16), t = (int)((g / 16) % 16); const long task = g / 256;
    const float* at = WSF(O_CAAT) + ((size_t)task * 16 + t) * 64; const float* rt = WSF(O_CART) + ((size_t)task * 16 + t) * 64;
    const float* bh = WSF(O_CABH) + ((size_t)task * 16 + j) * 64; const float* kh = WSF(O_CAKH) + ((size_t)task * 16 + j) * 64;
    float nt = 0.f, mt = 0.f, qk = 0.f, qb = 0.f;
    if (t >= j) { for (int c = 0; c < 64; ++c) { nt += at[c] * bh[c]; mt += at[c] * kh[c]; qk += rt[c] * kh[c]; qb += rt[c] * bh[c]; } }
    if (t == j) { nt = 0.f; mt = 0.f; }
    WSF(O_CANT)[g] = nt; WSF(O_CAMT)[g] = mt; WSF(O_CAQK)[g] = qk; WSF(O_CAQB)[g] = qb;
}
constexpr long N_rwc_a2 = (long)NTASK * 256;
DEV void st_rwc_a3(PREF p, int, long g) {
    const int col = (int)(g % 16); const long task = g / 16; const float* nt = WSF(O_CANT) + (size_t)task * 256;
    float x[16];
#pragma unroll
    for (int t = 0; t < 16; ++t) { float s = (t == col) ? 1.0f : 0.0f;
#pragma unroll
        for (int j = 0; j < 16; ++j) if (j < t) s -= nt[t * 16 + j] * x[j];
        x[t] = s; }
#pragma unroll
    for (int t = 0; t < 16; ++t) WSF(O_CATT)[(size_t)task * 256 + t * 16 + col] = x[t];
}
constexpr long N_rwc_a3 = (long)NTASK * 16;
DEV void st_rwc_a4(PREF p, int, long g) {
    const int e = (int)(g % 3328); const long task = g / 3328; const int ck = (int)(task % NCK), chain = (int)(task / NCK);
    const float* tt = WSF(O_CATT) + (size_t)task * 256;
    if (e < 1024) { const int c = e % 64, t = e / 64; float s = 0.f; for (int j = 0; j <= t; ++j) s += tt[t * 16 + j] * WSF(O_CAAT)[((size_t)task * 16 + j) * 64 + c];
        WSH(O_OW1)[(size_t)task * 1024 + e] = f2bf(s); WSH(O_ORT)[(size_t)task * 1024 + e] = f2bf(WSF(O_CART)[(size_t)task * 1024 + e]); }
    else if (e < 1280) { const int j = (e - 1024) % 16, t = (e - 1024) / 16; float s = 0.f; for (int i = 0; i <= t; ++i) s += tt[t * 16 + i] * WSF(O_CAMT)[(size_t)task * 256 + i * 16 + j];
        WSH(O_OTM)[(size_t)task * 512 + t * 32 + j] = f2bf(s); WSH(O_OTM)[(size_t)task * 512 + t * 32 + 16 + j] = 0;
        WSH(O_OQKB)[(size_t)task * 512 + t * 32 + j] = f2bf(WSF(O_CAQK)[(size_t)task * 256 + t * 16 + j]); WSH(O_OQKB)[(size_t)task * 512 + t * 32 + 16 + j] = f2bf(-WSF(O_CAQB)[(size_t)task * 256 + t * 16 + j]); }
    else if (e < 2304) { const int t = (e - 1280) % 16, c = (e - 1280) / 16; const float gc = WSF(O_CAGC)[(size_t)task * 64 + c];
        WSH(O_OKB)[(size_t)task * 2048 + c * 32 + t] = f2bf(WSF(O_CAKH)[((size_t)task * 16 + t) * 64 + c] * gc); WSH(O_OKB)[(size_t)task * 2048 + c * 32 + 16 + t] = f2bf(-WSF(O_CABH)[((size_t)task * 16 + t) * 64 + c] * gc); }
    else { const int t = (e - 2304) % 16, v = (e - 2304) / 16; int d, b, h; rw_chain_decode(chain, d, b, h);
        WSH(O_OVT)[(size_t)task * 1024 + v * 16 + t] = f2bf(WSF(O_SV)[((size_t)d * T + scan_tok(d, b, ck * RWC + t)) * G + h * 64 + v]); }
}
constexpr long N_rwc_a4 = (long)NTASK * 3328;
DEV void st_rwc_b(PREF p, int, long g) {
    const int v = (int)(g % 64), chain = (int)(g / 64); int d, b, h; rw_chain_decode(chain, d, b, h);
    float S[64];
#pragma unroll
    for (int c = 0; c < 64; ++c) S[c] = 0.f;
    for (int ck = 0; ck < NCK; ++ck) {
        const size_t task = (size_t)chain * NCK + ck;
        const unsigned short* w1 = WSH(O_OW1) + task * 1024; const unsigned short* rt = WSH(O_ORT) + task * 1024; const unsigned short* tm = WSH(O_OTM) + task * 512; const unsigned short* qkb = WSH(O_OQKB) + task * 512;
        const unsigned short* kb = WSH(O_OKB) + task * 2048; const unsigned short* vt = WSH(O_OVT) + task * 1024 + v * 16;
        float Sb[64], V[16], U[16];
#pragma unroll
        for (int c = 0; c < 64; ++c) Sb[c] = bf2f(f2bf(S[c]));
#pragma unroll
        for (int t = 0; t < 16; ++t) V[t] = bf2f(vt[t]);
#pragma unroll
        for (int t = 0; t < 16; ++t) { float s = 0.f;
#pragma unroll
            for (int c = 0; c < 64; ++c) s += bf2f(w1[t * 64 + c]) * Sb[c];
#pragma unroll
            for (int j = 0; j < 16; ++j) s += bf2f(tm[t * 32 + j]) * V[j];
            U[t] = bf2f(f2bf(s)); }
#pragma unroll
        for (int t = 0; t < 16; ++t) { float s = 0.f;
#pragma unroll
            for (int c = 0; c < 64; ++c) s += bf2f(rt[t * 64 + c]) * Sb[c];
#pragma unroll
            for (int j = 0; j < 16; ++j) s += bf2f(qkb[t * 32 + j]) * V[j] + bf2f(qkb[t * 32 + 16 + j]) * U[j];
            WSF(O_SY)[((size_t)d * T + scan_tok(d, b, ck * RWC + t)) * G + h * 64 + v] = s; }
#pragma unroll
        for (int c = 0; c < 64; ++c) { float s = WSF(O_CAGC)[task * 64 + c] * S[c];
#pragma unroll
            for (int t = 0; t < 16; ++t) s += bf2f(kb[c * 32 + t]) * V[t] + bf2f(kb[c * 32 + 16 + t]) * U[t];
            S[c] = s; }
    }
}
constexpr long N_rwc_b = (long)NCHAIN * 64;
DEV void st_rw_out(PREF p, int l, long g) {
    const int c = (int)(g % G), m = (int)(g / G); if (l == 1 && m >= TL) return; const int h0 = (c / 64) * 64;
    float tot = 0.f;
    for (int d = 0; d < 2; ++d) {
        const size_t base = ((size_t)d * T + m) * G + h0;
        const float* y = WSF(O_SY) + base; const float* r = WSF(O_SR) + base; const float* k = WSF(O_SK) + base;
        float mean = 0.f, bon = 0.f;
        for (int i = 0; i < 64; ++i) { mean += y[i]; bon += r[i] * k[i] * p.in[I_rw_r_k][l * G + h0 + i]; }
        mean *= (1.0f / 64.0f);
        float var = 0.f; for (int i = 0; i < 64; ++i) { const float dd = y[i] - mean; var += dd * dd; }
        var *= (1.0f / 64.0f);
        tot += (y[c - h0] - mean) / sqrtf(var + 64e-5f) * p.in[I_rw_ln_w][l * G + c] + p.in[I_rw_ln_b][l * G + c] + bon * WSF(O_SV)[base + (c - h0)];
    }
    WSH(O_CAT)[(size_t)m * D + 2 * G + c] = f2bf(tot * WSF(O_RWG)[(size_t)m * G + c]);
}

DEV float rt_lg(PREF p, int l, int d, int h) { return -softplusf(p.in[I_rt_decay][(l * 2 + d) * 4 + h]); }
DEV void st_rt_prep(PREF p, int, long g) {
    const int c = (int)(g % G), m = (int)(g / G); const int e = c % 128;
    float q = ldu(p, m, U_RT + c), k = ldu(p, m, U_RT + G + c);
    if (m < TL) {
        const int t = m % SEQ; const int half = e / 64, eh = e % 64, i = eh % 32; const float pos = half == 0 ? (float)(t / 64) : (float)(t % 64);
        const float ang = pos * powf(10000.0f, -(float)i / 32.0f); const float cs = cosf(ang), sn = sinf(ang);
        const int cp = eh < 32 ? c + 32 : c - 32;
        const float qp = ldu(p, m, U_RT + cp), kp = ldu(p, m, U_RT + G + cp);
        if (eh < 32) { q = q * cs - qp * sn; k = k * cs - kp * sn; } else { q = qp * sn + q * cs; k = kp * sn + k * cs; }
    }
    WSF(O_RQ)[g] = q; WSF(O_RK)[g] = k * 0.08838834764831845f;
}
DEV void st_rt_score(PREF p, int, long g) {
    const int j = (int)(g % 128), i = (int)((g / 128) % 128), h = (int)((g / 16384) % 4), ch = (int)(g / 65536);
    const float* q = WSF(O_RQ) + (size_t)(ch * 128 + i) * G + h * 128; const float* k = WSF(O_RK) + (size_t)(ch * 128 + j) * G + h * 128;
    float s = 0.f; for (int e = 0; e < 128; ++e) s += q[e] * k[e];
    WSF(O_SC)[g] = s;
}
constexpr long N_rt_score = (long)NCHUNK * 4 * 128 * 128;
DEV void st_rt_kv(PREF p, int l, long g) {
    const int e = (int)(g % 128), dd = (int)((g / 128) % 128), h = (int)((g / 16384) % 4), ch = (int)((g / 65536) % NCHUNK), d = (int)(g / (65536L * NCHUNK));
    const float lg = rt_lg(p, l, d, h); float s = 0.f;
    for (int j = 0; j < 128; ++j) { const int m = ch * 128 + j; const float dec = expf(lg * (float)(d == 0 ? 127 - j : j)); s += dec * WSF(O_RK)[(size_t)m * G + h * 128 + dd] * ldu(p, m, U_RT + 2 * G + h * 128 + e); }
    WSF(O_KV)[g] = s;
}
constexpr long N_rt_kv = 2L * N_rt_score;
DEV int rt_scan_chunk(int d, int b, int n) {
    if (n < NCH_C) return TL / 128 + b * NCH_C + (d == 0 ? n : NCH_C - 1 - n);
    const int q = n - NCH_C; return b * NCH_L + (d == 0 ? q : NCH_L - 1 - q);
}
DEV void st_rt_state(PREF p, int l, long g) {
    const int de = (int)(g % 16384), h = (int)((g / 16384) % 4), b = (int)((g / 65536) % NB), d = (int)(g / (65536L * NB));
    const float cdec = expf(128.0f * rt_lg(p, l, d, h)); float S = 0.f;
    for (int n = 0; n < NCH_C + NCH_L; ++n) { const size_t i = (((size_t)d * NCHUNK + rt_scan_chunk(d, b, n)) * 4 + h) * 16384 + de; WSF(O_SPREV)[i] = S; S = cdec * S + WSF(O_KV)[i]; }
}
constexpr long N_rt_state = 2L * NB * 4 * 16384;
DEV void st_rt_out(PREF p, int l, long g) {
    const int c = (int)(g % G), m = (int)(g / G); const int h = c / 128, e = c % 128, ch = m / 128, i = m % 128;
    const float lg0 = rt_lg(p, l, 0, h), lg1 = rt_lg(p, l, 1, h);
    const float* sc = WSF(O_SC) + (((size_t)ch * 4 + h) * 128 + i) * 128;
    float o = 0.f;
    for (int j = 0; j < 128; ++j) { const float w = j <= i ? expf(lg0 * (float)(i - j)) : expf(lg1 * (float)(j - i)); o += w * sc[j] * ldu(p, ch * 128 + j, U_RT + 2 * G + h * 128 + e); }
    const float* q = WSF(O_RQ) + (size_t)m * G + h * 128;
    const float* s0 = WSF(O_SPREV) + (((size_t)0 * NCHUNK + ch) * 4 + h) * 16384 + e; const float* s1 = WSF(O_SPREV) + (((size_t)1 * NCHUNK + ch) * 4 + h) * 16384 + e;
    float c0 = 0.f, c1 = 0.f; for (int dd = 0; dd < 128; ++dd) { c0 += q[dd] * s0[dd * 128]; c1 += q[dd] * s1[dd * 128]; }
    WSF(O_RO)[g] = o + expf(lg0 * (float)(i + 1)) * c0 + expf(lg1 * (float)(128 - i)) * c1;
}
DEV void st_rt_fin(PREF p, int l, long g) {
    const int c = (int)(g % G), m = (int)(g / G); if (l == 1 && m >= TL) return; const float* o = WSF(O_RO) + (size_t)m * G + (c / 128) * 128;
    float mean = 0.f; for (int i = 0; i < 128; ++i) mean += o[i]; mean *= (1.0f / 128.0f);
    float var = 0.f; for (int i = 0; i < 128; ++i) { const float dd = o[i] - mean; var += dd * dd; } var *= (1.0f / 128.0f);
    WSH(O_CAT)[(size_t)m * D + 3 * G + c] = f2bf((o[c % 128] - mean) / sqrtf(var + 1e-6f) * p.in[I_rt_gn_w][l * G + c] * siluf(ldu(p, m, U_RT + 3 * G + c)));
}

DEV int moe_ntok(int l) { return l == DEPTH - 1 ? TL : T; }
DEV void st_moe_fold(PREF p, int, long g) {
    const long nA = 2L * (NB + 1) * D * NE;
    if (g < nA) { const int e = (int)(g % NE), k = (int)((g / NE) % D), r = (int)((g / ((long)NE * D)) % (NB + 1)), l = (int)(g / ((long)NE * D * (NB + 1)));
        const float av = p.in[I_norm2_w][l * D + k] * (1.0f + modp(p, l, r, 4)[k]); const float v = av * p.in[I_moe_router_w][((size_t)l * D + k) * NE + e];
        WSF(O_RWA)[g] = v; const unsigned short hi = f2bf(v); const size_t o = (((size_t)(l * (NB + 1) + r) * 2) * NE + e) * D + k;
        WSH(O_RWAT)[o] = hi; WSH(O_RWAT)[o + (size_t)NE * D] = f2bf(v - bf2f(hi));
        if (e == 0) { WSF(O_MODA)[(size_t)(l * (NB + 1) + r) * D + k] = av; WSF(O_MODB)[(size_t)(l * (NB + 1) + r) * D + k] = modp(p, l, r, 3)[k]; } }
    else { g -= nA; if (g >= 2L * (NB + 1) * NE) return; const int e = (int)(g % NE), r = (int)((g / NE) % (NB + 1)), l = (int)(g / (NE * (NB + 1)));
        float s = p.in[I_moe_router_b][l * NE + e]; const float* sh = modp(p, l, r, 3); for (int k = 0; k < D; ++k) s += sh[k] * p.in[I_moe_router_w][((size_t)l * D + k) * NE + e];
        WSF(O_RCB)[g] = s; }
}
constexpr long N_moe_fold = 2L * (NB + 1) * D * NE + 2L * (NB + 1) * NE;
DEV void st_moe_logit(PREF p, int l, long g) {
    const int e = (int)(g % NE), m = (int)(g / NE); if (m >= moe_ntok(l)) return; const int r = mod_row(m);
    const float* rwa = WSF(O_RWA) + ((size_t)(l * (NB + 1) + r) * D) * NE + e; const float* x = WSF(O_X) + (size_t)m * D;
    float s = 0.f;
    for (int k = 0; k < D; k += 4) { const float4 xv = *(const float4*)(x + k); s += xv.x * rwa[(size_t)k * NE] + xv.y * rwa[(size_t)(k + 1) * NE] + xv.z * rwa[(size_t)(k + 2) * NE] + xv.w * rwa[(size_t)(k + 3) * NE]; }
    WSF(O_LOGITS)[g] = s / sqrtf(WSF(O_ROWSS)[m] * (1.0f / D) + 1e-6f) + WSF(O_RCB)[(l * (NB + 1) + r) * NE + e];
}
constexpr long N_moe_logit = (long)T * NE;
DEV int atomic_inc(int* a) {
#ifdef CPU_TEST
    return __sync_fetch_and_add(a, 1);
#else
    return atomicAdd(a, 1);
#endif
}
DEV void st_moe_topk(PREF p, int l, long g) {
    if (g < MAXSLOT) { WSI(O_SLOTTOK)[g] = 0; WSF(O_SLOTP)[g] = 0.f; }
    const int m = (int)g; if (m >= moe_ntok(l)) return;
    const float* lg = WSF(O_LOGITS) + (size_t)m * NE;
    int idx[4]; float val[4]; unsigned used = 0u;
#pragma unroll
    for (int k = 0; k < 4; ++k) { int bi = -1; float bv = 0.f; for (int e = 0; e < NE; ++e) { if (used & (1u << e)) continue; const float v = lg[e]; if (bi < 0 || v > bv) { bi = e; bv = v; } } idx[k] = bi; val[k] = bv; used |= 1u << bi; }
    float ex[4], sum = 0.f;
#pragma unroll
    for (int k = 0; k < 4; ++k) { ex[k] = expf(val[k] - val[0]); sum += ex[k]; }
#pragma unroll
    for (int k = 0; k < 4; ++k) { WSI(O_TOPE)[m * 4 + k] = idx[k]; WSF(O_TOPP)[m * 4 + k] = ex[k] / sum; WSI(O_TOPPOS)[m * 4 + k] = atomic_inc((int*)(p.ws + O_CTL) + CW_COUNTS + (l * NE + idx[k]) * CW_CSTR); }
}
constexpr long N_moe_topk = MAXSLOT > T ? MAXSLOT : T;
DEV void st_moe_slots(PREF p, int l, long g) {
    const int* cnt0 = (const int*)(p.ws + O_CTL) + CW_COUNTS + l * NE * CW_CSTR;
#define cnt(e_) cnt0[(e_) * CW_CSTR]
    if (g == 0) { int nt = 0; for (int e = 0; e < NE; ++e) { const int n = (cnt(e) + 255) / 256; for (int i = 0; i < n; ++i) WSI(O_TILEE)[nt + i] = e; nt += n; } WSI(O_TILEE)[MAXTILES] = nt; }
    const int m = (int)(g / 4); if (m >= moe_ntok(l)) return;
    const int e = WSI(O_TOPE)[g]; int base = 0; for (int i = 0; i < e; ++i) base += ((cnt(i) + 255) / 256) * 256;
    const int slot = base + WSI(O_TOPPOS)[g];
    WSI(O_SLOTTOK)[slot] = m; WSF(O_SLOTP)[slot] = WSF(O_TOPP)[g]; WSI(O_TOKSLOT)[g] = slot;
#undef cnt
}
constexpr long N_moe_slots = (long)T * 4;
DEV void st_moe_gather(PREF p, int, long g) {
    const int c8 = (int)(g % (D / 8)), slot = (int)(g / (D / 8)); if (slot >= WSI(O_TILEE)[MAXTILES] * 256) return;
    ((uint4*)WSH(O_AG))[g] = ((const uint4*)WSH(O_A1))[(size_t)WSI(O_SLOTTOK)[slot] * (D / 8) + c8];
}
constexpr long N_moe_gather = (long)MAXSLOT * (D / 8);
DEV void st_moe_comb(PREF p, int l, long g) {
    const int c = (int)(g % D), m = (int)(g / D); if (m >= moe_ntok(l)) return;
    float s = 0.f; for (int k = 0; k < 4; ++k) s += WSF(O_OSLOT)[(size_t)WSI(O_TOKSLOT)[m * 4 + k] * D + c];
    WSF(O_X)[g] += modp(p, l, mod_row(m), 5)[c] * s;
}
DEV void st_final(PREF p, int, long g) {
    const int c = (int)(g % D), m = (int)(g / D);
    p.out[g] = WSF(O_X)[g] / sqrtf(WSF(O_ROWSS)[m] * (1.0f / D) + 1e-6f) * p.in[I_final_norm_w][c];
}

#ifndef CPU_TEST
constexpr int LDS_WTAB = 147456 + 64;
__device__ __forceinline__ int hw_tid() {
    const unsigned phys = (unsigned)__builtin_amdgcn_s_getreg((5 << 11) | 4) & 63u;
    const int wv = __builtin_amdgcn_readfirstlane(((volatile __attribute__((address_space(3))) int*)(unsigned)LDS_WTAB)[phys]);
    int lane; asm volatile("v_mbcnt_lo_u32_b32 %0, -1, 0\n\tv_mbcnt_hi_u32_b32 %0, -1, %0" : "=v"(lane));
    return wv * 64 + lane;
}
namespace pg8 {
#define PG8_LAS __attribute__((address_space(3)))
typedef unsigned short bf16_t;
typedef short bf16x8 __attribute__((ext_vector_type(8)));
typedef float f32x4 __attribute__((ext_vector_type(4)));
typedef unsigned u32x4 __attribute__((ext_vector_type(4)));
constexpr int BM = 256, BK = 64, HALF = 128, HTB = HALF * BK * 2  , STAGE_BYTES = 8 * HTB, NXCD = 8, WGM = 8;

__host__ __device__ __forceinline__ int lds_byte(int r, int c) { const int st = (r >> 4) * 2 + (c >> 5), rr = r & 15, cc = c & 31, ob = rr * 64 + cc * 2; return st * 1024 + (ob ^ (((ob >> 9) & 1) << 5)); }
__host__ __device__ __forceinline__ void stage_rc(int b, int& R, int& C) { const int st = b / 1024, sb = b % 1024, swz = sb ^ (((sb >> 9) & 1) << 5); R = (st >> 1) * 16 + swz / 64; C = (st & 1) * 32 + (swz % 64) / 2; }
__host__ __device__ __forceinline__ int perm32(int rho) { const int n = rho >> 4, i = rho & 15; return 8 * (i >> 2) + 4 * n + (i & 3); }
struct Unit { int pm, pn; };
struct Gemm { const bf16_t* A; const bf16_t* Bt; int M, N, K; const int* rowmap; };
struct StaticOrder {
    int nM, nN, nwg, G, c;
    __host__ __device__ void init(int M, int N, int G_, int c_) { nM = M / BM; nN = N / BM; nwg = nM * nN; G = G_; c = c_; }
    __host__ __device__ bool next(int i, Unit& u) const {
        const long L = (long)i * G + c; if (L >= nwg) return false;
        int wgid = (int)L; { const int q = nwg / NXCD, r = nwg % NXCD, xcd = wgid % NXCD, off = wgid / NXCD; wgid = (xcd < r ? xcd * (q + 1) : r * (q + 1) + (xcd - r) * q) + off; }
        const int nig = WGM * nN, gid = wgid / nig, fm = gid * WGM, gsz = (nM - fm) < WGM ? (nM - fm) : WGM;
        u.pm = fm + ((wgid % nig) % gsz); u.pn = (wgid % nig) / gsz; return true;
    }
    __device__ __forceinline__ void a_ready(const Unit&) const {}
    __device__ __forceinline__ void done(const Unit&) const {}
};
__device__ __forceinline__ unsigned cvt_pk_bf16(float lo, float hi) { unsigned r; asm volatile("v_cvt_pk_bf16_f32 %0, %1, %2" : "=v"(r) : "v"(lo), "v"(hi)); return r; }
template <class Epi, class Sched, bool STAMP = false>
__device__ __forceinline__ void gemm_phase(PG8_LAS unsigned char* lds, const Gemm g, const Sched& S, const Epi& E, unsigned long long* stamps) {
    int tid = hw_tid(); asm volatile("" : "+v"(tid)); const int wid = __builtin_amdgcn_readfirstlane(tid >> 6), lane = tid & 63, wr = wid >> 2, wc = wid & 3, fr = lane & 15, fq = lane >> 4;
    const int K = g.K, nt = K / BK;
    int ts_lo = 0, ts_hi = 0, nts = 0; const unsigned long long rt_entry = STAMP ? (unsigned long long)wall_clock64() : 0ull;
#define PG8_STAMP() do { if (STAMP && wid == 0 && nts < 64) { const unsigned long long _c = (unsigned long long)clock64(); \
        ts_lo = (lane == nts) ? (int)(unsigned)_c : ts_lo; ts_hi = (lane == nts) ? (int)(unsigned)(_c >> 32) : ts_hi; ++nts; } } while (0)
    PG8_STAMP();
    unsigned vA0[2], vA1[2], voffB[2];
#pragma unroll
    for (int i = 0; i < 2; ++i) { int R, C; stage_rc(tid * 16 + i * 8192, R, C); const int Rb = E.perm ? ((R & ~31) + perm32(R & 31)) : R; voffB[i] = (unsigned)(Rb * K + C) * 2u; }
#define PG8_AOFF(un) do { _Pragma("unroll") for (int _i = 0; _i < 2; ++_i) { int _R, _C; stage_rc(tid * 16 + _i * 8192, _R, _C); const int _r0 = (un).pm * BM + _R; \
        const unsigned _row0 = g.rowmap ? (unsigned)g.rowmap[_r0] : (unsigned)_r0, _row1 = g.rowmap ? (unsigned)g.rowmap[_r0 + HALF] : (unsigned)(_r0 + HALF); \
        vA0[_i] = (_row0 * (unsigned)K + (unsigned)_C) * 2u; vA1[_i] = (_row1 * (unsigned)K + (unsigned)_C) * 2u; } } while (0)
    const size_t kstep = (size_t)(BK * 2);
    const size_t hstep = (size_t)HALF * K * 2;
    const size_t tstep = 2 * hstep;
    const unsigned ldsw = (unsigned)wid * 1024u;
    const int aoff = lds_byte(wr * 64 + fr, fq * 8), boff = lds_byte(wc * 32 + fr, fq * 8);
#define PG8_SA(b, h) (((b) * 2 + (h)) * HTB)
#define PG8_SB(b, h) ((4 + (b) * 2 + (h)) * HTB)
#define PG8_STAGE(bufoff, gbase, voff) do { _Pragma("unroll") for (int _i = 0; _i < 2; ++_i) \
        __builtin_amdgcn_global_load_lds((const unsigned*)((const char*)(gbase) + (voff)[_i]), (PG8_LAS unsigned*)(lds + (bufoff) + ldsw + _i * 8192), 16, 0, 0); } while (0)
#define PG8_LDA(dst, b, h) do { _Pragma("unroll") for (int m = 0; m < 4; ++m) _Pragma("unroll") for (int k = 0; k < 2; ++k) dst[m][k] = *(const PG8_LAS bf16x8*)(lds + PG8_SA(b, h) + aoff + m * 2048 + k * 1024); } while (0)
#define PG8_LDB(dst, b, h) do { _Pragma("unroll") for (int n = 0; n < 2; ++n) _Pragma("unroll") for (int k = 0; k < 2; ++k) dst[n][k] = *(const PG8_LAS bf16x8*)(lds + PG8_SB(b, h) + boff + n * 2048 + k * 1024); } while (0)
#define PG8_MMA(ai, bj, At, Bt) do { __builtin_amdgcn_s_setprio(1); _Pragma("unroll") for (int m = 0; m < 4; ++m) _Pragma("unroll") for (int n = 0; n < 2; ++n) _Pragma("unroll") for (int k = 0; k < 2; ++k) \
        acc[ai][bj][m][n] = __builtin_amdgcn_mfma_f32_16x16x32_bf16(Bt[n][k], At[m][k], acc[ai][bj][m][n], 0, 0, 0); __builtin_amdgcn_s_setprio(0); } while (0)
#define PG8_WAIT_V(n) asm volatile("s_waitcnt vmcnt(" #n ")" ::: "memory")
#define PG8_WAIT_L(n) asm volatile("s_waitcnt lgkmcnt(" #n ")" ::: "memory")
#define PG8_BAR __builtin_amdgcn_s_barrier()
#define PG8_SCHED __builtin_amdgcn_sched_barrier(0)
    Unit cur, nxt; int ui = 0;
    if (!S.next(0, cur)) return;
    f32x4 acc[2][2][4][2];
#pragma unroll
    for (int a = 0; a < 2; ++a)
#pragma unroll
        for (int b = 0; b < 2; ++b)
#pragma unroll
            for (int m = 0; m < 4; ++m)
#pragma unroll
                for (int n = 0; n < 2; ++n) acc[a][b][m][n] = (f32x4){0.f, 0.f, 0.f, 0.f};
    bf16x8 At[4][2], B0[2][2], B1[2][2];
    const char* cA = (const char*)g.A; const char* cB = (const char*)g.Bt + (size_t)cur.pn * tstep;
    PG8_AOFF(cur);
    S.a_ready(cur);
    PG8_STAGE(PG8_SB(0, 0), cB, voffB); PG8_STAGE(PG8_SA(0, 0), cA, vA0); PG8_STAGE(PG8_SB(0, 1), cB + hstep, voffB); PG8_STAGE(PG8_SA(0, 1), cA, vA1);
    if (wr == 1) PG8_BAR;
    PG8_WAIT_V(4); PG8_BAR;
    PG8_STAGE(PG8_SB(1, 0), cB + kstep, voffB); PG8_STAGE(PG8_SA(1, 0), cA + kstep, vA0); PG8_STAGE(PG8_SB(1, 1), cB + hstep + kstep, voffB);
    PG8_WAIT_V(6); PG8_BAR;
    PG8_STAMP();
    for (;;) {
        const bool has_next = S.next(ui + 1, nxt);
        const char* nB = has_next ? (const char*)g.Bt + (size_t)nxt.pn * tstep : cB;
        for (int t = 0; t < nt; t += 2) {
            const bool last = (t == nt - 2);
            const char* a1 = cA + (size_t)(t + 1) * kstep;
            const char* a2 = cA + (last ? (size_t)0 : (size_t)(t + 2) * kstep); const char* b2 = last ? nB : cB + (size_t)(t + 2) * kstep;
            const char* a3 = a2 + kstep; const char* b3 = b2 + kstep;
            if (last && has_next) S.a_ready(nxt);
            PG8_LDB(B0, 0, 0); PG8_SCHED; PG8_LDA(At, 0, 0); PG8_STAGE(PG8_SA(1, 1), a1, vA1);
            if (last && has_next) PG8_AOFF(nxt);
            PG8_WAIT_L(8); PG8_BAR; PG8_WAIT_L(0); PG8_MMA(0, 0, At, B0); PG8_BAR; PG8_SCHED;
            PG8_LDB(B1, 0, 1); PG8_STAGE(PG8_SB(0, 0), b2, voffB);
            PG8_BAR; PG8_WAIT_L(0); PG8_MMA(0, 1, At, B1); PG8_BAR;
            PG8_LDA(At, 0, 1); PG8_STAGE(PG8_SA(0, 0), a2, vA0);
            PG8_BAR; PG8_WAIT_L(0); PG8_MMA(1, 0, At, B0); PG8_BAR; PG8_SCHED;
            PG8_STAGE(PG8_SB(0, 1), b2 + hstep, voffB);
            PG8_WAIT_V(6); PG8_BAR; PG8_MMA(1, 1, At, B1); PG8_BAR;
            PG8_LDB(B0, 1, 0); PG8_SCHED; PG8_LDA(At, 1, 0); PG8_STAGE(PG8_SA(0, 1), a2, vA1);
            PG8_WAIT_L(8); PG8_BAR; PG8_WAIT_L(0); PG8_MMA(0, 0, At, B0); PG8_BAR; PG8_SCHED;
            PG8_LDB(B1, 1, 1); PG8_STAGE(PG8_SB(1, 0), b3, voffB);
            PG8_BAR; PG8_WAIT_L(0); PG8_MMA(0, 1, At, B1); PG8_BAR;
            PG8_LDA(At, 1, 1); PG8_STAGE(PG8_SA(1, 0), a3, vA0);
            PG8_BAR; PG8_WAIT_L(0); PG8_MMA(1, 0, At, B0); PG8_BAR; PG8_SCHED;
            PG8_STAGE(PG8_SB(1, 1), b3 + hstep, voffB);
            PG8_WAIT_V(6); PG8_BAR; PG8_MMA(1, 1, At, B1); PG8_BAR;
        }
        PG8_STAMP();
        if constexpr (!Epi::AFTER_DRAIN) { E(acc, cur, wr, wc, fr, fq); S.done(cur); }
        PG8_STAMP();
        if (!has_next) break;
#pragma unroll
        for (int a = 0; a < 2; ++a)
#pragma unroll
            for (int b = 0; b < 2; ++b)
#pragma unroll
                for (int m = 0; m < 4; ++m)
#pragma unroll
                    for (int n = 0; n < 2; ++n) acc[a][b][m][n] = (f32x4){0.f, 0.f, 0.f, 0.f};
        cur = nxt; cB = nB; ++ui;
    }
    PG8_WAIT_V(0);
    if (wr == 0) PG8_BAR;
    PG8_BAR;
    if constexpr (Epi::AFTER_DRAIN) { E.fused(acc, cur, wr, wc, fr, fq, lds, wid, lane); S.done(cur); }
    PG8_STAMP();
    if (STAMP && wid == 0) { stamps[lane] = lane < nts ? (((unsigned long long)(unsigned)ts_hi << 32) | (unsigned)ts_lo) : 0ull;
        if (lane == 62) stamps[62] = rt_entry; if (lane == 63) stamps[63] = (unsigned long long)wall_clock64(); }
#undef PG8_STAMP
#undef PG8_SA
#undef PG8_SB
#undef PG8_STAGE
#undef PG8_AOFF
#undef PG8_LDA
#undef PG8_LDB
#undef PG8_MMA
#undef PG8_WAIT_V
#undef PG8_WAIT_L
#undef PG8_BAR
#undef PG8_SCHED
}
}

#define LAS __attribute__((address_space(3)))
#define XB_TMO      128
#define XB_XCNT(j)  (256  + 64 * (j))
#define XB_XSUB(j)  (1280 + 64 * (j))
#define XB_XGEN(j)  (2304 + 64 * (j))
#define XB_TOP      3328
#define XB_TOPGEN   3392
#define XCD_BAR_WORDS 3456
#define XB_SPIN_CAP (1u << 24)

__device__ __forceinline__ unsigned xb_ld(unsigned* p)              { return __hip_atomic_load(p, __ATOMIC_RELAXED, __HIP_MEMORY_SCOPE_AGENT); }
__device__ __forceinline__ unsigned xb_add(unsigned* p, unsigned v) { return __hip_atomic_fetch_add(p, v, __ATOMIC_RELAXED, __HIP_MEMORY_SCOPE_AGENT); }
__device__ __forceinline__ unsigned xb_xcc_id() { return (unsigned)__builtin_amdgcn_s_getreg((3 << 11) | 20) & 0xFu; }
#define XB_SPIN(cond, bar) do { unsigned _sp = 0; while (cond) { __builtin_amdgcn_s_sleep(1); \
    if ((++_sp & 255u) == 0u) { if (xb_ld(&(bar)[XB_TMO])) break; if (_sp > XB_SPIN_CAP) { atomicAdd(&(bar)[XB_TMO], 1u); break; } } } } while (0)

struct XcdBarrier {
    unsigned* bar; unsigned x;
    volatile LAS unsigned* st;
};

__device__ __forceinline__ XcdBarrier xcd_barrier_post(unsigned* bar, volatile LAS unsigned* st) {
    XcdBarrier b; b.bar = bar; b.x = xb_xcc_id(); b.st = st;
    if (hw_tid() == 0) (void)xb_add(&bar[XB_XCNT(b.x)], 1u);
    return b;
}
__device__ __forceinline__ void xcd_barrier_complete(unsigned* bar, unsigned x, unsigned& nloc, unsigned& nx) {
    const unsigned G = gridDim.x * gridDim.y * gridDim.z;
    unsigned sum, cnt, mine, sp = 0u;
    for (;;) {
        sum = 0u; cnt = 0u; mine = 0u;
#pragma unroll
        for (unsigned j = 0; j < 16; ++j) { const unsigned c = xb_ld(&bar[XB_XCNT(j)]); sum += c; cnt += (c > 0u) ? 1u : 0u; mine = (j == x) ? c : mine; }
        if (sum == G) break;
        __builtin_amdgcn_s_sleep(1);
        if ((++sp & 255u) == 0u) { if (xb_ld(&bar[XB_TMO])) break; if (sp > XB_SPIN_CAP) { atomicAdd(&bar[XB_TMO], 1u); break; } }
    }
    nloc = mine > 0u ? mine : 1u; nx = cnt > 0u ? cnt : 1u;
}

__device__ __forceinline__ void xcd_barrier(const XcdBarrier& b) {
    asm volatile("s_waitcnt vmcnt(0)" ::: "memory");
    __syncthreads();
    if (hw_tid() == 0) {
        unsigned* bar = b.bar;
        __builtin_amdgcn_s_waitcnt(0);
        unsigned nloc = b.st[0], nx = b.st[1];
        if (nloc == 0u) { xcd_barrier_complete(bar, b.x, nloc, nx); b.st[0] = nloc; b.st[1] = nx; }
        const unsigned old = xb_add(&bar[XB_XSUB(b.x)], 1u);
        const unsigned gen = old / nloc;
        if (old + 1u == (gen + 1u) * nloc) {
            __builtin_amdgcn_fence(__ATOMIC_RELEASE, "agent");
            asm volatile("s_waitcnt vmcnt(0)" ::: "memory");
            const unsigned og = xb_add(&bar[XB_TOP], 1u);
            const unsigned tg = og / nx;
            if (og + 1u == (tg + 1u) * nx) xb_add(&bar[XB_TOPGEN], 1u);
            else XB_SPIN(xb_ld(&bar[XB_TOPGEN]) == tg, bar);
            __builtin_amdgcn_fence(__ATOMIC_ACQUIRE, "agent");
            xb_add(&bar[XB_XGEN(b.x)], 1u);
            asm volatile("s_waitcnt vmcnt(0)" ::: "memory");
        } else {
            XB_SPIN(xb_ld(&bar[XB_XGEN(b.x)]) == gen, bar);
            __builtin_amdgcn_fence(__ATOMIC_ACQUIRE, "agent");
            asm volatile("s_waitcnt vmcnt(0)" ::: "memory");
        }
    }
    __syncthreads();
}

namespace pg8 {
struct MoeOrder {
    const int* tile_e; int ntiles, G, c;
    __device__ __forceinline__ bool next(int i, Unit& u) const { const long L = (long)i * G + c; if (L >= (long)ntiles * 8) return false; u.pm = (int)(L >> 3); u.pn = tile_e[u.pm] * 8 + (int)(L & 7); return true; }
    __device__ __forceinline__ void a_ready(const Unit&) const {}
    __device__ __forceinline__ void done(const Unit&) const {}
};
struct EpiU {
    static constexpr bool PERM = true, AFTER_DRAIN = false;
    bf16_t* O; int ldc;
    __device__ __forceinline__ void operator()(const f32x4 (&acc)[2][2][4][2], const Unit& u, int wr, int wc, int fr, int fq) const {
        const int row0 = u.pm * BM + wr * 64 + fr, col0 = u.pn * BM + wc * 32 + 8 * fq;
#pragma unroll
        for (int ai = 0; ai < 2; ++ai)
#pragma unroll
            for (int m = 0; m < 4; ++m) { bf16_t* rowp = O + (size_t)(row0 + ai * HALF + m * 16) * ldc + col0;
#pragma unroll
                for (int bj = 0; bj < 2; ++bj) { const f32x4 v0 = acc[ai][bj][m][0], v1 = acc[ai][bj][m][1];
                    u32x4 w; w.x = cvt_pk_bf16(v0[0], v0[1]); w.y = cvt_pk_bf16(v0[2], v0[3]); w.z = cvt_pk_bf16(v1[0], v1[1]); w.w = cvt_pk_bf16(v1[2], v1[3]);
                    *(u32x4*)(rowp + bj * HALF) = w; } }
    }
};
struct EpiRes {
    static constexpr bool PERM = false, AFTER_DRAIN = false;
    float* X; const float* gate;
    __device__ __forceinline__ void operator()(const f32x4 (&acc)[2][2][4][2], const Unit& u, int wr, int wc, int fr, int fq) const {
        const int row0 = u.pm * BM + wr * 64 + fr, col0 = u.pn * BM + wc * 32 + 4 * fq;
#pragma unroll
        for (int ai = 0; ai < 2; ++ai)
#pragma unroll
            for (int m = 0; m < 4; ++m) { const int row = row0 + ai * HALF + m * 16; float* rowp = X + (size_t)row * D + col0; const float* gp = gate + (size_t)mod_row(row) * 12288 + col0;
#pragma unroll
                for (int bj = 0; bj < 2; ++bj)
#pragma unroll
                    for (int n = 0; n < 2; ++n) { const f32x4 gv = *(const f32x4*)(gp + bj * HALF + n * 16); f32x4* xp = (f32x4*)(rowp + bj * HALF + n * 16); *xp = *xp + gv * acc[ai][bj][m][n]; } }
    }
};
struct EpiAct {
    static constexpr bool PERM = true, AFTER_DRAIN = false;
    bf16_t* O; const float* bgu;
    __device__ __forceinline__ void operator()(const f32x4 (&acc)[2][2][4][2], const Unit& u, int wr, int wc, int fr, int fq) const {
        const int e = u.pn >> 3, pnl = u.pn & 7; const int row0 = u.pm * BM + wr * 64 + fr, j0 = wc * 32 + 8 * fq;
        const float* bg = bgu + (size_t)e * 2048 + pnl * 128 + j0;
        f32x4 bglu[2], blin[2];
#pragma unroll
        for (int n = 0; n < 2; ++n) { bglu[n] = *(const f32x4*)(bg + 4 * n); blin[n] = *(const f32x4*)(bg + 1024 + 4 * n); }
#pragma unroll
        for (int ai = 0; ai < 2; ++ai)
#pragma unroll
            for (int m = 0; m < 4; ++m) { bf16_t* rowp = O + (size_t)(row0 + ai * HALF + m * 16) * FE + pnl * 128 + j0;
                float r[8];
#pragma unroll
                for (int n = 0; n < 2; ++n)
#pragma unroll
                    for (int q = 0; q < 4; ++q) { float glu = acc[ai][0][m][n][q] + bglu[n][q], lin = acc[ai][1][m][n][q] + blin[n][q];
                        glu = fminf(glu, 7.0f); lin = fminf(fmaxf(lin, -7.0f), 7.0f);
                        r[n * 4 + q] = glu * (1.0f / (1.0f + __expf(-1.702f * glu))) * (lin + 1.0f); }
                u32x4 w; w.x = cvt_pk_bf16(r[0], r[1]); w.y = cvt_pk_bf16(r[2], r[3]); w.z = cvt_pk_bf16(r[4], r[5]); w.w = cvt_pk_bf16(r[6], r[7]);
                *(u32x4*)rowp = w; }
    }
};
struct EpiDown {
    static constexpr bool PERM = true, AFTER_DRAIN = false;
    bf16_t* O; const float* bdn; const float* prob;
    __device__ __forceinline__ void operator()(const f32x4 (&acc)[2][2][4][2], const Unit& u, int wr, int wc, int fr, int fq) const {
        const int e = u.pn >> 3, pnl = u.pn & 7; const int row0 = u.pm * BM + wr * 64 + fr, col0 = pnl * BM + wc * 32 + 8 * fq;
        f32x4 bv[2][2];
#pragma unroll
        for (int bj = 0; bj < 2; ++bj)
#pragma unroll
            for (int n = 0; n < 2; ++n) bv[bj][n] = *(const f32x4*)(bdn + (size_t)e * D + col0 + bj * HALF + 4 * n);
#pragma unroll
        for (int ai = 0; ai < 2; ++ai)
#pragma unroll
            for (int m = 0; m < 4; ++m) { const int row = row0 + ai * HALF + m * 16; bf16_t* rowp = O + (size_t)row * D + col0; const float pr = prob[row];
#pragma unroll
                for (int bj = 0; bj < 2; ++bj) { const f32x4 v0 = (acc[ai][bj][m][0] + bv[bj][0]) * pr, v1 = (acc[ai][bj][m][1] + bv[bj][1]) * pr;
                    u32x4 w; w.x = cvt_pk_bf16(v0[0], v0[1]); w.y = cvt_pk_bf16(v0[2], v0[3]); w.z = cvt_pk_bf16(v1[0], v1[1]); w.w = cvt_pk_bf16(v1[2], v1[3]);
                    *(u32x4*)(rowp + bj * HALF) = w; } }
    }
};

struct OrderAll {
    StaticOrder so; const int* tile_e; int ntiles, G, c, moe;
    __device__ __forceinline__ bool next(int i, Unit& u) const {
        if (!moe) return so.next(i, u);
        const long L = (long)i * G + c; if (L >= (long)ntiles * 8) return false; u.pm = (int)(L >> 3); u.pn = tile_e[u.pm] * 8 + (int)(L & 7); return true; }
    __device__ __forceinline__ void a_ready(const Unit&) const {}
    __device__ __forceinline__ void done(const Unit&) const {}
};
struct EpiAll {
    static constexpr bool AFTER_DRAIN = false;
    int mode; bool perm; void* O; const float* a1; const float* a2; int ldc;
    __device__ __forceinline__ void operator()(const f32x4 (&acc)[2][2][4][2], const Unit& u, int wr, int wc, int fr, int fq) const {
        asm volatile("" : "+v"(fr), "+v"(fq));
        if (mode == 0) { EpiU e{(bf16_t*)O, ldc}; e(acc, u, wr, wc, fr, fq); }
        else if (mode == 1) { EpiRes e{(float*)O, a1}; e(acc, u, wr, wc, fr, fq); }
        else if (mode == 2) { EpiAct e{(bf16_t*)O, a1}; e(acc, u, wr, wc, fr, fq); }
        else { EpiDown e{(bf16_t*)O, a1, a2}; e(acc, u, wr, wc, fr, fq); }
    }
};
}


__device__ __forceinline__ float fsigm(float x) { return __builtin_amdgcn_rcpf(1.0f + __expf(-x)); }
constexpr int NTHREADS = 512;
typedef short bf16x8_t __attribute__((ext_vector_type(8)));
typedef float f32x16_t __attribute__((ext_vector_type(16)));
typedef float f32x4_t __attribute__((ext_vector_type(4)));
typedef unsigned u32x4_t __attribute__((ext_vector_type(4)));
typedef unsigned u32x2_t __attribute__((ext_vector_type(2)));
constexpr int HY_PAD = 512, HY_ZS = SEQ + 2 * HY_PAD;
constexpr int HYL_TR = 0, HYL_Z0 = 65536, HYL_Z1 = HYL_Z0 + NB * HY_ZS * 2, HYL_END = HYL_Z1 + NB * HY_ZS * 2;
static_assert(SEQ == 4096 && NB == 4, "hyena unit geometry");
__device__ __forceinline__ void hy_unit(PREF p, int l, int c, LAS unsigned char* L) {
    int tid = hw_tid(); asm volatile("" : "+v"(tid)); const int lane = tid & 63, w = __builtin_amdgcn_readfirstlane(tid >> 6);
    LAS unsigned short* TR = (LAS unsigned short*)(L + HYL_TR);
    LAS unsigned short* Z0 = (LAS unsigned short*)(L + HYL_Z0);
    LAS unsigned short* Z1 = (LAS unsigned short*)(L + HYL_Z1);
    const unsigned short* ZT = WSH(O_ZT);
    __syncthreads();
    {   const u32x4_t* tg0 = (const u32x4_t*)(WSH(O_TRB) + ((size_t)(l * 2 + 0) * 512 + c) * 8192); const u32x4_t* tg1 = (const u32x4_t*)(WSH(O_TRB) + ((size_t)(l * 2 + 1) * 512 + c) * 8192);
        for (int i = tid; i < 1024; i += NTHREADS) { ((LAS u32x4_t*)TR)[i] = tg0[i]; ((LAS u32x4_t*)TR)[2048 + i] = tg1[i]; }
        for (int i = tid; i < 2 * 4096; i += NTHREADS) { const int o2 = i >> 12, q = i & 4095;
            const unsigned short* src = WSH(O_TRB) + ((size_t)(l * 2 + o2) * 512 + c) * 8192; const unsigned lo = src[2 * q + 1], hi = q < 4095 ? src[2 * q + 2] : 0u;
            ((LAS unsigned*)TR)[o2 * 8192 + 4096 + q] = lo | (hi << 16); }
        const u32x4_t zero = {0u, 0u, 0u, 0u};
        for (int i = tid; i < 2 * NB * 2 * 64; i += NTHREADS) { const int q = i & 63, side = (i >> 6) & 1, b = (i >> 7) % NB, buf = i / (128 * NB);
            ((LAS u32x4_t*)((buf ? Z1 : Z0) + b * HY_ZS + (side ? HY_PAD + SEQ : 0)))[q] = zero; }
        for (int i = tid; i < NB * (SEQ / 8); i += NTHREADS) { const int b = i / (SEQ / 8), q = i % (SEQ / 8);
            ((LAS u32x4_t*)(Z0 + b * HY_ZS + HY_PAD))[q] = ((const u32x4_t*)(ZT + ((size_t)(0 * NB + b) * 512 + c) * SEQ))[q]; }
    }
    __syncthreads();
    const int i16 = lane & 15, g = lane >> 4, bb = i16 >> 2, isub = i16 & 3;
#pragma unroll 1
    for (int o = 0; o < 2; ++o) {
        LAS unsigned short* Zin = o == 0 ? Z0 : Z1;
        LAS unsigned short* TRo = TR + o * 16384;
        f32x4_t acc[4][2];
#pragma unroll
        for (int ct = 0; ct < 4; ++ct) { acc[ct][0] = (f32x4_t){0.f, 0.f, 0.f, 0.f}; acc[ct][1] = (f32x4_t){0.f, 0.f, 0.f, 0.f}; }
        const int d_lo = 16 * w - 127, d_hi = 16 * w + 15;
        const int y0 = 4095 - 32 * d_lo - i16 + 8 * g, par = y0 & 1;
        LAS unsigned short* ya = TRo + par * 8192 + (y0 - par);
        LAS unsigned short* zb = Zin + bb * HY_ZS + HY_PAD + (16 * w + isub - d_lo) * 32 + 8 * g;
        bf16x8_t r1[4], r2[4], r3[4];
#pragma unroll
        for (int j = 0; j < 4; ++j) { r1[j] = *(LAS bf16x8_t*)(zb + 1 * 128 - 32 * j); r2[j] = *(LAS bf16x8_t*)(zb + 2 * 128 - 32 * j); r3[j] = *(LAS bf16x8_t*)(zb + 3 * 128 - 32 * j); }
#pragma unroll 1
        for (int d = d_lo; d + 3 <= d_hi; d += 4) {
#pragma unroll
            for (int j = 0; j < 4; ++j, ya -= 32, zb -= 32) {
                u32x4_t a0u, a1u;
#pragma unroll
                for (int k = 0; k < 4; ++k) { a0u[k] = ((volatile LAS unsigned*)ya)[k]; a1u[k] = ((volatile LAS unsigned*)ya)[k - 8]; }
                const bf16x8_t a0 = __builtin_bit_cast(bf16x8_t, a0u), a1 = __builtin_bit_cast(bf16x8_t, a1u);
                const bf16x8_t nb = *(LAS bf16x8_t*)(zb);
                acc[0][0] = __builtin_amdgcn_mfma_f32_16x16x32_bf16(a0, nb, acc[0][0], 0, 0, 0); acc[0][1] = __builtin_amdgcn_mfma_f32_16x16x32_bf16(a1, nb, acc[0][1], 0, 0, 0);
                acc[1][0] = __builtin_amdgcn_mfma_f32_16x16x32_bf16(a0, r1[j], acc[1][0], 0, 0, 0); acc[1][1] = __builtin_amdgcn_mfma_f32_16x16x32_bf16(a1, r1[j], acc[1][1], 0, 0, 0);
                acc[2][0] = __builtin_amdgcn_mfma_f32_16x16x32_bf16(a0, r2[j], acc[2][0], 0, 0, 0); acc[2][1] = __builtin_amdgcn_mfma_f32_16x16x32_bf16(a1, r2[j], acc[2][1], 0, 0, 0);
                acc[3][0] = __builtin_amdgcn_mfma_f32_16x16x32_bf16(a0, r3[j], acc[3][0], 0, 0, 0); acc[3][1] = __builtin_amdgcn_mfma_f32_16x16x32_bf16(a1, r3[j], acc[3][1], 0, 0, 0);
                r3[j] = r2[j]; r2[j] = r1[j]; r1[j] = nb; }
        }
#pragma unroll 1
        for (int d = d_lo + 4 * ((d_hi - d_lo + 1) / 4); d <= d_hi; ++d, ya -= 32, zb -= 32) {
            u32x4_t a0u, a1u;
#pragma unroll
            for (int k = 0; k < 4; ++k) { a0u[k] = ((volatile LAS unsigned*)ya)[k]; a1u[k] = ((volatile LAS unsigned*)ya)[k - 8]; }
            const bf16x8_t a0 = __builtin_bit_cast(bf16x8_t, a0u), a1 = __builtin_bit_cast(bf16x8_t, a1u);
#pragma unroll
            for (int ct = 0; ct < 4; ++ct) { const bf16x8_t bf = *(LAS bf16x8_t*)(zb + ct * 128);
                acc[ct][0] = __builtin_amdgcn_mfma_f32_16x16x32_bf16(a0, bf, acc[ct][0], 0, 0, 0);
                acc[ct][1] = __builtin_amdgcn_mfma_f32_16x16x32_bf16(a1, bf, acc[ct][1], 0, 0, 0); }
        }
        const float bias = p.in[I_hy_bias][l * 1024 + o * 512 + c];
        const unsigned short* gate = ZT + ((size_t)((o + 1) * NB + bb) * 512 + c) * SEQ;
#pragma unroll 1
        for (int ct = 0; ct < 4; ++ct) {
#pragma unroll
            for (int hh = 0; hh < 2; ++hh) {
                const int t4 = (16 * w + 4 * ct + isub) * 32 + 16 * hh + 4 * g;
                const u32x2_t zi = *(LAS u32x2_t*)(Zin + bb * HY_ZS + HY_PAD + t4); const u32x2_t gt = *(const u32x2_t*)(gate + t4);
                float r[4];
#pragma unroll
                for (int q = 0; q < 4; ++q) { const unsigned zw = q < 2 ? zi.x : zi.y, gw = q < 2 ? gt.x : gt.y;
                    const float zv = bf2f((unsigned short)((q & 1) ? (zw >> 16) : (zw & 0xffffu))), gv = bf2f((unsigned short)((q & 1) ? (gw >> 16) : (gw & 0xffffu)));
                    r[q] = gv * (acc[0][hh][q] + bias * zv); }
                if (o == 0) { u32x2_t ov; ov.x = (unsigned)f2bf(r[0]) | ((unsigned)f2bf(r[1]) << 16); ov.y = (unsigned)f2bf(r[2]) | ((unsigned)f2bf(r[3]) << 16); *(LAS u32x2_t*)(Z1 + bb * HY_ZS + HY_PAD + t4) = ov; }
                else { unsigned short* cp = WSH(O_CAT) + (size_t)(bb * SEQ + t4) * D + c;
#pragma unroll
                    for (int q = 0; q < 4; ++q) cp[(size_t)q * D] = f2bf(r[q]); }
            }
            acc[0][0] = acc[1][0]; acc[0][1] = acc[1][1]; acc[1][0] = acc[2][0]; acc[1][1] = acc[2][1]; acc[2][0] = acc[3][0]; acc[2][1] = acc[3][1];
        }
        __syncthreads();
    }
}
__device__ __forceinline__ void hy_units(PREF p, int l, LAS unsigned char* L, int b0, int nb) { int bl = blockIdx.x; asm volatile("" : "+s"(bl)); bl -= b0; if (bl < 0 || bl >= nb) return; for (int c = bl; c < 512; c += nb) hy_unit(p, l, c, L); }


__device__ __forceinline__ unsigned pk_bf16(float a, float b) { return (unsigned)f2bf(a) | ((unsigned)f2bf(b) << 16); }

__device__ __forceinline__ void cvt_item(const float* W, int K, int N, unsigned short* WT, int item, int permute_gu, LAS float* scr, int lane) {
    const int nblk = N / 32, kb = item / nblk, nb = item % nblk, k0 = 64 * kb, n0 = 32 * nb;
#pragma unroll 8
    for (int i = 0; i < 32; ++i) { const int kk = 2 * i + (lane >> 5); scr[kk * 33 + (lane & 31)] = W[(size_t)(k0 + kk) * N + n0 + (lane & 31)]; }
    asm volatile("s_waitcnt lgkmcnt(0)" ::: "memory");
    int nd0 = n0; if (permute_gu) { const int bj = n0 / 1024, r = n0 % 1024; nd0 = (r / 128) * 256 + bj * 128 + r % 128; }
    const int c = lane & 7;
#pragma unroll
    for (int j = 0; j < 4; ++j) { const int n = (lane >> 3) + 8 * j; const LAS float* sp = scr + (8 * c) * 33 + n;
        u32x4_t o; o.x = pk_bf16(sp[0 * 33], sp[1 * 33]); o.y = pk_bf16(sp[2 * 33], sp[3 * 33]); o.z = pk_bf16(sp[4 * 33], sp[5 * 33]); o.w = pk_bf16(sp[6 * 33], sp[7 * 33]);
        *(u32x4_t*)(WT + (size_t)(nd0 + n) * K + k0 + 8 * c) = o; }
    asm volatile("s_waitcnt lgkmcnt(0)" ::: "memory");
}
constexpr int CVT_IN = (D / 64) * (DIN / 32), CVT_OUT = (D / 64) * (D / 32), CVT_GU = (D / 64) * (2048 / 32), CVT_DN = (FE / 64) * (D / 32);
constexpr int CVT_PRO = 2 * CVT_IN + 2 * CVT_OUT, CVT_NIT = CVT_PRO + 2 * NE * CVT_GU + 2 * NE * CVT_DN;
__device__ __forceinline__ void cvt_all(PREF p, LAS unsigned char* L, int it_lo, int it_hi, int b0, int nb) {
    int tid = hw_tid(), bl = blockIdx.x; asm volatile("" : "+v"(tid), "+s"(bl)); bl -= b0; if (bl < 0 || bl >= nb) return; const int lane = tid & 63, w = __builtin_amdgcn_readfirstlane(tid >> 6);
    LAS float* scr = (LAS float*)(L + w * 8704);
    constexpr int I_IN = (D / 64) * (DIN / 32), I_OUT = (D / 64) * (D / 32), I_GU = (D / 64) * (2048 / 32), I_DN = (FE / 64) * (D / 32);
    constexpr int NIT = 2 * I_IN + 2 * I_OUT + 2 * NE * I_GU + 2 * NE * I_DN;
    static_assert(NIT == CVT_NIT, "cvt item count");
    for (int it = it_lo + bl * 8 + w; it < it_hi; it += nb * 8) {
        int r = it;
        if (r < 2 * I_IN) { const int l = r / I_IN; cvt_item(p.in[I_w_in] + (size_t)l * D * DIN, D, DIN, WSH(O_WIN) + (size_t)l * DIN * D, r % I_IN, 0, scr, lane); continue; } r -= 2 * I_IN;
        if (r < 2 * I_OUT) { const int l = r / I_OUT; cvt_item(p.in[I_w_out] + (size_t)l * D * D, D, D, WSH(O_WOUT) + (size_t)l * D * D, r % I_OUT, 0, scr, lane); continue; } r -= 2 * I_OUT;
        if (r < 2 * NE * I_GU) { const int le = r / I_GU; cvt_item(p.in[I_moe_w_gu] + (size_t)le * D * 2048, D, 2048, WSH(O_WGU) + (size_t)le * 2048 * D, r % I_GU, 1, scr, lane); continue; } r -= 2 * NE * I_GU;
        { const int le = r / I_DN; cvt_item(p.in[I_moe_w_dn] + (size_t)le * FE * D, FE, D, WSH(O_WDN) + (size_t)le * D * FE, r % I_DN, 0, scr, lane); }
    }
}


constexpr int RGL_WT = 0, RGL_XC = 128 * 72 * 2, RGL_XCF = RGL_XC + 64 * 72 * 2, RGL_AA = RGL_XCF + 64 * 64 * 4, RGL_BB = RGL_AA + 64 * 64 * 4, RGL_END = RGL_BB + 64 * 64 * 4;
__device__ __forceinline__ void rg_load_x(PREF p, int d, int b, int h, int tile, int pos, int c8, bf16x8_t (&xin)[4]) {
    const int m = scan_tok(d, b, tile * 64 + pos);
#pragma unroll
    for (int j = 0; j < 4; ++j) { const int pm = tok_prev(m, d, 3 - j); xin[j] = (bf16x8_t){0, 0, 0, 0, 0, 0, 0, 0};
        if (pm >= 0) xin[j] = *(const bf16x8_t*)(WSH(O_U) + (size_t)pm * DIN + U_RG + h * 64 + c8 * 8); }
}
__device__ __forceinline__ void rg_unit(PREF p, int l, int u, LAS unsigned char* L) {
    int tid = hw_tid(); asm volatile("" : "+v"(tid)); const int lane = tid & 63, w = __builtin_amdgcn_readfirstlane(tid >> 6), n = lane & 15, kg = lane >> 4;
    const int h = u % 8, b = (u / 8) % NB, d = u / (8 * NB), ld = l * 2 + d;
    LAS unsigned short* WT = (LAS unsigned short*)(L + RGL_WT); LAS unsigned short* XC = (LAS unsigned short*)(L + RGL_XC);
    LAS float* XCF = (LAS float*)(L + RGL_XCF); LAS float* AA = (LAS float*)(L + RGL_AA); LAS float* BB = (LAS float*)(L + RGL_BB);
    __syncthreads();
    {   const float* wa = p.in[I_rg_wa] + ((size_t)ld * 8 + h) * 4096; const float* wx = p.in[I_rg_wx] + ((size_t)ld * 8 + h) * 4096;
        for (int e = tid; e < 8192; e += NTHREADS) { const int j = e & 63, i = (e >> 6) & 63, g = e >> 12; WT[(g * 64 + j) * 72 + i] = f2bf((g ? wx : wa)[i * 64 + j]); } }
    const int pos = tid >> 3, c8 = tid & 7;
    float cw[4][8], cb[8];
#pragma unroll
    for (int j = 0; j < 4; ++j)
#pragma unroll
        for (int i = 0; i < 8; ++i) cw[j][i] = p.in[I_rg_conv_w][((size_t)ld * 4 + j) * G + h * 64 + c8 * 8 + i];
#pragma unroll
    for (int i = 0; i < 8; ++i) cb[i] = p.in[I_rg_conv_b][ld * G + h * 64 + c8 * 8 + i];
    const int mt = w & 3, jp = w >> 2;
    float ba[2], bx[2], sl[2];
#pragma unroll
    for (int t = 0; t < 2; ++t) { const int c = h * 64 + 16 * (2 * jp + t) + n; ba[t] = p.in[I_rg_ba][ld * G + c]; bx[t] = p.in[I_rg_bx][ld * G + c]; sl[t] = -8.0f * softplusf(-p.in[I_rg_lambda][ld * G + c]); }
    float hst = 0.f;
    bf16x8_t xin[4]; rg_load_x(p, d, b, h, 0, pos, c8, xin);
#pragma unroll 1
    for (int tile = 0; tile < SCANL / 64; ++tile) {
        __syncthreads();
        {   float acc[8];
#pragma unroll
            for (int i = 0; i < 8; ++i) acc[i] = cb[i];
#pragma unroll
            for (int j = 0; j < 4; ++j) {
#pragma unroll
                for (int i = 0; i < 8; ++i) acc[i] += cw[j][i] * bf2f((unsigned short)xin[j][i]); }
            if (tile + 1 < SCANL / 64) rg_load_x(p, d, b, h, tile + 1, pos, c8, xin);
            u32x4_t o = {pk_bf16(acc[0], acc[1]), pk_bf16(acc[2], acc[3]), pk_bf16(acc[4], acc[5]), pk_bf16(acc[6], acc[7])};
            *(LAS u32x4_t*)(XC + pos * 72 + c8 * 8) = o;
            *(LAS f32x4_t*)(XCF + pos * 64 + c8 * 8) = (f32x4_t){acc[0], acc[1], acc[2], acc[3]}; *(LAS f32x4_t*)(XCF + pos * 64 + c8 * 8 + 4) = (f32x4_t){acc[4], acc[5], acc[6], acc[7]};
        }
        __syncthreads();
        f32x4_t ga[2], gx[2];
#pragma unroll
        for (int t = 0; t < 2; ++t) { ga[t] = (f32x4_t){0.f, 0.f, 0.f, 0.f}; gx[t] = ga[t]; }
#pragma unroll
        for (int ks = 0; ks < 2; ++ks) { const bf16x8_t xa = *(LAS bf16x8_t*)(XC + (16 * mt + n) * 72 + ks * 32 + 8 * kg);
#pragma unroll
            for (int t = 0; t < 2; ++t) { const int jt = 2 * jp + t;
                ga[t] = __builtin_amdgcn_mfma_f32_16x16x32_bf16(xa, *(LAS bf16x8_t*)(WT + (16 * jt + n) * 72 + ks * 32 + 8 * kg), ga[t], 0, 0, 0);
                gx[t] = __builtin_amdgcn_mfma_f32_16x16x32_bf16(xa, *(LAS bf16x8_t*)(WT + (64 + 16 * jt + n) * 72 + ks * 32 + 8 * kg), gx[t], 0, 0, 0); } }
#pragma unroll
        for (int t = 0; t < 2; ++t)
#pragma unroll
            for (int q = 0; q < 4; ++q) { const int ps = 16 * mt + 4 * kg + q, j = 16 * (2 * jp + t) + n;
                const float r = fsigm(ga[t][q] + ba[t]), ig = fsigm(gx[t][q] + bx[t]); const float av = __expf(sl[t] * r);
                AA[ps * 64 + j] = av; BB[ps * 64 + j] = __builtin_sqrtf(fmaxf(1.0f - av * av, 0.0f)) * (ig * XCF[ps * 64 + j]); }
        __syncthreads();
        if (w == 0) {
#pragma unroll 8
            for (int ps = 0; ps < 64; ++ps) { hst = AA[ps * 64 + lane] * hst + BB[ps * 64 + lane];
                WSF(O_RGH)[((size_t)d * T + scan_tok(d, b, tile * 64 + ps)) * G + h * 64 + lane] = hst; }
        }
    }
}
__device__ __forceinline__ void rg_units(PREF p, int l, LAS unsigned char* L) { int bl = blockIdx.x; asm volatile("" : "+s"(bl)); for (int u = bl; u < 2 * NB * 8; u += gridDim.x) rg_unit(p, l, u, L); }

constexpr int RT_LD = 136;
constexpr int RTL_Q = 0, RTL_K = 128 * RT_LD * 2, RTL_VT = 2 * RTL_K, RTL_KT = 3 * RTL_K, RTL_END = 4 * RTL_K;
static_assert(RTL_END <= 147456, "retention LDS map");
__device__ __forceinline__ void rt_unit_a(PREF p, int l, int u, LAS unsigned char* L) {
    int tid = hw_tid(); asm volatile("" : "+v"(tid)); const int lane = tid & 63, w = __builtin_amdgcn_readfirstlane(tid >> 6);
    const int ch = u >> 2, h = u & 3, m0 = ch * 128, n = lane & 15, kg = lane >> 4;
    LAS unsigned short* Ql = (LAS unsigned short*)(L + RTL_Q); LAS unsigned short* Kl = (LAS unsigned short*)(L + RTL_K);
    LAS unsigned short* VTl = (LAS unsigned short*)(L + RTL_VT); LAS unsigned short* KTl = (LAS unsigned short*)(L + RTL_KT);
    const float lg0 = rt_lg(p, l, 0, h) * 1.4426950408889634f, lg1 = rt_lg(p, l, 1, h) * 1.4426950408889634f;
    __syncthreads();
    {   const int row = tid >> 2, sl = tid & 3, m = m0 + row; const unsigned short* ub = WSH(O_U) + (size_t)m * DIN + U_RT + h * 128;
        const bool lat = m < TL; const int t = m % SEQ; const float pos = (sl < 2) ? (float)(t / 64) : (float)(t % 64);
        const int partner = sl ^ 1;
#pragma unroll
        for (int c8 = 0; c8 < 4; ++c8) {
            float qo[8], ko[8];
#pragma unroll
            for (int j = 0; j < 8; ++j) { const int i = c8 * 8 + j;
                float q = bf2f(ub[sl * 32 + i]), k = bf2f(ub[G + sl * 32 + i]);
                if (lat) { const float qp = bf2f(ub[partner * 32 + i]), kp = bf2f(ub[G + partner * 32 + i]);
                    float sn, cs; sincosf(pos * exp2f(-(float)i * (13.287712379549449f / 32.0f)), &sn, &cs);
                    if ((sl & 1) == 0) { q = q * cs - qp * sn; k = k * cs - kp * sn; } else { q = qp * sn + q * cs; k = kp * sn + k * cs; } }
                qo[j] = q; ko[j] = k * 0.08838834764831845f; }
            const u32x4_t qv = {pk_bf16(qo[0], qo[1]), pk_bf16(qo[2], qo[3]), pk_bf16(qo[4], qo[5]), pk_bf16(qo[6], qo[7])}, kv = {pk_bf16(ko[0], ko[1]), pk_bf16(ko[2], ko[3]), pk_bf16(ko[4], ko[5]), pk_bf16(ko[6], ko[7])};
            *(LAS u32x4_t*)(Ql + row * RT_LD + sl * 32 + c8 * 8) = qv; *(LAS u32x4_t*)(Kl + row * RT_LD + sl * 32 + c8 * 8) = kv;
            *(u32x4_t*)(WSH(O_RQB) + (size_t)m * G + h * 128 + sl * 32 + c8 * 8) = qv;
        }
#pragma unroll 8
        for (int i = 0; i < 32; ++i) VTl[(sl * 32 + i) * RT_LD + row] = ub[2 * G + sl * 32 + i];
    }
    __syncthreads();
    f32x4_t st[8];
#pragma unroll
    for (int t = 0; t < 8; ++t) st[t] = (f32x4_t){0.f, 0.f, 0.f, 0.f};
#pragma unroll
    for (int ks = 0; ks < 4; ++ks) { const bf16x8_t bq = *(LAS bf16x8_t*)(Ql + (16 * w + n) * RT_LD + ks * 32 + 8 * kg);
#pragma unroll
        for (int t = 0; t < 8; ++t) st[t] = __builtin_amdgcn_mfma_f32_16x16x32_bf16(*(LAS bf16x8_t*)(Kl + (16 * t + n) * RT_LD + ks * 32 + 8 * kg), bq, st[t], 0, 0, 0); }
    bf16x8_t pa[4];
    {   const int i = 16 * w + n;
#pragma unroll
        for (int s2 = 0; s2 < 4; ++s2) { unsigned pk[4];
#pragma unroll
            for (int hh = 0; hh < 2; ++hh) { const int t = 2 * s2 + hh; float v[4];
#pragma unroll
                for (int q = 0; q < 4; ++q) { const int j = 16 * t + 4 * kg + q; const float wgt = j <= i ? exp2f(lg0 * (float)(i - j)) : exp2f(lg1 * (float)(j - i)); v[q] = st[t][q] * wgt; }
                pk[hh * 2] = pk_bf16(v[0], v[1]); pk[hh * 2 + 1] = pk_bf16(v[2], v[3]); }
            u32x4_t x = {pk[0], pk[1], pk[2], pk[3]}; pa[s2] = __builtin_bit_cast(bf16x8_t, x); }
    }
#pragma unroll
    for (int et = 0; et < 8; ++et) { f32x4_t o = {0.f, 0.f, 0.f, 0.f};
#pragma unroll
        for (int s2 = 0; s2 < 4; ++s2) { const LAS unsigned short* vp = VTl + (16 * et + n) * RT_LD + 32 * s2 + 4 * kg;
            const u32x2_t lo = *(LAS u32x2_t*)vp, hi = *(LAS u32x2_t*)(vp + 16); u32x4_t x = {lo.x, lo.y, hi.x, hi.y};
            o = __builtin_amdgcn_mfma_f32_16x16x32_bf16(pa[s2], __builtin_bit_cast(bf16x8_t, x), o, 0, 0, 0); }
#pragma unroll
        for (int q = 0; q < 4; ++q) WSF(O_RO)[(size_t)(m0 + 16 * w + 4 * kg + q) * G + h * 128 + 16 * et + n] = o[q]; }
#pragma unroll 1
    for (int d = 0; d < 2; ++d) {
        __syncthreads();
        {   const int row = tid >> 2, sl = tid & 3; const float dec = exp2f((d == 0 ? lg0 : lg1) * (float)(d == 0 ? 127 - row : row));
#pragma unroll 8
            for (int i = 0; i < 32; ++i) KTl[(sl * 32 + i) * RT_LD + row] = f2bf(bf2f(Kl[row * RT_LD + sl * 32 + i]) * dec); }
        __syncthreads();
        float* kvo = WSF(O_KV) + (((size_t)d * NCHUNK + ch) * 4 + h) * 16384;
#pragma unroll 1
        for (int dt = 0; dt < 8; ++dt) { f32x4_t o = {0.f, 0.f, 0.f, 0.f};
#pragma unroll
            for (int ks = 0; ks < 4; ++ks)
                o = __builtin_amdgcn_mfma_f32_16x16x32_bf16(*(LAS bf16x8_t*)(VTl + (16 * w + n) * RT_LD + ks * 32 + 8 * kg), *(LAS bf16x8_t*)(KTl + (16 * dt + n) * RT_LD + ks * 32 + 8 * kg), o, 0, 0, 0);
#pragma unroll
            for (int q = 0; q < 4; ++q) kvo[(size_t)(16 * w + 4 * kg + q) * 128 + 16 * dt + n] = o[q]; }
    }
}
__device__ __forceinline__ void rt_units_a(PREF p, int l, LAS unsigned char* L, int b0, int nb) { int bl = blockIdx.x; asm volatile("" : "+s"(bl)); bl -= b0; if (bl < 0 || bl >= nb) return; for (int u = bl; u < NCHUNK * 4; u += nb) rt_unit_a(p, l, u, L); }
__device__ __forceinline__ void rt_unit_c(PREF p, int l, int u, LAS unsigned char* L) {
    int tid = hw_tid(); asm volatile("" : "+v"(tid)); const int lane = tid & 63, w = __builtin_amdgcn_readfirstlane(tid >> 6);
    const int ch = u >> 2, h = u & 3, m0 = ch * 128, n = lane & 15, kg = lane >> 4;
    if (l == DEPTH - 1 && m0 >= TL) return;
    const float lg0 = rt_lg(p, l, 0, h) * 1.4426950408889634f, lg1 = rt_lg(p, l, 1, h) * 1.4426950408889634f;
    bf16x8_t qa[4];
#pragma unroll
    for (int ks = 0; ks < 4; ++ks) qa[ks] = *(const bf16x8_t*)(WSH(O_RQB) + (size_t)(m0 + 16 * w + n) * G + h * 128 + ks * 32 + 8 * kg);
    f32x4_t o[8];
#pragma unroll
    for (int et = 0; et < 8; ++et) {
        f32x4_t c0 = {0.f, 0.f, 0.f, 0.f}, c1 = c0;
        const float* s0 = WSF(O_SPREV) + (((size_t)0 * NCHUNK + ch) * 4 + h) * 16384 + (size_t)(16 * et + n) * 128; const float* s1 = s0 + (size_t)NCHUNK * 4 * 16384;
#pragma unroll
        for (int ks = 0; ks < 4; ++ks) { const f32x4_t a0 = *(const f32x4_t*)(s0 + ks * 32 + 8 * kg), a1 = *(const f32x4_t*)(s0 + ks * 32 + 8 * kg + 4), b0 = *(const f32x4_t*)(s1 + ks * 32 + 8 * kg), b1 = *(const f32x4_t*)(s1 + ks * 32 + 8 * kg + 4);
            u32x4_t x0 = {pk_bf16(a0[0], a0[1]), pk_bf16(a0[2], a0[3]), pk_bf16(a1[0], a1[1]), pk_bf16(a1[2], a1[3])}, x1 = {pk_bf16(b0[0], b0[1]), pk_bf16(b0[2], b0[3]), pk_bf16(b1[0], b1[1]), pk_bf16(b1[2], b1[3])};
            c0 = __builtin_amdgcn_mfma_f32_16x16x32_bf16(qa[ks], __builtin_bit_cast(bf16x8_t, x0), c0, 0, 0, 0);
            c1 = __builtin_amdgcn_mfma_f32_16x16x32_bf16(qa[ks], __builtin_bit_cast(bf16x8_t, x1), c1, 0, 0, 0); }
#pragma unroll
        for (int q = 0; q < 4; ++q) { const int i = 16 * w + 4 * kg + q;
            o[et][q] = WSF(O_RO)[(size_t)(m0 + i) * G + h * 128 + 16 * et + n] + exp2f(lg0 * (float)(i + 1)) * c0[q] + exp2f(lg1 * (float)(128 - i)) * c1[q]; }
    }
#pragma unroll
    for (int q = 0; q < 4; ++q) {
        float sm = 0.f;
#pragma unroll
        for (int et = 0; et < 8; ++et) sm += o[et][q];
#pragma unroll
        for (int off = 1; off < 16; off <<= 1) sm += __shfl_xor(sm, off);
        const float mean = sm * (1.0f / 128.0f); float vs = 0.f;
#pragma unroll
        for (int et = 0; et < 8; ++et) { const float dd = o[et][q] - mean; vs += dd * dd; }
#pragma unroll
        for (int off = 1; off < 16; off <<= 1) vs += __shfl_xor(vs, off);
        const float rstd = 1.0f / sqrtf(vs * (1.0f / 128.0f) + 1e-6f); const int m = m0 + 16 * w + 4 * kg + q;
#pragma unroll
        for (int et = 0; et < 8; ++et) { const int c = h * 128 + 16 * et + n;
            WSH(O_CAT)[(size_t)m * D + 3 * G + c] = f2bf((o[et][q] - mean) * rstd * p.in[I_rt_gn_w][l * G + c] * siluf(ldu(p, m, U_RT + 3 * G + c))); }
    }
}
__device__ __forceinline__ void rt_units_c(PREF p, int l, LAS unsigned char* L) { int bl = blockIdx.x; asm volatile("" : "+s"(bl)); for (int u = bl; u < NCHUNK * 4; u += gridDim.x) rt_unit_c(p, l, u, L); }


__device__ __forceinline__ float wave_sum64(float v) {
#pragma unroll
    for (int off = 1; off < 64; off <<= 1) v += __shfl_xor(v, off);
    return v;
}
__device__ __forceinline__ void norm1_rows(PREF p, int l) {
    int tid = hw_tid(), bl = blockIdx.x; asm volatile("" : "+v"(tid), "+s"(bl)); const int lane = tid & 63, w = __builtin_amdgcn_readfirstlane(tid >> 6);
    const int nrows = l == DEPTH ? TL : T;
#pragma unroll 1
    for (int m = bl * 8 + w; m < nrows; m += (int)gridDim.x * 8) {
        float* xr = WSF(O_X) + (size_t)m * D; const int r = mod_row(m);
        f32x4_t x[8];
#pragma unroll
        for (int j = 0; j < 8; ++j) x[j] = *(const f32x4_t*)(xr + 256 * j + 4 * lane);
        if (l > 0 && m < moe_ntok(l - 1)) {
            const float* g5 = modp(p, l - 1, r, 5); const int* ts = WSI(O_TOKSLOT) + m * 4;
            const unsigned short* o0 = WSH(O_OSLOT) + (size_t)ts[0] * D, *o1 = WSH(O_OSLOT) + (size_t)ts[1] * D, *o2 = WSH(O_OSLOT) + (size_t)ts[2] * D, *o3 = WSH(O_OSLOT) + (size_t)ts[3] * D;
#pragma unroll
            for (int j = 0; j < 8; ++j) { const int c = 256 * j + 4 * lane;
                const u32x2_t r0 = *(const u32x2_t*)(o0 + c), r1 = *(const u32x2_t*)(o1 + c), r2 = *(const u32x2_t*)(o2 + c), r3 = *(const u32x2_t*)(o3 + c);
                f32x4_t sm;
                sm[0] = (bf2f((unsigned short)(r0.x & 0xffffu)) + bf2f((unsigned short)(r1.x & 0xffffu))) + (bf2f((unsigned short)(r2.x & 0xffffu)) + bf2f((unsigned short)(r3.x & 0xffffu)));
                sm[1] = (bf2f((unsigned short)(r0.x >> 16)) + bf2f((unsigned short)(r1.x >> 16))) + (bf2f((unsigned short)(r2.x >> 16)) + bf2f((unsigned short)(r3.x >> 16)));
                sm[2] = (bf2f((unsigned short)(r0.y & 0xffffu)) + bf2f((unsigned short)(r1.y & 0xffffu))) + (bf2f((unsigned short)(r2.y & 0xffffu)) + bf2f((unsigned short)(r3.y & 0xffffu)));
                sm[3] = (bf2f((unsigned short)(r0.y >> 16)) + bf2f((unsigned short)(r1.y >> 16))) + (bf2f((unsigned short)(r2.y >> 16)) + bf2f((unsigned short)(r3.y >> 16)));
                x[j] = x[j] + *(const f32x4_t*)(g5 + c) * sm; *(f32x4_t*)(xr + c) = x[j]; }
        }
        float ss = 0.f;
#pragma unroll
        for (int j = 0; j < 8; ++j) ss += (x[j][0] * x[j][0] + x[j][1] * x[j][1]) + (x[j][2] * x[j][2] + x[j][3] * x[j][3]);
        ss = wave_sum64(ss); const float rinv = 1.0f / sqrtf(ss * (1.0f / D) + 1e-6f);
        if (l == DEPTH) {
#pragma unroll
            for (int j = 0; j < 8; ++j) { const int c = 256 * j + 4 * lane; *(f32x4_t*)(p.out + (size_t)m * D + c) = x[j] * rinv * *(const f32x4_t*)(p.in[I_final_norm_w] + c); }
        } else {
            const float* nw = p.in[I_norm1_w] + l * D; const float* sh = modp(p, l, r, 0); const float* sc = modp(p, l, r, 1);
#pragma unroll
            for (int j = 0; j < 8; ++j) { const int c = 256 * j + 4 * lane; const f32x4_t v = x[j] * rinv * *(const f32x4_t*)(nw + c) * (*(const f32x4_t*)(sc + c) + 1.0f) + *(const f32x4_t*)(sh + c);
                u32x2_t o; o.x = pk_bf16(v[0], v[1]); o.y = pk_bf16(v[2], v[3]); *(u32x2_t*)(WSH(O_A1) + (size_t)m * D + c) = o; }
        }
    }
}
__device__ __forceinline__ void norm2_tiles(PREF p, int l, LAS unsigned char* L) {
    int tid = hw_tid(), bl = blockIdx.x; asm volatile("" : "+v"(tid), "+s"(bl)); const int lane = tid & 63, w = __builtin_amdgcn_readfirstlane(tid >> 6), n = lane & 15, kg = lane >> 4;
    LAS float* Lg = (LAS float*)(L + w * 2304);
    const int ntile = moe_ntok(l) / 16;
#pragma unroll 1
    for (int wt = bl * 8 + w; wt < ntile; wt += (int)gridDim.x * 8) {
        const int m0 = wt * 16, r = mod_row(m0); const float* xr = WSF(O_X) + (size_t)(m0 + n) * D + 8 * kg;
        const unsigned short* bh = WSH(O_RWAT) + ((size_t)(l * (NB + 1) + r) * 2) * NE * D + (size_t)n * D + 8 * kg; const unsigned short* blo = bh + (size_t)NE * D;
        f32x4_t a0 = {0.f, 0.f, 0.f, 0.f}, a1 = a0; float ss = 0.f;
#pragma unroll 4
        for (int ks = 0; ks < 64; ++ks) {
            const f32x4_t xa = *(const f32x4_t*)(xr + ks * 32), xb = *(const f32x4_t*)(xr + ks * 32 + 4);
            ss += (xa[0] * xa[0] + xa[1] * xa[1]) + (xa[2] * xa[2] + xa[3] * xa[3]) + (xb[0] * xb[0] + xb[1] * xb[1]) + (xb[2] * xb[2] + xb[3] * xb[3]);
            unsigned short h[8]; unsigned hp[4], lp[4];
#pragma unroll
            for (int j = 0; j < 4; ++j) h[j] = f2bf(xa[j]);
#pragma unroll
            for (int j = 0; j < 4; ++j) h[4 + j] = f2bf(xb[j]);
#pragma unroll
            for (int j = 0; j < 2; ++j) { hp[j] = (unsigned)h[2 * j] | ((unsigned)h[2 * j + 1] << 16); lp[j] = pk_bf16(xa[2 * j] - bf2f(h[2 * j]), xa[2 * j + 1] - bf2f(h[2 * j + 1]));
                hp[2 + j] = (unsigned)h[4 + 2 * j] | ((unsigned)h[5 + 2 * j] << 16); lp[2 + j] = pk_bf16(xb[2 * j] - bf2f(h[4 + 2 * j]), xb[2 * j + 1] - bf2f(h[5 + 2 * j])); }
            u32x4_t hx = {hp[0], hp[1], hp[2], hp[3]}, lx = {lp[0], lp[1], lp[2], lp[3]}; const bf16x8_t xh = __builtin_bit_cast(bf16x8_t, hx), xl = __builtin_bit_cast(bf16x8_t, lx);
            const bf16x8_t w0h = *(const bf16x8_t*)(bh + ks * 32), w1h = *(const bf16x8_t*)(bh + (size_t)16 * D + ks * 32), w0l = *(const bf16x8_t*)(blo + ks * 32), w1l = *(const bf16x8_t*)(blo + (size_t)16 * D + ks * 32);
            a0 = __builtin_amdgcn_mfma_f32_16x16x32_bf16(xh, w0h, a0, 0, 0, 0); a1 = __builtin_amdgcn_mfma_f32_16x16x32_bf16(xh, w1h, a1, 0, 0, 0);
            a0 = __builtin_amdgcn_mfma_f32_16x16x32_bf16(xl, w0h, a0, 0, 0, 0); a1 = __builtin_amdgcn_mfma_f32_16x16x32_bf16(xl, w1h, a1, 0, 0, 0);
            a0 = __builtin_amdgcn_mfma_f32_16x16x32_bf16(xh, w0l, a0, 0, 0, 0); a1 = __builtin_amdgcn_mfma_f32_16x16x32_bf16(xh, w1l, a1, 0, 0, 0);
        }
        ss += __shfl_xor(ss, 16); ss += __shfl_xor(ss, 32);
        const float rinv = 1.0f / sqrtf(ss * (1.0f / D) + 1e-6f);
        if (kg == 0) WSF(O_ROWSS)[m0 + n] = ss;
#pragma unroll
        for (int q = 0; q < 4; ++q) { Lg[(4 * kg + q) * 36 + n] = a0[q]; Lg[(4 * kg + q) * 36 + 16 + n] = a1[q]; }
        asm volatile("s_waitcnt lgkmcnt(0)" ::: "memory");
        if (lane < 16) {
            const int m = m0 + lane; const float* cb = WSF(O_RCB) + (l * (NB + 1) + r) * NE; float lg[NE];
#pragma unroll
            for (int e = 0; e < NE; ++e) lg[e] = Lg[lane * 36 + e] * rinv + cb[e];
            int idx[4]; float val[4]; unsigned used = 0u;
#pragma unroll
            for (int k = 0; k < 4; ++k) { int bi = 0; float bv = -3.0e38f;
#pragma unroll
                for (int e = 0; e < NE; ++e) { const bool ok = !((used >> e) & 1u) && lg[e] > bv; bi = ok ? e : bi; bv = ok ? lg[e] : bv; }
                idx[k] = bi; val[k] = bv; used |= 1u << bi; }
            float ex[4], sum = 0.f;
#pragma unroll
            for (int k = 0; k < 4; ++k) { ex[k] = expf(val[k] - val[0]); sum += ex[k]; }
#pragma unroll
            for (int k = 0; k < 4; ++k) { WSI(O_TOPE)[m * 4 + k] = idx[k]; WSF(O_TOPP)[m * 4 + k] = ex[k] / sum; WSI(O_TOPPOS)[m * 4 + k] = atomicAdd((int*)(p.ws + O_CTL) + CW_COUNTS + (l * NE + idx[k]) * CW_CSTR, 1); }
        }
        asm volatile("s_waitcnt lgkmcnt(0)" ::: "memory");
    }
}

__device__ __forceinline__ void norm2_rows(PREF p, int l) {
    int tid = hw_tid(), bl = blockIdx.x; asm volatile("" : "+v"(tid), "+s"(bl)); const int lane = tid & 63, w = __builtin_amdgcn_readfirstlane(tid >> 6);
    const int nrows = moe_ntok(l);
#pragma unroll 1
    for (int m = bl * 8 + w; m < nrows; m += (int)gridDim.x * 8) {
        const float* xr = WSF(O_X) + (size_t)m * D; const int r = mod_row(m);
        f32x4_t x[8]; float ss = 0.f;
#pragma unroll
        for (int j = 0; j < 8; ++j) { x[j] = *(const f32x4_t*)(xr + 256 * j + 4 * lane); ss += (x[j][0] * x[j][0] + x[j][1] * x[j][1]) + (x[j][2] * x[j][2] + x[j][3] * x[j][3]); }
        ss = wave_sum64(ss); const float rinv = 1.0f / sqrtf(ss * (1.0f / D) + 1e-6f);
        const float* ma = WSF(O_MODA) + (size_t)(l * (NB + 1) + r) * D; const float* mb = WSF(O_MODB) + (size_t)(l * (NB + 1) + r) * D;
#pragma unroll
        for (int j = 0; j < 8; ++j) { const int c = 256 * j + 4 * lane; const f32x4_t v = x[j] * rinv * *(const f32x4_t*)(ma + c) + *(const f32x4_t*)(mb + c);
            u32x2_t o; o.x = pk_bf16(v[0], v[1]); o.y = pk_bf16(v[2], v[3]); *(u32x2_t*)(WSH(O_A1) + (size_t)m * D + c) = o; }
    }
}
DEV_GPU void st_slot_init(PREF p, int, long g) { WSI(O_SLOTTOK)[g] = 0; WSF(O_SLOTP)[g] = 0.f; }


__device__ __forceinline__ void hy_mlp_rows(PREF p) {
    int tid = hw_tid(), bl = blockIdx.x; asm volatile("" : "+v"(tid), "+s"(bl)); const int lane = tid & 63, w = __builtin_amdgcn_readfirstlane(tid >> 6);
#pragma unroll 1
    for (int pos = bl * 8 + w; pos < 3 * SEQ; pos += (int)gridDim.x * 8) {
        const int n = pos % SEQ, vi = pos / SEQ; const int L = hv_len(vi), l = hv_layer(vi); if (n >= L) continue;
        const float fq = p.in[I_hy_f_freq][l * 64 + lane];
        float z;
        {   const int i = lane < 17 ? lane - 1 : lane - 17; const float fr = 1e-4f + (float)i * ((15.0f - 1e-4f) / 15.0f); const float ang = (6.283185307179586f / (float)L) * (float)n * fr;
            z = lane == 0 ? (float)n / (float)(L - 1) : (lane < 17 ? cosf(ang) : -sinf(ang)); }
        float s1 = p.in[I_hy_f_b1][l * 64 + lane]; const float* w1 = p.in[I_hy_f_w1] + l * 33 * 64 + lane;
#pragma unroll
        for (int i = 0; i < 33; ++i) s1 += __shfl(z, i) * w1[i * 64];
        const float a = sinf(fq * s1);
        float s2 = p.in[I_hy_f_b2][l * 64 + lane]; const float* w2 = p.in[I_hy_f_w2] + l * 64 * 64 + lane;
#pragma unroll
        for (int i = 0; i < 64; ++i) s2 += __shfl(a, i) * w2[i * 64];
        const float b = sinf(fq * s2);
        float s3 = p.in[I_hy_f_b3][l * 64 + lane]; const float* w3 = p.in[I_hy_f_w3] + l * 64 * 64 + lane;
#pragma unroll
        for (int i = 0; i < 64; ++i) s3 += __shfl(b, i) * w3[i * 64];
        { const float h3 = sinf(fq * s3); WSF(O_HYA)[((size_t)vi * SEQ + n) * 64 + lane] = h3; WSH(O_HYAB)[((size_t)vi * SEQ + n) * 64 + lane] = f2bf(h3); }
    }
}


DEV_GPU void st_w4t(PREF p, int, long g) { const int i = (int)(g % 64), col = (int)((g / 64) % 2048), l = (int)(g / (64 * 2048)); WSH(O_W4T)[g] = f2bf(p.in[I_hy_f_w4][((size_t)l * 64 + i) * 2048 + col]); }
constexpr long N_w4t = 2L * 2048 * 64;
__device__ __forceinline__ void hy_raw_units(PREF p) {
    int tid = hw_tid(), bl = blockIdx.x; asm volatile("" : "+v"(tid), "+s"(bl)); const int lane = tid & 63, w = __builtin_amdgcn_readfirstlane(tid >> 6), n = lane & 15, kg = lane >> 4;
    const float dmin = -3.0701134573253944f, dmax = -15.350567286626973f;
    constexpr int NU = (2 * (SEQ / 16) + CTX / 16) * 8;
#pragma unroll 1
    for (int u = bl * 8 + w; u < NU; u += (int)gridDim.x * 8) {
        const int cb = u & 7, nt = u >> 3; const int vi = nt < SEQ / 16 ? 0 : (nt < 2 * (SEQ / 16) ? 1 : 2); const int n0 = (nt - (vi == 0 ? 0 : (vi == 1 ? SEQ / 16 : 2 * (SEQ / 16)))) * 16;
        const int L = hv_len(vi), l = hv_layer(vi);
        const unsigned short* hb = WSH(O_HYAB) + ((size_t)vi * SEQ + n0 + n) * 64 + 8 * kg; const bf16x8_t b0 = *(const bf16x8_t*)hb, b1 = *(const bf16x8_t*)(hb + 32);
        const float tn = (float)(n0 + n) / (float)(L - 1);
#pragma unroll 4
        for (int ct = 0; ct < 16; ++ct) { const int col0 = cb * 256 + ct * 16; const unsigned short* wa = WSH(O_W4T) + ((size_t)l * 2048 + col0 + n) * 64 + 8 * kg;
            f32x4_t acc = {0.f, 0.f, 0.f, 0.f};
            acc = __builtin_amdgcn_mfma_f32_16x16x32_bf16(*(const bf16x8_t*)wa, b0, acc, 0, 0, 0); acc = __builtin_amdgcn_mfma_f32_16x16x32_bf16(*(const bf16x8_t*)(wa + 32), b1, acc, 0, 0, 0);
#pragma unroll
            for (int q = 0; q < 4; ++q) { const int col = col0 + 4 * kg + q; const float delta = fabsf(dmin + (float)(col % 512) * ((dmax - dmin) / 511.0f));
                WSF(O_TAPS)[((size_t)vi * 2048 + col) * SEQ + n0 + n] = acc[q] * __expf(-tn * delta); } }
    }
}

constexpr int RWH_LD = 168;
__device__ __forceinline__ void rw_hidden_store(LAS unsigned short* Hl, int col, int kg, const f32x4_t v) {
#pragma unroll
    for (int q = 0; q < 4; ++q) Hl[(4 * kg + q) * RWH_LD + col] = f2bf(v[q]);
}
__device__ __forceinline__ void rw_prep1(PREF p, int l, LAS unsigned char* L, int b0, int nb) {
    int tid = hw_tid(), bl = blockIdx.x; asm volatile("" : "+v"(tid), "+s"(bl)); bl -= b0; if (bl < 0 || bl >= nb) return; const int lane = tid & 63, w = __builtin_amdgcn_readfirstlane(tid >> 6), n = lane & 15, kg = lane >> 4;
    LAS unsigned short* Hl = (LAS unsigned short*)(L + w * (16 * RWH_LD * 2));
    const unsigned short* W1T = WSH(O_LW1T) + (size_t)l * 160 * 512; const unsigned short* G2T = WSH(O_LG2T) + (size_t)l * 512 * 128; const unsigned short* V2T = WSH(O_LV2T) + (size_t)l * 512 * 32;
#pragma unroll 1
    for (int wt = bl * 8 + w; wt < T / 16; wt += nb * 8) {
        const int m0 = wt * 16;
        bf16x8_t za[16];
#pragma unroll
        for (int ks = 0; ks < 16; ++ks) za[ks] = *(const bf16x8_t*)(WSH(O_U) + (size_t)(m0 + n) * DIN + U_RW + 3 * G + ks * 32 + 8 * kg);
#pragma unroll 1
        for (int nt = (l == 0 ? 2 : 0); nt < 10; ++nt) { f32x4_t acc = {0.f, 0.f, 0.f, 0.f};
#pragma unroll
            for (int ks = 0; ks < 16; ++ks) acc = __builtin_amdgcn_mfma_f32_16x16x32_bf16(za[ks], *(const bf16x8_t*)(W1T + (size_t)(16 * nt + n) * 512 + ks * 32 + 8 * kg), acc, 0, 0, 0);
            if (nt >= 2) {
#pragma unroll
                for (int q = 0; q < 4; ++q) acc[q] = 1.0f / (1.0f + __expf(-acc[q])); }
            rw_hidden_store(Hl, 16 * nt + n, kg, acc); }
        asm volatile("s_waitcnt lgkmcnt(0)" ::: "memory");
        bf16x8_t hg[4], hv;
#pragma unroll
        for (int ks = 0; ks < 4; ++ks) hg[ks] = *(LAS bf16x8_t*)(Hl + n * RWH_LD + 32 + ks * 32 + 8 * kg);
        hv = *(LAS bf16x8_t*)(Hl + n * RWH_LD + 8 * kg);
#pragma unroll 1
        for (int ct = 0; ct < 32; ++ct) { f32x4_t ag = {0.f, 0.f, 0.f, 0.f}, av = ag; const int cr = 16 * ct + n;
#pragma unroll
            for (int ks = 0; ks < 4; ++ks) ag = __builtin_amdgcn_mfma_f32_16x16x32_bf16(*(const bf16x8_t*)(G2T + (size_t)cr * 128 + ks * 32 + 8 * kg), hg[ks], ag, 0, 0, 0);
            if (l > 0) av = __builtin_amdgcn_mfma_f32_16x16x32_bf16(*(const bf16x8_t*)(V2T + (size_t)cr * 32 + 8 * kg), hv, av, 0, 0, 0);
            const int m = m0 + n, c = 16 * ct + 4 * kg; const size_t o = (size_t)m * G + c;
            const u32x2_t vraw = *(const u32x2_t*)(WSH(O_U) + (size_t)m * DIN + U_RW + 2 * G + c);
            f32x4_t v = {bf2f((unsigned short)(vraw.x & 0xffffu)), bf2f((unsigned short)(vraw.x >> 16)), bf2f((unsigned short)(vraw.y & 0xffffu)), bf2f((unsigned short)(vraw.y >> 16))};
            if (l == 0) *(f32x4_t*)(WSF(O_VFIRST) + o) = v;
            else { const f32x4_t vf = *(const f32x4_t*)(WSF(O_VFIRST) + o), v0 = *(const f32x4_t*)(p.in[I_rw_v0] + (l - 1) * G + c);
#pragma unroll
                for (int q = 0; q < 4; ++q) v[q] = v[q] + (vf[q] - v[q]) * fsigm(v0[q] + av[q]); }
            *(f32x4_t*)(WSF(O_RWV) + o) = v; *(f32x4_t*)(WSF(O_RWG) + o) = ag; }
        asm volatile("s_waitcnt lgkmcnt(0)" ::: "memory");
    }
}
__device__ __forceinline__ void rw_prep2a(PREF p, int l, int b0, int nb) {
    int tid = hw_tid(), bl = blockIdx.x; asm volatile("" : "+v"(tid), "+s"(bl)); const int lane = tid & 63, w = __builtin_amdgcn_readfirstlane(tid >> 6), n = lane & 15, kg = lane >> 4;
    bl -= b0; if (bl < 0 || bl >= nb) return;
#pragma unroll 1
    for (int un = bl * 8 + w; un < 4 * (T / 16); un += nb * 8) {
        const int nh = un & 1, wt = un >> 1, d = wt / (T / 16), m0 = (wt % (T / 16)) * 16, ld = l * 2 + d;
        const unsigned short* WA1T = WSH(O_LWA1T) + (size_t)ld * 2 * 128 * 512 + (size_t)nh * 64 * 512;
        f32x4_t hacc[4];
#pragma unroll
        for (int nt = 0; nt < 4; ++nt) hacc[nt] = (f32x4_t){0.f, 0.f, 0.f, 0.f};
#pragma unroll 1
        for (int half = 0; half < 2; ++half) {
            const int m = m0 + n, src = half == 0 ? m : tok_prev(m, d, 1); const int srow = src >= 0 ? src : m;
            bf16x8_t za[16];
#pragma unroll
            for (int ks = 0; ks < 16; ++ks) { za[ks] = *(const bf16x8_t*)(WSH(O_U) + (size_t)srow * DIN + U_RW + 3 * G + ks * 32 + 8 * kg); if (src < 0) za[ks] = (bf16x8_t){0, 0, 0, 0, 0, 0, 0, 0}; }
            const unsigned short* Wh = WA1T + (size_t)half * 128 * 512;
#pragma unroll
            for (int nt = 0; nt < 4; ++nt)
#pragma unroll
                for (int ks = 0; ks < 16; ++ks) hacc[nt] = __builtin_amdgcn_mfma_f32_16x16x32_bf16(*(const bf16x8_t*)(Wh + (size_t)(16 * nt + n) * 512 + ks * 32 + 8 * kg), za[ks], hacc[nt], 0, 0, 0);
        }
        unsigned short* hrow = WSH(O_H2) + ((size_t)d * T + m0 + n) * 128 + 64 * nh + 4 * kg;
#pragma unroll
        for (int nt = 0; nt < 4; ++nt) { f32x4_t acc = hacc[nt];
            if (nh == 0) {
#pragma unroll
                for (int q = 0; q < 4; ++q) acc[q] = tanhf(acc[q]); }
            u32x2_t o; o.x = pk_bf16(acc[0], acc[1]); o.y = pk_bf16(acc[2], acc[3]); *(u32x2_t*)(hrow + 16 * nt) = o; }
    }
}
__device__ __forceinline__ void rw_prep2b(PREF p, int l) {
    int tid = hw_tid(), bl = blockIdx.x; asm volatile("" : "+v"(tid), "+s"(bl)); const int lane = tid & 63, w = __builtin_amdgcn_readfirstlane(tid >> 6), n = lane & 15, kg = lane >> 4;
#pragma unroll 1
    for (int un = bl * 8 + w; un < 2 * (T / 16) * 8; un += (int)gridDim.x * 8) {
        const int hh = un & 7, wt = un >> 3, d = wt / (T / 16), m0 = (wt % (T / 16)) * 16, ld = l * 2 + d;
        const unsigned short* W2T = WSH(O_LW2T) + (size_t)ld * 512 * 64; const unsigned short* A2T = WSH(O_LA2T) + (size_t)ld * 512 * 64; const float* mu = p.in[I_rw_mu] + (size_t)ld * 4 * G;
        const int m = m0 + n, pm = tok_prev(m, d, 1); const unsigned short* ur = WSH(O_U) + (size_t)m * DIN + U_RW; const unsigned short* up = WSH(O_U) + (size_t)(pm >= 0 ? pm : m) * DIN + U_RW;
        const float pz = pm >= 0 ? 1.0f : 0.0f;
        const unsigned short* hrow = WSH(O_H2) + ((size_t)d * T + m) * 128 + 8 * kg;
        bf16x8_t hw[2], ha[2];
#pragma unroll
        for (int ks = 0; ks < 2; ++ks) { hw[ks] = *(const bf16x8_t*)(hrow + ks * 32); ha[ks] = *(const bf16x8_t*)(hrow + 64 + ks * 32); }
        f32x4_t aw[4], aa[4], ksv[4]; float ss = 0.f;
#pragma unroll
        for (int j = 0; j < 4; ++j) { const int cr = 64 * hh + 16 * j + n, c = 64 * hh + 16 * j + 4 * kg; aw[j] = (f32x4_t){0.f, 0.f, 0.f, 0.f}; aa[j] = aw[j];
#pragma unroll
            for (int ks = 0; ks < 2; ++ks) { aw[j] = __builtin_amdgcn_mfma_f32_16x16x32_bf16(*(const bf16x8_t*)(W2T + (size_t)cr * 64 + ks * 32 + 8 * kg), hw[ks], aw[j], 0, 0, 0);
                aa[j] = __builtin_amdgcn_mfma_f32_16x16x32_bf16(*(const bf16x8_t*)(A2T + (size_t)cr * 64 + ks * 32 + 8 * kg), ha[ks], aa[j], 0, 0, 0); }
            const u32x2_t k0r = *(const u32x2_t*)(ur + G + c), kpr = *(const u32x2_t*)(up + G + c); const f32x4_t muk = *(const f32x4_t*)(mu + G + c), kkc = *(const f32x4_t*)(p.in[I_rw_k_k] + l * G + c);
            const f32x4_t k0 = {bf2f((unsigned short)(k0r.x & 0xffffu)), bf2f((unsigned short)(k0r.x >> 16)), bf2f((unsigned short)(k0r.y & 0xffffu)), bf2f((unsigned short)(k0r.y >> 16))};
            const f32x4_t kp = {bf2f((unsigned short)(kpr.x & 0xffffu)) * pz, bf2f((unsigned short)(kpr.x >> 16)) * pz, bf2f((unsigned short)(kpr.y & 0xffffu)) * pz, bf2f((unsigned short)(kpr.y >> 16)) * pz};
            ksv[j] = k0 + (kp - k0) * muk; const f32x4_t kr = ksv[j] * kkc; ss += (kr[0] * kr[0] + kr[1] * kr[1]) + (kr[2] * kr[2] + kr[3] * kr[3]); }
        ss += __shfl_xor(ss, 16); ss += __shfl_xor(ss, 32);
        const float inv = 1.0f / fmaxf(sqrtf(ss), 1e-12f);
#pragma unroll
        for (int j = 0; j < 4; ++j) { const int c = 64 * hh + 16 * j + 4 * kg; const size_t o = ((size_t)d * T + m) * G + c;
            const f32x4_t w0c = *(const f32x4_t*)(p.in[I_rw_w0] + ld * G + c), a0c = *(const f32x4_t*)(p.in[I_rw_a0] + ld * G + c), kac = *(const f32x4_t*)(p.in[I_rw_k_a] + l * G + c), kkc = *(const f32x4_t*)(p.in[I_rw_k_k] + l * G + c);
            const f32x4_t mur = *(const f32x4_t*)(mu + c), muv = *(const f32x4_t*)(mu + 2 * G + c);
            const u32x2_t r0r = *(const u32x2_t*)(ur + c), rpr = *(const u32x2_t*)(up + c);
            const f32x4_t r0 = {bf2f((unsigned short)(r0r.x & 0xffffu)), bf2f((unsigned short)(r0r.x >> 16)), bf2f((unsigned short)(r0r.y & 0xffffu)), bf2f((unsigned short)(r0r.y >> 16))};
            const f32x4_t rp = {bf2f((unsigned short)(rpr.x & 0xffffu)) * pz, bf2f((unsigned short)(rpr.x >> 16)) * pz, bf2f((unsigned short)(rpr.y & 0xffffu)) * pz, bf2f((unsigned short)(rpr.y >> 16)) * pz};
            const f32x4_t v0 = *(const f32x4_t*)(WSF(O_RWV) + (size_t)m * G + c), vp = *(const f32x4_t*)(WSF(O_RWV) + (size_t)(pm >= 0 ? pm : m) * G + c) * pz;
            f32x4_t av, dec;
#pragma unroll
            for (int q = 0; q < 4; ++q) { av[q] = fsigm(a0c[q] + aa[j][q]); dec[q] = __expf(-0.6065306597126334f * fsigm(w0c[q] + aw[j][q])); }
            const f32x4_t kk = ksv[j] * kkc * inv;
            *(f32x4_t*)(WSF(O_SR) + o) = r0 + (rp - r0) * mur; *(f32x4_t*)(WSF(O_SW) + o) = dec; *(f32x4_t*)(WSF(O_SV) + o) = v0 + (vp - v0) * muv;
            *(f32x4_t*)(WSF(O_SK) + o) = ksv[j] * ((av - 1.0f) * kac + 1.0f); *(f32x4_t*)(WSF(O_SKK) + o) = kk; *(f32x4_t*)(WSF(O_SKKA) + o) = kk * av; }
    }
}

constexpr int RCL_LD = 72;
constexpr int RCL_AT = 0, RCL_BH = 16 * RCL_LD * 2, RCL_KH = 2 * RCL_BH, RCL_RT = 3 * RCL_BH, RCL_ATT = 4 * RCL_BH  , RCL_NT = RCL_ATT + 64 * 24 * 2  ,
              RCL_TT = RCL_NT + 16 * 20 * 4  , RCL_MTT = RCL_TT + 16 * 40 * 2  , RCL_END = RCL_MTT + 16 * 24 * 2;
static_assert(RCL_END <= 16384, "rwkv chunk unit LDS per wave");
__device__ __forceinline__ void rwc_tasks(PREF p, LAS unsigned char* L) {
    int tid = hw_tid(), bl = blockIdx.x; asm volatile("" : "+v"(tid), "+s"(bl)); const int lane = tid & 63, w = __builtin_amdgcn_readfirstlane(tid >> 6), n = lane & 15, kg = lane >> 4;
    LAS unsigned char* Lw = L + w * 16384;
    LAS unsigned short* ATl = (LAS unsigned short*)(Lw + RCL_AT); LAS unsigned short* BHl = (LAS unsigned short*)(Lw + RCL_BH); LAS unsigned short* KHl = (LAS unsigned short*)(Lw + RCL_KH); LAS unsigned short* RTl = (LAS unsigned short*)(Lw + RCL_RT);
    LAS unsigned short* ATTl = (LAS unsigned short*)(Lw + RCL_ATT); LAS float* NTl = (LAS float*)(Lw + RCL_NT); LAS unsigned short* TTl = (LAS unsigned short*)(Lw + RCL_TT); LAS unsigned short* MTTl = (LAS unsigned short*)(Lw + RCL_MTT);
    const bf16x8_t zero8 = {0, 0, 0, 0, 0, 0, 0, 0};
#pragma unroll 1
    for (int task = bl * 8 + w; task < NTASK; task += (int)gridDim.x * 8) {
        const int ck = task % NCK, chain = task / NCK; int d, b, h; rw_chain_decode(chain, d, b, h);
        {   const int c = lane; float gam = 1.0f; float khv[16], bhv[16];
#pragma unroll
            for (int t = 0; t < RWC; ++t) { const size_t base = ((size_t)d * T + scan_tok(d, b, ck * RWC + t)) * G + h * 64 + c;
                const float at = WSF(O_SKK)[base] * gam; gam *= WSF(O_SW)[base]; const float inv = 1.0f / gam;
                bhv[t] = WSF(O_SKKA)[base] * inv; khv[t] = WSF(O_SK)[base] * inv; const float rt = WSF(O_SR)[base] * gam;
                ATl[t * RCL_LD + c] = f2bf(at); BHl[t * RCL_LD + c] = f2bf(bhv[t]); KHl[t * RCL_LD + c] = f2bf(khv[t]); RTl[t * RCL_LD + c] = f2bf(rt); ATTl[c * 24 + t] = f2bf(at);
                WSH(O_ORT)[(size_t)task * 1024 + t * 64 + c] = f2bf(rt);
                WSH(O_OVT)[(size_t)task * 1024 + c * 16 + t] = f2bf(WSF(O_SV)[base]); }
            WSF(O_CAGC)[(size_t)task * 64 + c] = gam;
            u32x4_t* dst = (u32x4_t*)(WSH(O_OKB) + (size_t)task * 2048 + c * 32);
#pragma unroll
            for (int i = 0; i < 2; ++i) { u32x4_t v, u;
#pragma unroll
                for (int j = 0; j < 4; ++j) { v[j] = pk_bf16(khv[8 * i + 2 * j] * gam, khv[8 * i + 2 * j + 1] * gam); u[j] = pk_bf16(-bhv[8 * i + 2 * j] * gam, -bhv[8 * i + 2 * j + 1] * gam); }
                dst[i] = v; dst[2 + i] = u; }
        }
        asm volatile("s_waitcnt lgkmcnt(0)" ::: "memory");
        f32x4_t nt = {0.f, 0.f, 0.f, 0.f}, mt = nt, qk = nt, qb = nt;
#pragma unroll
        for (int ks = 0; ks < 2; ++ks) { const bf16x8_t fa = *(LAS bf16x8_t*)(ATl + n * RCL_LD + ks * 32 + 8 * kg), fr = *(LAS bf16x8_t*)(RTl + n * RCL_LD + ks * 32 + 8 * kg);
            const bf16x8_t fb = *(LAS bf16x8_t*)(BHl + n * RCL_LD + ks * 32 + 8 * kg), fk = *(LAS bf16x8_t*)(KHl + n * RCL_LD + ks * 32 + 8 * kg);
            nt = __builtin_amdgcn_mfma_f32_16x16x32_bf16(fa, fb, nt, 0, 0, 0); mt = __builtin_amdgcn_mfma_f32_16x16x32_bf16(fa, fk, mt, 0, 0, 0);
            qk = __builtin_amdgcn_mfma_f32_16x16x32_bf16(fr, fk, qk, 0, 0, 0); qb = __builtin_amdgcn_mfma_f32_16x16x32_bf16(fr, fb, qb, 0, 0, 0); }
#pragma unroll
        for (int q = 0; q < 4; ++q) { const int t = 4 * kg + q; if (t <= n) { nt[q] = 0.f; mt[q] = 0.f; } if (t < n) { qk[q] = 0.f; qb[q] = 0.f; }
            NTl[t * 20 + n] = nt[q];
            WSH(O_OQKB)[(size_t)task * 512 + t * 32 + n] = f2bf(qk[q]); WSH(O_OQKB)[(size_t)task * 512 + t * 32 + 16 + n] = f2bf(-qb[q]); }
        { u32x2_t mv; mv.x = pk_bf16(mt[0], mt[1]); mv.y = pk_bf16(mt[2], mt[3]); *(LAS u32x2_t*)(MTTl + n * 24 + 4 * kg) = mv; }
        asm volatile("s_waitcnt lgkmcnt(0)" ::: "memory");
        {   float x[16];
#pragma unroll
            for (int t = 0; t < 16; ++t) { float sacc = (t == n) ? 1.0f : 0.0f;
#pragma unroll
                for (int j4 = 0; j4 < 4; ++j4) { if (4 * j4 < t) { const f32x4_t r4 = *(LAS f32x4_t*)(NTl + t * 20 + 4 * j4);
#pragma unroll
                        for (int jj = 0; jj < 4; ++jj) if (4 * j4 + jj < t) sacc -= r4[jj] * x[4 * j4 + jj]; } }
                x[t] = sacc; }
            if (kg == 0) {
#pragma unroll
                for (int t = 0; t < 16; ++t) { TTl[t * 40 + n] = f2bf(x[t]); TTl[t * 40 + 16 + n] = 0; } }
        }
        asm volatile("s_waitcnt lgkmcnt(0)" ::: "memory");
        {   const bf16x8_t ta = *(LAS bf16x8_t*)(TTl + n * 40 + 8 * kg);
#pragma unroll
            for (int ct = 0; ct < 4; ++ct) { const bf16x8_t bt = kg < 2 ? *(LAS bf16x8_t*)(ATTl + (16 * ct + n) * 24 + 8 * (kg & 1)) : zero8;
                f32x4_t w1 = {0.f, 0.f, 0.f, 0.f}; w1 = __builtin_amdgcn_mfma_f32_16x16x32_bf16(ta, bt, w1, 0, 0, 0);
#pragma unroll
                for (int q = 0; q < 4; ++q) WSH(O_OW1)[(size_t)task * 1024 + (4 * kg + q) * 64 + 16 * ct + n] = f2bf(w1[q]); }
            const bf16x8_t bm = kg < 2 ? *(LAS bf16x8_t*)(MTTl + n * 24 + 8 * (kg & 1)) : zero8;
            f32x4_t tm = {0.f, 0.f, 0.f, 0.f}; tm = __builtin_amdgcn_mfma_f32_16x16x32_bf16(ta, bm, tm, 0, 0, 0);
#pragma unroll
            for (int q = 0; q < 4; ++q) { WSH(O_OTM)[(size_t)task * 512 + (4 * kg + q) * 32 + n] = f2bf(tm[q]); WSH(O_OTM)[(size_t)task * 512 + (4 * kg + q) * 32 + 16 + n] = 0; }
        }
        asm volatile("s_waitcnt lgkmcnt(0)" ::: "memory");
    }
}
__device__ __forceinline__ void rw_out_rows(PREF p, int l) {
    int tid = hw_tid(), bl = blockIdx.x; asm volatile("" : "+v"(tid), "+s"(bl)); const int lane = tid & 63, w = __builtin_amdgcn_readfirstlane(tid >> 6);
    const int nrows = (l == DEPTH - 1 ? TL : T) * 8;
#pragma unroll 1
    for (int rh = bl * 8 + w; rh < nrows; rh += (int)gridDim.x * 8) {
        const int m = rh >> 3, h = rh & 7, c = h * 64 + lane; float tot = 0.f;
#pragma unroll
        for (int d = 0; d < 2; ++d) { const size_t o = ((size_t)d * T + m) * G + c;
            const float y = WSF(O_SY)[o], r = WSF(O_SR)[o], k = WSF(O_SK)[o], v = WSF(O_SV)[o];
            float s1 = y, s2 = y * y, s3 = r * k * p.in[I_rw_r_k][l * G + c];
#pragma unroll
            for (int off = 1; off < 64; off <<= 1) { s1 += __shfl_xor(s1, off); s2 += __shfl_xor(s2, off); s3 += __shfl_xor(s3, off); }
            const float mean = s1 * (1.0f / 64.0f), dy = y - mean, var = fmaxf(s2 * (1.0f / 64.0f) - mean * mean, 0.0f), bon = s3;
            tot += dy / sqrtf(var + 64e-5f) * p.in[I_rw_ln_w][l * G + c] + p.in[I_rw_ln_b][l * G + c] + bon * v; }
        WSH(O_CAT)[(size_t)m * D + 2 * G + c] = f2bf(tot * WSF(O_RWG)[(size_t)m * G + c]);
    }
}

struct RwOps { bf16x8_t w1a, w1b, rta, rtb, tm, qkb, kb0, kb1, kb2, kb3, vt; f32x4_t gc0, gc1, gc2, gc3; };
__device__ __forceinline__ void rw_load_ops(PREF p, RwOps& o, size_t task, int q, int n, int kg) {
    const unsigned short* w1 = WSH(O_OW1) + task * 1024 + n * 64 + 8 * kg; const unsigned short* rt = WSH(O_ORT) + task * 1024 + n * 64 + 8 * kg;
    o.w1a = *(const bf16x8_t*)w1; o.w1b = *(const bf16x8_t*)(w1 + 32); o.rta = *(const bf16x8_t*)rt; o.rtb = *(const bf16x8_t*)(rt + 32);
    o.tm = *(const bf16x8_t*)(WSH(O_OTM) + task * 512 + n * 32 + 8 * kg); o.qkb = *(const bf16x8_t*)(WSH(O_OQKB) + task * 512 + n * 32 + 8 * kg);
    const unsigned short* kb = WSH(O_OKB) + task * 2048 + n * 32 + 8 * kg;
    o.kb0 = *(const bf16x8_t*)kb; o.kb1 = *(const bf16x8_t*)(kb + 512); o.kb2 = *(const bf16x8_t*)(kb + 1024); o.kb3 = *(const bf16x8_t*)(kb + 1536);
    o.vt = *(const bf16x8_t*)(WSH(O_OVT) + task * 1024 + (16 * q + n) * 16 + 8 * (kg & 1));
    const float* gc = WSF(O_CAGC) + task * 64 + 4 * kg;
    o.gc0 = *(const f32x4_t*)gc; o.gc1 = *(const f32x4_t*)(gc + 16); o.gc2 = *(const f32x4_t*)(gc + 32); o.gc3 = *(const f32x4_t*)(gc + 48);
}
__device__ __forceinline__ void rw_chain_unit(PREF p, int chain, LAS unsigned char* L) {
    int tid = hw_tid(); asm volatile("" : "+v"(tid)); const int lane = tid & 63, q = __builtin_amdgcn_readfirstlane(tid >> 6);
    if (q >= 4) return;
    int d, b, h; rw_chain_decode(chain, d, b, h);
    const int n = lane & 15, kg = lane >> 4;
    LAS unsigned short* Sl = (LAS unsigned short*)(L + q * 4096);
    LAS unsigned short* Ul = (LAS unsigned short*)(L + q * 4096 + 2304);
    f32x4_t s0 = {0.f, 0.f, 0.f, 0.f}, s1 = s0, s2 = s0, s3 = s0;
    const bf16x8_t zero8 = {0, 0, 0, 0, 0, 0, 0, 0};
    RwOps nx; rw_load_ops(p, nx, (size_t)chain * NCK, q, n, kg);
#pragma unroll 1
    for (int ck = 0; ck < NCK; ++ck) {
        const RwOps o = nx;
        if (ck + 1 < NCK) rw_load_ops(p, nx, (size_t)chain * NCK + ck + 1, q, n, kg);
        { u32x2_t w; w.x = pk_bf16(s0[0], s0[1]); w.y = pk_bf16(s0[2], s0[3]); *(LAS u32x2_t*)(Sl + n * 72 + 4 * kg) = w;
          w.x = pk_bf16(s1[0], s1[1]); w.y = pk_bf16(s1[2], s1[3]); *(LAS u32x2_t*)(Sl + n * 72 + 16 + 4 * kg) = w;
          w.x = pk_bf16(s2[0], s2[1]); w.y = pk_bf16(s2[2], s2[3]); *(LAS u32x2_t*)(Sl + n * 72 + 32 + 4 * kg) = w;
          w.x = pk_bf16(s3[0], s3[1]); w.y = pk_bf16(s3[2], s3[3]); *(LAS u32x2_t*)(Sl + n * 72 + 48 + 4 * kg) = w; }
        asm volatile("s_waitcnt lgkmcnt(0)" ::: "memory");
        const bf16x8_t bs0 = *(LAS bf16x8_t*)(Sl + n * 72 + 8 * kg), bs1 = *(LAS bf16x8_t*)(Sl + n * 72 + 32 + 8 * kg);
        const bf16x8_t bvlo = kg < 2 ? o.vt : zero8;
        f32x4_t ut = {0.f, 0.f, 0.f, 0.f};
        ut = __builtin_amdgcn_mfma_f32_16x16x32_bf16(o.w1a, bs0, ut, 0, 0, 0);
        ut = __builtin_amdgcn_mfma_f32_16x16x32_bf16(o.w1b, bs1, ut, 0, 0, 0);
        ut = __builtin_amdgcn_mfma_f32_16x16x32_bf16(o.tm, bvlo, ut, 0, 0, 0);
        { u32x2_t w; w.x = pk_bf16(ut[0], ut[1]); w.y = pk_bf16(ut[2], ut[3]); *(LAS u32x2_t*)(Ul + n * 24 + 4 * kg) = w; }
        asm volatile("s_waitcnt lgkmcnt(0)" ::: "memory");
        const bf16x8_t uf = *(LAS bf16x8_t*)(Ul + n * 24 + 8 * (kg & 1));
        const bf16x8_t bv = kg < 2 ? o.vt : uf;
        f32x4_t yt = {0.f, 0.f, 0.f, 0.f};
        yt = __builtin_amdgcn_mfma_f32_16x16x32_bf16(o.rta, bs0, yt, 0, 0, 0);
        yt = __builtin_amdgcn_mfma_f32_16x16x32_bf16(o.rtb, bs1, yt, 0, 0, 0);
        yt = __builtin_amdgcn_mfma_f32_16x16x32_bf16(o.qkb, bv, yt, 0, 0, 0);
#pragma unroll
        for (int qq = 0; qq < 4; ++qq) WSF(O_SY)[((size_t)d * T + scan_tok(d, b, ck * RWC + 4 * kg + qq)) * G + h * 64 + 16 * q + n] = yt[qq];
        s0 = s0 * o.gc0; s1 = s1 * o.gc1; s2 = s2 * o.gc2; s3 = s3 * o.gc3;
        s0 = __builtin_amdgcn_mfma_f32_16x16x32_bf16(o.kb0, bv, s0, 0, 0, 0);
        s1 = __builtin_amdgcn_mfma_f32_16x16x32_bf16(o.kb1, bv, s1, 0, 0, 0);
        s2 = __builtin_amdgcn_mfma_f32_16x16x32_bf16(o.kb2, bv, s2, 0, 0, 0);
        s3 = __builtin_amdgcn_mfma_f32_16x16x32_bf16(o.kb3, bv, s3, 0, 0, 0);
        asm volatile("s_waitcnt lgkmcnt(0)" ::: "memory");
    }
}
__device__ __forceinline__ void rw_chain_units(PREF p, LAS unsigned char* L) { int bl = blockIdx.x; asm volatile("" : "+s"(bl)); for (int ch = bl; ch < NCHAIN; ch += gridDim.x) rw_chain_unit(p, ch, L); }

constexpr int LDS_STAGE = 147456, LDS_MISC = LDS_STAGE, LDS_BYTES = LDS_STAGE + 512;
static_assert(LDS_WTAB == LDS_MISC + 64, "wave table address");
static_assert(HYL_END <= LDS_STAGE, "hyena LDS map");
typedef void (*stage_fn)(PREF, int, long);
template <stage_fn F> __device__ __forceinline__ void run_stage(PREF p, int l, long n, int b0 = 0, int nb = 0) {
    int tl = hw_tid(), bl = blockIdx.x; asm volatile("" : "+v"(tl), "+s"(bl));
    if (nb == 0) nb = (int)gridDim.x; bl -= b0; if (bl < 0 || bl >= nb) return;
    for (long g = (long)bl * NTHREADS + tl; g < n; g += (long)nb * NTHREADS) F(p, l, g);
}
constexpr int PRO_PH = 7, LAYER_PH = 35, FIN_PH = 2, NPHASES = PRO_PH + DEPTH * LAYER_PH + FIN_PH;

__global__ void __launch_bounds__(NTHREADS, 2) fwd_kernel(P p_arg) {
    const __attribute__((address_space(4))) P* kp = (const __attribute__((address_space(4))) P*)__builtin_amdgcn_kernarg_segment_ptr();
    extern __shared__ __attribute__((aligned(16))) unsigned char lds[];
    LAS unsigned char* L = (LAS unsigned char*)lds;
    volatile LAS unsigned* misc = (volatile LAS unsigned*)(L + LDS_MISC);
    if (threadIdx.x < 16) misc[threadIdx.x] = 0u;
    if ((threadIdx.x & 63) == 0) ((volatile LAS int*)(unsigned)LDS_WTAB)[(unsigned)__builtin_amdgcn_s_getreg((5 << 11) | 4) & 63u] = (int)(threadIdx.x >> 6);
    __syncthreads();
    (void)xcd_barrier_post((unsigned*)(kp->ws + O_CTL) + CW_BAR, misc);
    int ph = 0;
#define PHASE_BEGIN if (ph >= kp->lo && ph < kp->hi) { asm volatile("" : "+s"(kp)); PREF p = *kp;
#define PHASE_END if (ph + 1 < kp->hi) { XcdBarrier bar_; bar_.bar = (unsigned*)(kp->ws + O_CTL) + CW_BAR; bar_.x = xb_xcc_id(); bar_.st = (volatile LAS unsigned*)(L + LDS_MISC); xcd_barrier(bar_); } } ++ph;
#define STAGE(fn, l, n) run_stage<fn>(p, l, n)
#define STAGE_SUB(fn, l, n, b0, nb) run_stage<fn>(p, l, n, b0, nb)
    PHASE_BEGIN STAGE(st_copy_x, 0, N_copy_x); STAGE(st_ada_part, 0, N_ada_part); hy_mlp_rows(p); STAGE(st_w4t, 0, N_w4t); STAGE(st_lora_cvt, 0, N_lora_cvt); cvt_all(p, L, 0, CVT_NIT, 0, (int)gridDim.x); PHASE_END
    PHASE_BEGIN STAGE(st_ada_red, 0, N_ada_red); hy_raw_units(p); PHASE_END
    PHASE_BEGIN STAGE(st_hy_nrm1, 0, N_hy_nrm1); PHASE_END
    PHASE_BEGIN STAGE(st_hy_nrm, 0, N_hy_nrm); PHASE_END
    PHASE_BEGIN STAGE(st_hy_scale, 0, 2048L * SEQ); STAGE(st_hy_trb, 0, N_hy_trb); PHASE_END
    for (int l = 0; l < DEPTH; ++l) {
#pragma unroll 1
        for (int seg = 0; seg < 4; ++seg) {
            if (seg == 0) {
                PHASE_BEGIN if (l == 0) STAGE(st_moe_fold, 0, N_moe_fold); norm1_rows(p, l); PHASE_END
            } else if (seg == 1) {
                const int GB = (int)gridDim.x, RB = GB > 128 ? 64 : 0;
                PHASE_BEGIN rg_units(p, l, L); STAGE_SUB(st_hy_shortT, l, N_hy_shortT, RB, GB - RB); if (l == 0) STAGE_SUB(st_hy_short_ctx, l, N_hy_short_ctx, RB, GB - RB); rw_prep1(p, l, L, RB, GB - RB); rw_prep2a(p, l, RB, GB - RB); rt_units_a(p, l, L, RB, GB - RB); PHASE_END
                PHASE_BEGIN if (l == 0) STAGE(st_hy_conv0_ctx, l, N_hy_conv_c); rw_prep2b(p, l); STAGE(st_rt_state, l, N_rt_state); PHASE_END
                PHASE_BEGIN if (l == 0) STAGE(st_hy_conv1_ctx, l, N_hy_conv_c); STAGE(st_rg_out, l, N_mc); rt_units_c(p, l, L); rwc_tasks(p, L); PHASE_END
                PHASE_BEGIN rw_chain_units(p, L); hy_units(p, l, L, RB, GB - RB); PHASE_END
                PHASE_BEGIN rw_out_rows(p, l); PHASE_END
            } else if (seg == 2) {
                PHASE_BEGIN norm2_tiles(p, l, L); norm2_rows(p, l); STAGE(st_slot_init, l, MAXSLOT); PHASE_END
                PHASE_BEGIN STAGE(st_moe_slots, l, N_moe_slots); PHASE_END
            }
            PHASE_BEGIN {
                pg8::Gemm g; pg8::OrderAll S; pg8::EpiAll E; S.tile_e = WSI(O_TILEE); S.G = (int)gridDim.x; { int bl = blockIdx.x; asm volatile("" : "+s"(bl)); S.c = bl; } S.ntiles = 0; S.moe = seg >= 2; E.mode = seg; E.perm = (seg != 1); E.a2 = nullptr; E.ldc = DIN;
                if (seg == 0) { g = pg8::Gemm{WSH(O_A1), WSH(O_WIN) + (size_t)l * DIN * D, T, DIN, D, nullptr}; S.so.init(T, DIN, S.G, S.c); E.O = WSH(O_U); E.a1 = nullptr; }
                else if (seg == 1) { const int M = l == DEPTH - 1 ? TL : T; g = pg8::Gemm{WSH(O_CAT), WSH(O_WOUT) + (size_t)l * D * D, M, D, D, nullptr}; S.so.init(M, D, S.G, S.c); E.O = WSF(O_X); E.a1 = modp(p, l, 0, 2); }
                else if (seg == 2) { g = pg8::Gemm{WSH(O_A1), WSH(O_WGU) + (size_t)l * NE * 2048 * D, MAXSLOT, NE * 2048, D, WSI(O_SLOTTOK)}; S.so.init(256, 256, S.G, S.c); S.ntiles = WSI(O_TILEE)[MAXTILES]; E.O = WSH(O_ACT); E.a1 = p.in[I_moe_b_gu] + (size_t)l * NE * 2048; }
                else { g = pg8::Gemm{WSH(O_ACT), WSH(O_WDN) + (size_t)l * NE * D * FE, MAXSLOT, NE * D, FE, nullptr}; S.so.init(256, 256, S.G, S.c); S.ntiles = WSI(O_TILEE)[MAXTILES]; E.O = WSH(O_OSLOT); E.a1 = p.in[I_moe_b_dn] + (size_t)l * NE * D; E.a2 = WSF(O_SLOTP); }
                pg8::gemm_phase<pg8::EpiAll, pg8::OrderAll, false>(L, g, S, E, nullptr);
            } PHASE_END
        }
    }
    PHASE_BEGIN norm1_rows(p, DEPTH); PHASE_END
#undef PHASE_BEGIN
#undef PHASE_END
#undef STAGE
}

#ifndef MK_ONE_LAUNCH
#define MK_ONE_LAUNCH 1
#endif
extern "C" void kernel_launch(void* const* d_in, const int* in_sizes, int n_in, void* d_out, int out_size, void* d_ws, size_t ws_size, hipStream_t stream) {
    static int grid = 0;
    if (grid == 0) {
        if (n_in != N_IN || out_size != TL * D || ws_size < WS_END) { fprintf(stderr, "kernel_launch: unexpected shapes (n_in %d, out %d, ws %zu < %zu)\n", n_in, out_size, ws_size, (size_t)WS_END); grid = -1; return; }
        int dev = 0, cus = 0, per_cu = 0;
        if (hipGetDevice(&dev) != hipSuccess || hipDeviceGetAttribute(&cus, hipDeviceAttributeMultiprocessorCount, dev) != hipSuccess) { grid = -1; return; }
        if (hipFuncSetAttribute((const void*)fwd_kernel, hipFuncAttributeMaxDynamicSharedMemorySize, LDS_BYTES) != hipSuccess) { fprintf(stderr, "kernel_launch: hipFuncSetAttribute failed\n"); grid = -1; return; }
        if (hipOccupancyMaxActiveBlocksPerMultiprocessor(&per_cu, (const void*)fwd_kernel, NTHREADS, LDS_BYTES) != hipSuccess || per_cu < 1) fprintf(stderr, "kernel_launch: occupancy query says %d\n", per_cu);
        (void)hipGetLastError();
        grid = cus;
    }
    if (grid < 0) return;
    (void)hipMemsetAsync((char*)d_ws + O_CTL, 0, CTL_BYTES, stream);
    P p{};
    for (int i = 0; i < N_IN; ++i) p.in[i] = (const float*)d_in[i];
    p.out = (float*)d_out; p.ws = (unsigned char*)d_ws;
#if MK_ONE_LAUNCH
#ifdef PROBE_K
    p.lo = 0; p.hi = PROBE_K;
    hipLaunchKernelGGL(fwd_kernel, dim3(grid), dim3(NTHREADS), LDS_BYTES, stream, p);
    (void)hipMemsetAsync((char*)d_ws + O_CTL, 0, CTL_BYTES, stream);
#endif
    p.lo = 0; p.hi = NPHASES;
    hipLaunchKernelGGL(fwd_kernel, dim3(grid), dim3(NTHREADS), LDS_BYTES, stream, p);
#else
    for (int k = 0; k < NPHASES; ++k) { p.lo = k; p.hi = k + 1; hipLaunchKernelGGL(fwd_kernel, dim3(grid), dim3(NTHREADS), LDS_BYTES, stream, p); }
#endif
    const hipError_t le = hipPeekAtLastError();
    if (le != hipSuccess) fprintf(stderr, "kernel_launch: launch failed: %s\n", hipGetErrorName(le));
}
#endif
```

```cpp
#ifdef CPU_TEST
#include <cmath>
#include <cstdio>
#include <cstdlib>
#include <cstring>
#include <cstdint>
#include <vector>
#define DEV static inline
struct float4 { float x, y, z, w; };
struct uint4 { unsigned x, y, z, w; };
#else
#include <hip/hip_runtime.h>
#include <cstdio>
#include <cstdint>
#define DEV __device__ __forceinline__
#define DEV_GPU __device__ __forceinline__
#endif

#ifndef NB
#define NB 4
#endif
#ifndef SEQ
#define SEQ 4096
#endif
#ifndef CTX
#define CTX 256
#endif
constexpr int D = 2048, G = 512, DIN = 13 * G, NMOD = 6, DEPTH = 2;
constexpr int TL = NB * SEQ, TC = NB * CTX, T = TL + TC, SCANL = CTX + SEQ;
constexpr int NE = 32, TOPK = 4, FE = 1024;
constexpr int RTC = 128, NCHUNK = T / RTC, NCH_C = CTX / RTC, NCH_L = SEQ / RTC;
constexpr int MAXTILES = (T * TOPK) / 256 + NE, MAXSLOT = MAXTILES * 256;
constexpr int U_HY = 0, U_RG = 3 * G, U_RW = 5 * G, U_RT = 9 * G;
constexpr int ADA_KS = 8;
static_assert(TL % 256 == 0 && TC % 256 == 0 && SEQ % 128 == 0 && CTX % 128 == 0, "tile shapes");

enum { I_x, I_c, I_ctx, I_c_ctx, I_ada_w, I_ada_b, I_norm1_w, I_norm2_w, I_w_in, I_w_out, I_hy_short_w, I_hy_short_b, I_hy_f_w1, I_hy_f_b1, I_hy_f_w2, I_hy_f_b2,
       I_hy_f_w3, I_hy_f_b3, I_hy_f_w4, I_hy_f_freq, I_hy_bias, I_rg_conv_w, I_rg_conv_b, I_rg_wa, I_rg_ba, I_rg_wx, I_rg_bx, I_rg_lambda, I_rw_mu, I_rw_w0, I_rw_w1,
       I_rw_w2, I_rw_a0, I_rw_a1, I_rw_a2, I_rw_g1, I_rw_g2, I_rw_k_k, I_rw_k_a, I_rw_r_k, I_rw_ln_w, I_rw_ln_b, I_rw_v0, I_rw_v1, I_rw_v2, I_rt_decay, I_rt_gn_w,
       I_moe_router_w, I_moe_router_b, I_moe_w_gu, I_moe_b_gu, I_moe_w_dn, I_moe_b_dn, I_final_norm_w, N_IN };

constexpr size_t al256(size_t x) { return (x + 255) & ~(size_t)255; }
constexpr size_t O_CTL = 0;
constexpr size_t CTL_BYTES = 1u << 20;
constexpr size_t O_MODS = CTL_BYTES;
constexpr size_t O_ADAP = O_MODS + al256((size_t)2 * (NB + 1) * 12288 * 4);
constexpr size_t O_X = O_ADAP + al256((size_t)ADA_KS * 2 * (NB + 1) * 12288 * 4);
constexpr size_t O_A1 = O_X + al256((size_t)T * D * 4);
constexpr size_t O_U = O_A1 + al256((size_t)T * D * 2);
constexpr size_t O_CAT = O_U + al256((size_t)T * DIN * 2);
constexpr size_t O_WIN = O_CAT + al256((size_t)T * D * 2);
constexpr size_t O_WOUT = O_WIN + al256((size_t)2 * DIN * D * 2);
constexpr size_t O_WGU = O_WOUT + al256((size_t)2 * D * D * 2);
constexpr size_t O_WDN = O_WGU + al256((size_t)2 * NE * 2048 * 2048 * 2);
constexpr size_t O_HYA = O_WDN + al256((size_t)2 * NE * 2048 * 1024 * 2);
constexpr size_t O_HYB = O_HYA + al256((size_t)3 * SEQ * 64 * 4);
constexpr size_t O_HYAB = O_HYB + al256((size_t)3 * SEQ * 64 * 4);
constexpr size_t O_W4T = O_HYAB + al256((size_t)3 * SEQ * 64 * 2);
constexpr size_t O_TAPS = O_W4T + al256((size_t)2 * 2048 * 64 * 2);
constexpr size_t O_TAPSC = O_TAPS + al256((size_t)3 * SEQ * 2048 * 4);
constexpr size_t O_NRM = O_TAPSC + al256((size_t)CTX * 2048 * 4);
constexpr size_t O_NRMP = O_NRM + al256((size_t)3 * 2 * 512 * 4);
constexpr size_t O_ROWSS = O_NRMP + al256((size_t)3 * 64 * 1024 * 4);
constexpr size_t O_VFIRST = O_ROWSS + al256((size_t)T * 4);
constexpr size_t O_LOGITS = O_VFIRST + al256((size_t)T * G * 4);
constexpr size_t O_TOPE = O_LOGITS + al256((size_t)T * NE * 4);
constexpr size_t O_TOPP = O_TOPE + al256((size_t)T * 4 * 4);
constexpr size_t O_TOPPOS = O_TOPP + al256((size_t)T * 4 * 4);
constexpr size_t O_TOKSLOT = O_TOPPOS + al256((size_t)T * 4 * 4);
constexpr size_t O_SLOTTOK = O_TOKSLOT + al256((size_t)T * 4 * 4);
constexpr size_t O_SLOTP = O_SLOTTOK + al256((size_t)MAXSLOT * 4);
constexpr size_t O_TILEE = O_SLOTP + al256((size_t)MAXSLOT * 4);
constexpr size_t O_RWA = O_TILEE + al256((size_t)(MAXTILES + 64) * 4);
constexpr size_t O_RCB = O_RWA + al256((size_t)2 * (NB + 1) * D * NE * 4);
constexpr size_t O_MODA = O_RCB + al256((size_t)2 * (NB + 1) * NE * 4);
constexpr size_t O_MODB = O_MODA + al256((size_t)2 * (NB + 1) * D * 4);
constexpr size_t O_RWAT = O_MODB + al256((size_t)2 * (NB + 1) * D * 4);
constexpr size_t O_LW1T = O_RWAT + al256((size_t)2 * (NB + 1) * 2 * NE * D * 2);
constexpr size_t O_LG2T = O_LW1T + al256((size_t)2 * 160 * 512 * 2);
constexpr size_t O_LV2T = O_LG2T + al256((size_t)2 * 512 * 128 * 2);
constexpr size_t O_LWA1T = O_LV2T + al256((size_t)2 * 512 * 32 * 2);
constexpr size_t O_LW2T = O_LWA1T + al256((size_t)8 * 128 * 512 * 2);
constexpr size_t O_LA2T = O_LW2T + al256((size_t)4 * 512 * 64 * 2);
constexpr size_t O_TRB = O_LA2T + al256((size_t)4 * 512 * 64 * 2);
constexpr size_t O_SCR = O_TRB + al256((size_t)2 * 2 * 512 * 8192 * 2);
constexpr size_t SZ_TG = al256((size_t)T * G * 4), SZ_2TG = al256((size_t)2 * T * G * 4);
constexpr size_t O_HYU = O_SCR;
constexpr size_t O_HZ1 = O_HYU + al256((size_t)T * 1536 * 4);
constexpr size_t O_RGXC = O_HZ1 + SZ_TG;
constexpr size_t O_RGA = O_RGXC + SZ_2TG, O_RGB = O_RGA + SZ_2TG, O_RGH = O_RGB + SZ_2TG;
constexpr size_t O_RWV = O_RGH + SZ_2TG, O_RWG = O_RWV + SZ_TG;
constexpr size_t O_LH = O_RWG + SZ_TG;
constexpr size_t O_LHW = O_LH + al256((size_t)T * 160 * 4);
constexpr size_t O_SR = O_LHW + al256((size_t)2 * T * 128 * 4);
constexpr size_t O_SW = O_SR + SZ_2TG, O_SK = O_SW + SZ_2TG, O_SV = O_SK + SZ_2TG, O_SKKR = O_SV + SZ_2TG, O_SA = O_SKKR + SZ_2TG, O_SKK = O_SA + SZ_2TG,
                 O_SKKA = O_SKK + SZ_2TG, O_SY = O_SKKA + SZ_2TG;
constexpr size_t O_RQ = O_SY + SZ_2TG, O_RK = O_RQ + SZ_TG;
constexpr size_t O_SC = O_RK + SZ_TG;
constexpr size_t SZ_SC = al256((size_t)NCHUNK * 4 * 128 * 128 * 4);
constexpr size_t O_KV = O_SC + SZ_SC, O_SPREV = O_KV + 2 * SZ_SC;
constexpr size_t O_RO = O_SPREV + 2 * SZ_SC;
constexpr size_t O_ZT = O_RO + SZ_TG;
constexpr size_t O_RWEND0 = O_ZT + al256((size_t)3 * NB * 512 * SEQ * 2);
constexpr int RWC = 16, NCK = (CTX + SEQ) / RWC, NCHAIN = 2 * NB * 8, NTASK = NCHAIN * NCK;
constexpr size_t O_CAAT = O_RWEND0, O_CABH = O_CAAT + SZ_2TG, O_CAKH = O_CABH + SZ_2TG, O_CART = O_CAKH + SZ_2TG;
constexpr size_t O_CAGC = O_CART + SZ_2TG;
constexpr size_t SZ_T256 = al256((size_t)NTASK * 256 * 4);
constexpr size_t O_CANT = O_CAGC + al256((size_t)NTASK * 64 * 4), O_CAMT = O_CANT + SZ_T256, O_CAQK = O_CAMT + SZ_T256, O_CAQB = O_CAQK + SZ_T256, O_CATT = O_CAQB + SZ_T256;
constexpr size_t O_OW1 = O_CATT + SZ_T256;
constexpr size_t O_ORT = O_OW1 + al256((size_t)NTASK * 1024 * 2);
constexpr size_t O_OTM = O_ORT + al256((size_t)NTASK * 1024 * 2);
constexpr size_t O_OQKB = O_OTM + al256((size_t)NTASK * 512 * 2);
constexpr size_t O_OKB = O_OQKB + al256((size_t)NTASK * 512 * 2);
constexpr size_t O_OVT = O_OKB + al256((size_t)NTASK * 2048 * 2);
constexpr size_t O_RQB = O_OVT + al256((size_t)NTASK * 1024 * 2);
constexpr size_t O_H2 = O_RQB + al256((size_t)T * G * 2);
constexpr size_t O_MIXEND = O_H2 + al256((size_t)2 * T * 128 * 2);
constexpr size_t O_AG = O_SCR;
constexpr size_t O_ACT = O_AG + al256((size_t)MAXSLOT * D * 2);
constexpr size_t O_OSLOT = O_ACT + al256((size_t)MAXSLOT * FE * 2);
constexpr size_t O_MOEEND = O_OSLOT + al256((size_t)MAXSLOT * D * 4);
constexpr size_t WS_END = O_MIXEND > O_MOEEND ? O_MIXEND : O_MOEEND;
constexpr int CW_COUNTS = 8192, CW_CSTR = 64;
constexpr int CW_BAR = 4096;

struct P { const float* in[N_IN]; float* out; unsigned char* ws; int lo, hi; };
#ifdef CPU_TEST
#define PREF const P&
#else
#define PREF const __attribute__((address_space(4))) P&
#endif
#define WSF(off) ((float*)(p.ws + (off)))
#define WSI(off) ((int*)(p.ws + (off)))
#define WSH(off) ((unsigned short*)(p.ws + (off)))

DEV unsigned short f2bf(float f) { unsigned u; memcpy(&u, &f, 4); u += 0x7fffu + ((u >> 16) & 1u); return (unsigned short)(u >> 16); }
DEV float bf2f(unsigned short h) { unsigned u = ((unsigned)h) << 16; float f; memcpy(&f, &u, 4); return f; }
DEV float sigm(float x) { return 1.0f / (1.0f + expf(-x)); }
DEV float siluf(float x) { return x * sigm(x); }
DEV float softplusf(float x) { return fmaxf(x, 0.f) + log1pf(expf(-fabsf(x))); }
DEV float gelu_tanh(float x) { return 0.5f * x * (1.0f + tanhf(0.7978845608028654f * (x + 0.044715f * x * x * x))); }
DEV int tok_t(int m) { return m < TL ? m % SEQ : (m - TL) % CTX; }
DEV int tok_len(int m) { return m < TL ? SEQ : CTX; }
DEV int mod_row(int m) { return m < TL ? m / SEQ : NB; }
DEV int tok_prev(int m, int d, int k) { const int t = tok_t(m); if (d == 0) return t - k >= 0 ? m - k : -1; return t + k < tok_len(m) ? m + k : -1; }
DEV int scan_tok(int d, int b, int pp) { if (pp < CTX) { const int tc = d == 0 ? pp : CTX - 1 - pp; return TL + b * CTX + tc; } const int q = pp - CTX; return b * SEQ + (d == 0 ? q : SEQ - 1 - q); }
DEV float ldu(PREF p, int m, int col) { return bf2f(WSH(O_U)[(size_t)m * DIN + col]); }
DEV const float* modp(PREF p, int l, int row, int which) { return WSF(O_MODS) + ((size_t)(l * (NB + 1) + row) * NMOD + which) * D; }

DEV void st_copy_x(PREF p, int, long g) { const long n4 = (long)TL * D / 4; const float4* s = g < n4 ? (const float4*)p.in[I_x] + g : (const float4*)p.in[I_ctx] + (g - n4); ((float4*)WSF(O_X))[g] = *s; }
constexpr long N_copy_x = (long)T * D / 4;

DEV void st_ada_part(PREF p, int, long g) {
    const int c4 = (int)(g % 3072), ks = (int)((g / 3072) % ADA_KS), l = (int)(g / (3072 * ADA_KS));
    float acc[NB + 1][4];
#pragma unroll
    for (int r = 0; r <= NB; ++r) { acc[r][0] = acc[r][1] = acc[r][2] = acc[r][3] = 0.f; }
    const float* aw = p.in[I_ada_w] + (size_t)l * D * 12288;
    for (int k = ks * (D / ADA_KS); k < (ks + 1) * (D / ADA_KS); ++k) {
        const float4 w = *(const float4*)(aw + (size_t)k * 12288 + c4 * 4);
#pragma unroll
        for (int r = 0; r <= NB; ++r) { const float cv = siluf(r < NB ? p.in[I_c][r * D + k] : p.in[I_c_ctx][k]); acc[r][0] += cv * w.x; acc[r][1] += cv * w.y; acc[r][2] += cv * w.z; acc[r][3] += cv * w.w; }
    }
#pragma unroll
    for (int r = 0; r <= NB; ++r) { float4 o; o.x = acc[r][0]; o.y = acc[r][1]; o.z = acc[r][2]; o.w = acc[r][3];
        *(float4*)(WSF(O_ADAP) + ((size_t)(ks * 2 + l) * (NB + 1) + r) * 12288 + c4 * 4) = o; }
}
constexpr long N_ada_part = 2L * ADA_KS * 3072;
DEV void st_ada_red(PREF p, int, long g) {
    const int col = (int)(g % 12288), r = (int)((g / 12288) % (NB + 1)), l = (int)(g / (12288 * (NB + 1)));
    float s = p.in[I_ada_b][l * 12288 + col];
    for (int ks = 0; ks < ADA_KS; ++ks) s += WSF(O_ADAP)[((size_t)(ks * 2 + l) * (NB + 1) + r) * 12288 + col];
    WSF(O_MODS)[(size_t)(l * (NB + 1) + r) * 12288 + col] = s;
}
constexpr long N_ada_red = 2L * (NB + 1) * 12288;

DEV void cvt_one(const float* W, int K, int N, unsigned short* WT, long g, int permute_gu) {
    const int n = (int)(g % N), k8 = (int)(g / N);
    unsigned short o[8];
#pragma unroll
    for (int j = 0; j < 8; ++j) o[j] = f2bf(W[(size_t)(k8 * 8 + j) * N + n]);
    int nd = n;
    if (permute_gu) { const int bj = n / 1024, r = n % 1024, pn = r / 128, j = r % 128; nd = pn * 256 + bj * 128 + j; }
    uint4 v; memcpy(&v, o, 16);
    *(uint4*)(WT + (size_t)nd * K + k8 * 8) = v;
}
DEV void st_cvt_win(PREF p, int, long g) { const long per = (long)D / 8 * DIN; const int l = (int)(g / per); cvt_one(p.in[I_w_in] + (size_t)l * D * DIN, D, DIN, WSH(O_WIN) + (size_t)l * DIN * D, g % per, 0); }
constexpr long N_cvt_win = 2L * (D / 8) * DIN;
DEV void st_cvt_wout(PREF p, int, long g) { const long per = (long)D / 8 * D; const int l = (int)(g / per); cvt_one(p.in[I_w_out] + (size_t)l * D * D, D, D, WSH(O_WOUT) + (size_t)l * D * D, g % per, 0); }
constexpr long N_cvt_wout = 2L * (D / 8) * D;
DEV void st_cvt_wgu(PREF p, int, long g) { const long per = (long)D / 8 * 2048; const int le = (int)(g / per); cvt_one(p.in[I_moe_w_gu] + (size_t)le * D * 2048, D, 2048, WSH(O_WGU) + (size_t)le * 2048 * D, g % per, 1); }
constexpr long N_cvt_wgu = 2L * NE * (D / 8) * 2048;
DEV void st_cvt_wdn(PREF p, int, long g) { const long per = (long)FE / 8 * D; const int le = (int)(g / per); cvt_one(p.in[I_moe_w_dn] + (size_t)le * FE * D, FE, D, WSH(O_WDN) + (size_t)le * D * FE, g % per, 0); }
constexpr long N_cvt_wdn = 2L * NE * (FE / 8) * D;

DEV void st_rowss(PREF p, int, long g) { const float4* x = (const float4*)(WSF(O_X) + (size_t)g * D); float s = 0.f; for (int i = 0; i < D / 4; ++i) { const float4 v = x[i]; s += v.x * v.x + v.y * v.y + v.z * v.z + v.w * v.w; } WSF(O_ROWSS)[g] = s; }
DEV float modval(PREF p, int l, int m, int c, int which) {
    const float rinv = 1.0f / sqrtf(WSF(O_ROWSS)[m] * (1.0f / D) + 1e-6f);
    const float nw = (which == 0 ? p.in[I_norm1_w] : p.in[I_norm2_w])[l * D + c];
    const int r = mod_row(m);
    return WSF(O_X)[(size_t)m * D + c] * rinv * nw * (1.0f + modp(p, l, r, which + 1)[c]) + modp(p, l, r, which)[c];
}
DEV void st_mod1(PREF p, int l, long g) { const int m = (int)(g / D), c = (int)(g % D); WSH(O_A1)[g] = f2bf(modval(p, l, m, c, 0)); }
DEV void st_mod2(PREF p, int l, long g) { const int m = (int)(g / D), c = (int)(g % D); WSH(O_A1)[g] = f2bf(modval(p, l, m, c, 3)); }

DEV int hv_layer(int vi) { return vi == 1 ? 1 : 0; }
DEV int hv_len(int vi) { return vi == 2 ? CTX : SEQ; }
DEV void st_hy_h1(PREF p, int, long g) {
    const int j = (int)(g % 64), n = (int)((g / 64) % SEQ), vi = (int)(g / (64 * SEQ)); const int L = hv_len(vi), l = hv_layer(vi); if (n >= L) return;
    const float* w1 = p.in[I_hy_f_w1] + l * 33 * 64;
    const float t = (float)n / (float)(L - 1);
    float s = t * w1[j];
    for (int i = 0; i < 16; ++i) { const float fr = 1e-4f + (float)i * ((15.0f - 1e-4f) / 15.0f); const float ang = (6.283185307179586f / (float)L) * (float)n * fr;
        s += cosf(ang) * w1[(1 + i) * 64 + j] - sinf(ang) * w1[(17 + i) * 64 + j]; }
    WSF(O_HYA)[((size_t)vi * SEQ + n) * 64 + j] = sinf(p.in[I_hy_f_freq][l * 64 + j] * (s + p.in[I_hy_f_b1][l * 64 + j]));
}
DEV void hy_hidden(PREF p, long g, const float* src, float* dst, int wi, int bi) {
    const int j = (int)(g % 64), n = (int)((g / 64) % SEQ), vi = (int)(g / (64 * SEQ)); const int L = hv_len(vi), l = hv_layer(vi); if (n >= L) return;
    const float* w = p.in[wi] + l * 64 * 64; const float* h = src + ((size_t)vi * SEQ + n) * 64;
    float s = 0.f; for (int i = 0; i < 64; ++i) s += h[i] * w[i * 64 + j];
    dst[((size_t)vi * SEQ + n) * 64 + j] = sinf(p.in[I_hy_f_freq][l * 64 + j] * (s + p.in[bi][l * 64 + j]));
}
DEV void st_hy_h2(PREF p, int, long g) { hy_hidden(p, g, WSF(O_HYA), WSF(O_HYB), I_hy_f_w2, I_hy_f_b2); }
DEV void st_hy_h3(PREF p, int, long g) { hy_hidden(p, g, WSF(O_HYB), WSF(O_HYA), I_hy_f_w3, I_hy_f_b3); }
constexpr long N_hy_h = 3L * SEQ * 64;
DEV void st_hy_raw(PREF p, int, long g) {
    const int n = (int)(g % SEQ), cg = (int)((g / SEQ) % 32), vi = (int)(g / (32L * SEQ)); const int L = hv_len(vi), l = hv_layer(vi); if (n >= L) return;
    const float* w4 = p.in[I_hy_f_w4] + (size_t)l * 64 * 2048 + cg * 64; const float* hp = WSF(O_HYA) + ((size_t)vi * SEQ + n) * 64;
    float h[64];
#pragma unroll
    for (int i = 0; i < 64; ++i) h[i] = hp[i];
    const float t = (float)n / (float)(L - 1);
    const float dmin = -3.0701134573253944f, dmax = -15.350567286626973f;
    for (int cc = 0; cc < 64; ++cc) { const int col = cg * 64 + cc; float s = 0.f;
#pragma unroll
        for (int i = 0; i < 64; ++i) s += h[i] * w4[i * 2048 + cc];
        const float delta = fabsf(dmin + (float)(col % 512) * ((dmax - dmin) / 511.0f));
        WSF(O_TAPS)[((size_t)vi * 2048 + col) * SEQ + n] = s * expf(-t * delta); }
}
constexpr long N_hy_raw = 3L * SEQ * 2048, N_hy_raw_thr = 3L * 32 * SEQ;
constexpr int HNP = 64;
DEV void st_hy_nrm1(PREF p, int, long g) {
    const int part = (int)(g % HNP), c = (int)((g / HNP) % 512), o = (int)((g / (HNP * 512)) % 2), vi = (int)(g / (1024 * HNP)); const int L = hv_len(vi);
    const float* tf = WSF(O_TAPS) + ((size_t)vi * 2048 + o * 512 + c) * SEQ; const float* tb = tf + (size_t)1024 * SEQ; float s = 0.f; const int per = (L + HNP - 1) / HNP;
    for (int n = part * per; n < (part + 1) * per && n < L; ++n) { s += fabsf(tf[n]); if (n >= 1) s += fabsf(tb[n]); }
    WSF(O_NRMP)[((size_t)vi * HNP + part) * 1024 + o * 512 + c] = s;
}
constexpr long N_hy_nrm1 = 3L * HNP * 1024;
DEV void st_hy_nrm(PREF p, int, long g) {
    const int oc = (int)(g % 1024), vi = (int)(g / 1024); float s = 0.f;
    for (int part = 0; part < HNP; ++part) s += WSF(O_NRMP)[((size_t)vi * HNP + part) * 1024 + oc];
    WSF(O_NRM)[g] = s;
}
constexpr long N_hy_nrm = 3L * 2 * 512;
DEV void st_hy_scale(PREF p, int, long g) {
    const int n = (int)(g % SEQ), col = (int)((g / SEQ) % 2048), vi = 2; if (n >= hv_len(vi)) return;
    WSF(O_TAPSC)[(size_t)n * 2048 + col] = WSF(O_TAPS)[(size_t)vi * 2048 * SEQ + g] / WSF(O_NRM)[vi * 1024 + ((col / 512) % 2) * 512 + col % 512];
}

DEV void st_hy_trb(PREF p, int, long g) {
    const int y = (int)(g % 8192), c = (int)((g / 8192) % 512), o = (int)((g / (8192 * 512)) % 2), vi = (int)(g / (8192L * 512 * 2));
    const int e = 4095 - y; float v = 0.f;
    if (e >= 0 && e < SEQ) v = WSF(O_TAPS)[((size_t)vi * 2048 + o * 512 + c) * SEQ + e];
    else if (e < 0 && -e < SEQ) v = WSF(O_TAPS)[((size_t)vi * 2048 + 1024 + o * 512 + c) * SEQ + (-e)];
    WSH(O_TRB)[g] = f2bf(v / WSF(O_NRM)[vi * 1024 + o * 512 + c]);
}
constexpr long N_hy_trb = 2L * 2 * 512 * 8192;
DEV void st_hy_shortT(PREF p, int l, long g) {
    const int c = (int)(g % 512), t8 = (int)((g / 512) % (SEQ / 8)), b = (int)((g / (512 * (SEQ / 8))) % NB), sidx = (int)(g / (512L * (SEQ / 8) * NB));
    const int col = sidx * 512 + c; const float* sw = p.in[I_hy_short_w] + l * 3 * 1536; const float w0 = sw[col], w1 = sw[1536 + col], w2 = sw[2 * 1536 + col], sb = p.in[I_hy_short_b][l * 1536 + col];
    float x[10];
#pragma unroll
    for (int i = 0; i < 10; ++i) { const int t = t8 * 8 - 1 + i; x[i] = (t >= 0 && t < SEQ) ? ldu(p, b * SEQ + t, col) : 0.f; }
    unsigned pk[4];
#pragma unroll
    for (int i = 0; i < 4; ++i) pk[i] = (unsigned)f2bf(w0 * x[2 * i] + w1 * x[2 * i + 1] + w2 * x[2 * i + 2] + sb) | ((unsigned)f2bf(w0 * x[2 * i + 1] + w1 * x[2 * i + 2] + w2 * x[2 * i + 3] + sb) << 16);
    uint4 v; v.x = pk[0]; v.y = pk[1]; v.z = pk[2]; v.w = pk[3];
    *(uint4*)(WSH(O_ZT) + ((size_t)(sidx * NB + b) * 512 + c) * SEQ + t8 * 8) = v;
}
constexpr long N_hy_shortT = 3L * NB * (SEQ / 8) * 512;
DEV void st_hy_short(PREF p, int l, long g) {
    const int c = (int)(g % 1536), m = (int)(g / 1536); if (l == 1 && m >= TL) return;
    const float* sw = p.in[I_hy_short_w] + l * 3 * 1536; const int pm = tok_prev(m, 0, 1), nm = tok_prev(m, 1, 1);
    float s = sw[1536 + c] * ldu(p, m, c) + p.in[I_hy_short_b][l * 1536 + c];
    if (pm >= 0) s += sw[c] * ldu(p, pm, c);
    if (nm >= 0) s += sw[2 * 1536 + c] * ldu(p, nm, c);
    WSF(O_HYU)[g] = s;
}
constexpr long N_hy_short = (long)T * 1536;
constexpr int HTT = 16;
constexpr long N_hy_conv_l = (long)NB * (SEQ / HTT) * 512, N_hy_conv_c = (long)NB * (CTX / HTT) * 512;
DEV void st_hy_conv(PREF p, int l, int o, long g) {
    int c, tt, b, L, vi, m0;
    if (g < N_hy_conv_l) { c = (int)(g % 512); tt = (int)((g / 512) % (SEQ / HTT)); b = (int)(g / (512 * (SEQ / HTT))); L = SEQ; vi = l; m0 = b * SEQ; }
    else { if (l == 1) return; g -= N_hy_conv_l; c = (int)(g % 512); tt = (int)((g / 512) % (CTX / HTT)); b = (int)(g / (512 * (CTX / HTT))); L = CTX; vi = 2; m0 = TL + b * CTX; }
    const float* tp = WSF(O_TAPSC) + o * 512 + c;
    const float* zin = o == 0 ? WSF(O_HYU) + c : WSF(O_HZ1) + c; const int zs = o == 0 ? 1536 : 512;
    const int t0 = tt * HTT;
    float acc[HTT];
#pragma unroll
    for (int i = 0; i < HTT; ++i) acc[i] = 0.f;
    for (int s0 = 0; s0 < L; s0 += HTT) {
        float w[2 * HTT - 1], z[HTT];
#pragma unroll
        for (int q = 0; q < 2 * HTT - 1; ++q) { const int d = t0 - s0 + (q - (HTT - 1)); w[q] = (d >= 0) ? (d < L ? tp[(size_t)d * 2048] : 0.f) : (-d < L ? tp[(size_t)(-d) * 2048 + 1024] : 0.f); }
#pragma unroll
        for (int j = 0; j < HTT; ++j) z[j] = zin[(size_t)(m0 + s0 + j) * zs];
#pragma unroll
        for (int i = 0; i < HTT; ++i)
#pragma unroll
            for (int j = 0; j < HTT; ++j) acc[i] += w[i - j + HTT - 1] * z[j];
    }
    const float bias = p.in[I_hy_bias][l * 1024 + o * 512 + c];
#pragma unroll
    for (int i = 0; i < HTT; ++i) { const int m = m0 + t0 + i; const float zt = zin[(size_t)m * zs]; const float gate = WSF(O_HYU)[(size_t)m * 1536 + (o + 1) * 512 + c];
        const float r = gate * (acc[i] + bias * zt);
        if (o == 0) WSF(O_HZ1)[(size_t)m * 512 + c] = r; else WSH(O_CAT)[(size_t)m * D + c] = f2bf(r); }
}
DEV void st_hy_conv0(PREF p, int l, long g) { st_hy_conv(p, l, 0, g); }
DEV void st_hy_conv1(PREF p, int l, long g) { st_hy_conv(p, l, 1, g); }
constexpr long N_hy_conv = N_hy_conv_l + N_hy_conv_c;
DEV void st_hy_short_ctx(PREF p, int l, long g) { st_hy_short(p, l, g + (long)TL * 1536); }
constexpr long N_hy_short_ctx = (long)TC * 1536;
DEV void st_hy_conv0_ctx(PREF p, int l, long g) { st_hy_conv(p, l, 0, g + N_hy_conv_l); }
DEV void st_hy_conv1_ctx(PREF p, int l, long g) { st_hy_conv(p, l, 1, g + N_hy_conv_l); }

constexpr long N_dmc = 2L * T * G;
DEV void st_rg_conv(PREF p, int l, long g) {
    const int c = (int)(g % G), m = (int)((g / G) % T), d = (int)(g / ((long)G * T));
    const float* cw = p.in[I_rg_conv_w] + (size_t)(l * 2 + d) * 4 * G;
    float s = p.in[I_rg_conv_b][(l * 2 + d) * G + c];
    for (int j = 0; j < 4; ++j) { const int pm = tok_prev(m, d, 3 - j); if (pm >= 0) s += cw[j * G + c] * ldu(p, pm, U_RG + c); }
    WSF(O_RGXC)[g] = s;
}
DEV void st_rg_gate(PREF p, int l, long g) {
    const int c = (int)(g % G), m = (int)((g / G) % T), d = (int)(g / ((long)G * T)); const int h = c / 64, j = c % 64;
    const float* xc = WSF(O_RGXC) + ((size_t)d * T + m) * G + h * 64;
    const float* wa = p.in[I_rg_wa] + ((size_t)(l * 2 + d) * 8 + h) * 4096; const float* wx = p.in[I_rg_wx] + ((size_t)(l * 2 + d) * 8 + h) * 4096;
    float sa = p.in[I_rg_ba][(l * 2 + d) * G + c], sx = p.in[I_rg_bx][(l * 2 + d) * G + c];
    for (int i = 0; i < 64; ++i) { sa += xc[i] * wa[i * 64 + j]; sx += xc[i] * wx[i * 64 + j]; }
    const float r = sigm(sa), ig = sigm(sx);
    const float log_a = -8.0f * r * softplusf(-p.in[I_rg_lambda][(l * 2 + d) * G + c]);
    WSF(O_RGA)[g] = expf(log_a);
    WSF(O_RGB)[g] = sqrtf(-expm1f(2.0f * log_a)) * (ig * xc[j]);
}
DEV void st_rg_scan(PREF p, int, long g) {
    const int c = (int)(g % G), b = (int)((g / G) % NB), d = (int)(g / (G * NB));
    float h = 0.f;
    for (int p0 = 0; p0 < SCANL; p0 += 8) {
        float a[8], bb[8]; size_t idx[8];
#pragma unroll
        for (int j = 0; j < 8; ++j) { idx[j] = ((size_t)d * T + scan_tok(d, b, p0 + j)) * G + c; a[j] = WSF(O_RGA)[idx[j]]; bb[j] = WSF(O_RGB)[idx[j]]; }
#pragma unroll
        for (int j = 0; j < 8; ++j) { h = a[j] * h + bb[j]; WSF(O_RGH)[idx[j]] = h; }
    }
}
constexpr long N_rg_scan = 2L * NB * G;
DEV void st_rg_out(PREF p, int l, long g) {
    const int c = (int)(g % G), m = (int)(g / G); if (l == 1 && m >= TL) return;
    const float h = WSF(O_RGH)[(size_t)m * G + c] + WSF(O_RGH)[((size_t)T + m) * G + c];
    WSH(O_CAT)[(size_t)m * D + G + c] = f2bf(h * gelu_tanh(ldu(p, m, U_RG + G + c)));
}
constexpr long N_mc = (long)T * G;

DEV void st_rw_lh(PREF p, int l, long g) {
    const int j = (int)(g % 160), m = (int)(g / 160);
    float s = 0.f;
    if (j < 32) { if (l == 0) return; const float* v1 = p.in[I_rw_v1] + (size_t)(l - 1) * G * 32; for (int c = 0; c < G; ++c) s += ldu(p, m, U_RW + 3 * G + c) * v1[c * 32 + j]; }
    else { const float* g1 = p.in[I_rw_g1] + (size_t)l * G * 128; for (int c = 0; c < G; ++c) s += ldu(p, m, U_RW + 3 * G + c) * g1[c * 128 + (j - 32)]; s = sigm(s); }
    WSF(O_LH)[g] = s;
}
constexpr long N_rw_lh = (long)T * 160;
DEV void st_rw_vg(PREF p, int l, long g) {
    const int c = (int)(g % G), m = (int)(g / G);
    const float* lh = WSF(O_LH) + (size_t)m * 160;
    float v = ldu(p, m, U_RW + 2 * G + c);
    if (l == 0) WSF(O_VFIRST)[g] = v;
    else { const float* v2 = p.in[I_rw_v2] + (size_t)(l - 1) * 32 * G; float s = p.in[I_rw_v0][(l - 1) * G + c]; for (int j = 0; j < 32; ++j) s += lh[j] * v2[j * G + c]; v = v + (WSF(O_VFIRST)[g] - v) * sigm(s); }
    WSF(O_RWV)[g] = v;
    const float* g2 = p.in[I_rw_g2] + (size_t)l * 128 * G; float s = 0.f; for (int j = 0; j < 128; ++j) s += lh[32 + j] * g2[j * G + c];
    WSF(O_RWG)[g] = s;
}
DEV void st_rw_lhw(PREF p, int l, long g) {
    const int j = (int)(g % 128), m = (int)((g / 128) % T), d = (int)(g / (128L * T));
    const int pm = tok_prev(m, d, 1); const float* mu = p.in[I_rw_mu] + ((size_t)(l * 2 + d) * 4 + 3) * G;
    const float* w = j < 64 ? p.in[I_rw_w1] + (size_t)(l * 2 + d) * G * 64 + j : p.in[I_rw_a1] + (size_t)(l * 2 + d) * G * 64 + (j - 64);
    float s = 0.f;
    for (int c = 0; c < G; ++c) { const float z = ldu(p, m, U_RW + 3 * G + c), zp = pm >= 0 ? ldu(p, pm, U_RW + 3 * G + c) : 0.f; s += (z + (zp - z) * mu[c]) * w[c * 64]; }
    WSF(O_LHW)[g] = j < 64 ? tanhf(s) : s;
}
constexpr long N_rw_lhw = 2L * T * 128;
DEV void st_rw_tok(PREF p, int l, long g) {
    const int c = (int)(g % G), m = (int)((g / G) % T), d = (int)(g / ((long)G * T)); const int ld = l * 2 + d;
    const float* lhw = WSF(O_LHW) + ((size_t)d * T + m) * 128;
    const float* w2 = p.in[I_rw_w2] + (size_t)ld * 64 * G; const float* a2 = p.in[I_rw_a2] + (size_t)ld * 64 * G;
    float wl = p.in[I_rw_w0][ld * G + c], al = p.in[I_rw_a0][ld * G + c];
    for (int j = 0; j < 64; ++j) { wl += lhw[j] * w2[j * G + c]; al += lhw[64 + j] * a2[j * G + c]; }
    const float w_log = -softplusf(-wl) - 0.5f; const float dec = expf(-expf(w_log)); const float a = sigm(al);
    const int pm = tok_prev(m, d, 1); const float* mu = p.in[I_rw_mu] + (size_t)ld * 4 * G;
    const float r0 = ldu(p, m, U_RW + c), k0 = ldu(p, m, U_RW + G + c), v0 = WSF(O_RWV)[(size_t)m * G + c];
    const float rp = pm >= 0 ? ldu(p, pm, U_RW + c) : 0.f, kp = pm >= 0 ? ldu(p, pm, U_RW + G + c) : 0.f, vp = pm >= 0 ? WSF(O_RWV)[(size_t)pm * G + c] : 0.f;
    const float rs = r0 + (rp - r0) * mu[c], ks = k0 + (kp - k0) * mu[G + c], vs = v0 + (vp - v0) * mu[2 * G + c];
    WSF(O_SR)[g] = rs; WSF(O_SW)[g] = dec; WSF(O_SV)[g] = vs; WSF(O_SA)[g] = a;
    WSF(O_SK)[g] = ks * (1.0f + (a - 1.0f) * p.in[I_rw_k_a][l * G + c]);
    WSF(O_SKKR)[g] = ks * p.in[I_rw_k_k][l * G + c];
}
DEV void st_rw_kk(PREF p, int, long g) {
    const int c = (int)(g % G); const float* kr = WSF(O_SKKR) + (g - c) + (c / 64) * 64;
    float s = 0.f; for (int i = 0; i < 64; ++i) s += kr[i] * kr[i];
    const float kk = WSF(O_SKKR)[g] / fmaxf(sqrtf(s), 1e-12f);
    WSF(O_SKK)[g] = kk; WSF(O_SKKA)[g] = kk * WSF(O_SA)[g];
}
DEV void st_rw_scan(PREF p, int, long g) {
    const int i = (int)(g % 64), h = (int)((g / 64) % 8), b = (int)((g / 512) % NB), d = (int)(g / (512 * NB));
    float S[64];
#pragma unroll
    for (int j = 0; j < 64; ++j) S[j] = 0.f;
    for (int pp = 0; pp < SCANL; ++pp) {
        const size_t base = ((size_t)d * T + scan_tok(d, b, pp)) * G + h * 64;
        const float* kk = WSF(O_SKK) + base; const float* kka = WSF(O_SKKA) + base; const float* w = WSF(O_SW) + base; const float* k = WSF(O_SK) + base; const float* r = WSF(O_SR) + base;
        const float v = WSF(O_SV)[base + i];
        float sa = 0.f;
#pragma unroll
        for (int j = 0; j < 64; ++j) sa += S[j] * kk[j];
        float y = 0.f;
#pragma unroll
        for (int j = 0; j < 64; ++j) { S[j] = S[j] * w[j] - sa * kka[j] + v * k[j]; y += S[j] * r[j]; }
        WSF(O_SY)[base + i] = y;
    }
}
constexpr long N_rw_scan = 2L * NB * 512;


DEV void st_lora_cvt(PREF p, int, long g) {
    long r = g;
    if (r < 2L * 160 * 512) { const int k = (int)(r % 512), n = (int)((r / 512) % 160), l = (int)(r / (160 * 512));
        float v = 0.f; if (n < 32) { if (l >= 1) v = p.in[I_rw_v1][((size_t)(l - 1) * G + k) * 32 + n]; } else v = p.in[I_rw_g1][((size_t)l * G + k) * 128 + (n - 32)];
        WSH(O_LW1T)[r] = f2bf(v); return; } r -= 2L * 160 * 512;
    if (r < 2L * 512 * 128) { const int k = (int)(r % 128), c = (int)((r / 128) % 512), l = (int)(r / (128 * 512)); WSH(O_LG2T)[r] = f2bf(p.in[I_rw_g2][((size_t)l * 128 + k) * G + c]); return; } r -= 2L * 512 * 128;
    if (r < 2L * 512 * 32) { const int k = (int)(r % 32), c = (int)((r / 32) % 512), l = (int)(r / (32 * 512)); WSH(O_LV2T)[r] = f2bf(l >= 1 ? p.in[I_rw_v2][((size_t)(l - 1) * 32 + k) * G + c] : 0.f); return; } r -= 2L * 512 * 32;
    if (r < 8L * 128 * 512) { const int k = (int)(r % 512), n = (int)((r / 512) % 128), half = (int)((r / (128 * 512)) % 2), ld = (int)(r / (2 * 128 * 512));
        const float mz = p.in[I_rw_mu][((size_t)ld * 4 + 3) * G + k]; const float wv = n < 64 ? p.in[I_rw_w1][((size_t)ld * G + k) * 64 + n] : p.in[I_rw_a1][((size_t)ld * G + k) * 64 + (n - 64)];
        WSH(O_LWA1T)[r] = f2bf(wv * (half == 0 ? 1.0f - mz : mz)); return; } r -= 8L * 128 * 512;
    if (r < 4L * 512 * 64) { const int k = (int)(r % 64), c = (int)((r / 64) % 512), ld = (int)(r / (64 * 512)); WSH(O_LW2T)[r] = f2bf(p.in[I_rw_w2][((size_t)ld * 64 + k) * G + c]); return; } r -= 4L * 512 * 64;
    if (r < 4L * 512 * 64) { const int k = (int)(r % 64), c = (int)((r / 64) % 512), ld = (int)(r / (64 * 512)); WSH(O_LA2T)[r] = f2bf(p.in[I_rw_a2][((size_t)ld * 64 + k) * G + c]); }
}
constexpr long N_lora_cvt = 2L * 160 * 512 + 2L * 512 * 128 + 2L * 512 * 32 + 8L * 128 * 512 + 8L * 512 * 64;
DEV void rw_chain_decode(int chain, int& d, int& b, int& h) { h = chain % 8; b = (chain / 8) % NB; d = chain / (8 * NB); }
DEV void st_rwc_a1(PREF p, int, long g) {
    const int c = (int)(g % 64); const long task = g / 64; const int ck = (int)(task % NCK), chain = (int)(task / NCK); int d, b, h; rw_chain_decode(chain, d, b, h);
    float gam = 1.0f;
    for (int t = 0; t < RWC; ++t) {
        const size_t base = ((size_t)d * T + scan_tok(d, b, ck * RWC + t)) * G + h * 64 + c; const size_t o = ((size_t)task * RWC + t) * 64 + c;
        WSF(O_CAAT)[o] = WSF(O_SKK)[base] * gam;
        gam *= WSF(O_SW)[base]; const float inv = 1.0f / gam;
        WSF(O_CABH)[o] = WSF(O_SKKA)[base] * inv; WSF(O_CAKH)[o] = WSF(O_SK)[base] * inv; WSF(O_CART)[o] = WSF(O_SR)[base] * gam;
    }
    WSF(O_CAGC)[g] = gam;
}
constexpr long N_rwc_a1 = (long)NTASK * 64;
DEV void st_rwc_a2(PREF p, int, long g) {
    const int j = (int)(g % 16), t = (int)((g / 16) % 16); const long task = g / 256;
    const float* at = WSF(O_CAAT) + ((size_t)task * 16 + t) * 64; const float* rt = WSF(O_CART) + ((size_t)task * 16 + t) * 64;
    const float* bh = WSF(O_CABH) + ((size_t)task * 16 + j) * 64; const float* kh = WSF(O_CAKH) + ((size_t)task * 16 + j) * 64;
    float nt = 0.f, mt = 0.f, qk = 0.f, qb = 0.f;
    if (t >= j) { for (int c = 0; c < 64; ++c) { nt += at[c] * bh[c]; mt += at[c] * kh[c]; qk += rt[c] * kh[c]; qb += rt[c] * bh[c]; } }
    if (t == j) { nt = 0.f; mt = 0.f; }
    WSF(O_CANT)[g] = nt; WSF(O_CAMT)[g] = mt; WSF(O_CAQK)[g] = qk; WSF(O_CAQB)[g] = qb;
}
constexpr long N_rwc_a2 = (long)NTASK * 256;
DEV void st_rwc_a3(PREF p, int, long g) {
    const int col = (int)(g % 16); const long task = g / 16; const float* nt = WSF(O_CANT) + (size_t)task * 256;
    float x[16];
#pragma unroll
    for (int t = 0; t < 16; ++t) { float s = (t == col) ? 1.0f : 0.0f;
#pragma unroll
        for (int j = 0; j < 16; ++j) if (j < t) s -= nt[t * 16 + j] * x[j];
        x[t] = s; }
#pragma unroll
    for (int t = 0; t < 16; ++t) WSF(O_CATT)[(size_t)task * 256 + t * 16 + col] = x[t];
}
constexpr long N_rwc_a3 = (long)NTASK * 16;
DEV void st_rwc_a4(PREF p, int, long g) {
    const int e = (int)(g % 3328); const long task = g / 3328; const int ck = (int)(task % NCK), chain = (int)(task / NCK);
    const float* tt = WSF(O_CATT) + (size_t)task * 256;
    if (e < 1024) { const int c = e % 64, t = e / 64; float s = 0.f; for (int j = 0; j <= t; ++j) s += tt[t * 16 + j] * WSF(O_CAAT)[((size_t)task * 16 + j) * 64 + c];
        WSH(O_OW1)[(size_t)task * 1024 + e] = f2bf(s); WSH(O_ORT)[(size_t)task * 1024 + e] = f2bf(WSF(O_CART)[(size_t)task * 1024 + e]); }
    else if (e < 1280) { const int j = (e - 1024) % 16, t = (e - 1024) / 16; float s = 0.f; for (int i = 0; i <= t; ++i) s += tt[t * 16 + i] * WSF(O_CAMT)[(size_t)task * 256 + i * 16 + j];
        WSH(O_OTM)[(size_t)task * 512 + t * 32 + j] = f2bf(s); WSH(O_OTM)[(size_t)task * 512 + t * 32 + 16 + j] = 0;
        WSH(O_OQKB)[(size_t)task * 512 + t * 32 + j] = f2bf(WSF(O_CAQK)[(size_t)task * 256 + t * 16 + j]); WSH(O_OQKB)[(size_t)task * 512 + t * 32 + 16 + j] = f2bf(-WSF(O_CAQB)[(size_t)task * 256 + t * 16 + j]); }
    else if (e < 2304) { const int t = (e - 1280) % 16, c = (e - 1280) / 16; const float gc = WSF(O_CAGC)[(size_t)task * 64 + c];
        WSH(O_OKB)[(size_t)task * 2048 + c * 32 + t] = f2bf(WSF(O_CAKH)[((size_t)task * 16 + t) * 64 + c] * gc); WSH(O_OKB)[(size_t)task * 2048 + c * 32 + 16 + t] = f2bf(-WSF(O_CABH)[((size_t)task * 16 + t) * 64 + c] * gc); }
    else { const int t = (e - 2304) % 16, v = (e - 2304) / 16; int d, b, h; rw_chain_decode(chain, d, b, h);
        WSH(O_OVT)[(size_t)task * 1024 + v * 16 + t] = f2bf(WSF(O_SV)[((size_t)d * T + scan_tok(d, b, ck * RWC + t)) * G + h * 64 + v]); }
}
constexpr long N_rwc_a4 = (long)NTASK * 3328;
DEV void st_rwc_b(PREF p, int, long g) {
    const int v = (int)(g % 64), chain = (int)(g / 64); int d, b, h; rw_chain_decode(chain, d, b, h);
    float S[64];
#pragma unroll
    for (int c = 0; c < 64; ++c) S[c] = 0.f;
    for (int ck = 0; ck < NCK; ++ck) {
        const size_t task = (size_t)chain * NCK + ck;
        const unsigned short* w1 = WSH(O_OW1) + task * 1024; const unsigned short* rt = WSH(O_ORT) + task * 1024; const unsigned short* tm = WSH(O_OTM) + task * 512; const unsigned short* qkb = WSH(O_OQKB) + task * 512;
        const unsigned short* kb = WSH(O_OKB) + task * 2048; const unsigned short* vt = WSH(O_OVT) + task * 1024 + v * 16;
        float Sb[64], V[16], U[16];
#pragma unroll
        for (int c = 0; c < 64; ++c) Sb[c] = bf2f(f2bf(S[c]));
#pragma unroll
        for (int t = 0; t < 16; ++t) V[t] = bf2f(vt[t]);
#pragma unroll
        for (int t = 0; t < 16; ++t) { float s = 0.f;
#pragma unroll
            for (int c = 0; c < 64; ++c) s += bf2f(w1[t * 64 + c]) * Sb[c];
#pragma unroll
            for (int j = 0; j < 16; ++j) s += bf2f(tm[t * 32 + j]) * V[j];
            U[t] = bf2f(f2bf(s)); }
#pragma unroll
        for (int t = 0; t < 16; ++t) { float s = 0.f;
#pragma unroll
            for (int c = 0; c < 64; ++c) s += bf2f(rt[t * 64 + c]) * Sb[c];
#pragma unroll
            for (int j = 0; j < 16; ++j) s += bf2f(qkb[t * 32 + j]) * V[j] + bf2f(qkb[t * 32 + 16 + j]) * U[j];
            WSF(O_SY)[((size_t)d * T + scan_tok(d, b, ck * RWC + t)) * G + h * 64 + v] = s; }
#pragma unroll
        for (int c = 0; c < 64; ++c) { float s = WSF(O_CAGC)[task * 64 + c] * S[c];
#pragma unroll
            for (int t = 0; t < 16; ++t) s += bf2f(kb[c * 32 + t]) * V[t] + bf2f(kb[c * 32 + 16 + t]) * U[t];
            S[c] = s; }
    }
}
constexpr long N_rwc_b = (long)NCHAIN * 64;
DEV void st_rw_out(PREF p, int l, long g) {
    const int c = (int)(g % G), m = (int)(g / G); if (l == 1 && m >= TL) return; const int h0 = (c / 64) * 64;
    float tot = 0.f;
    for (int d = 0; d < 2; ++d) {
        const size_t base = ((size_t)d * T + m) * G + h0;
        const float* y = WSF(O_SY) + base; const float* r = WSF(O_SR) + base; const float* k = WSF(O_SK) + base;
        float mean = 0.f, bon = 0.f;
        for (int i = 0; i < 64; ++i) { mean += y[i]; bon += r[i] * k[i] * p.in[I_rw_r_k][l * G + h0 + i]; }
        mean *= (1.0f / 64.0f);
        float var = 0.f; for (int i = 0; i < 64; ++i) { const float dd = y[i] - mean; var += dd * dd; }
        var *= (1.0f / 64.0f);
        tot += (y[c - h0] - mean) / sqrtf(var + 64e-5f) * p.in[I_rw_ln_w][l * G + c] + p.in[I_rw_ln_b][l * G + c] + bon * WSF(O_SV)[base + (c - h0)];
    }
    WSH(O_CAT)[(size_t)m * D + 2 * G + c] = f2bf(tot * WSF(O_RWG)[(size_t)m * G + c]);
}

#ifdef CPU_TEST
DEV float rt_lg(PREF p, int l, int d, int h) { return -softplusf(p.in[I_rt_decay][(l * 2 + d) * 4 + h]); }
#else
DEV float fast_softplus(float x) { return x > 15.0f ? x : __logf(1.0f + __expf(x)); }
DEV float rt_lg(PREF p, int l, int d, int h) { return -fast_softplus(p.in[I_rt_decay][(l * 2 + d) * 4 + h]); }
#endif
DEV void st_rt_prep(PREF p, int, long g) {
    const int c = (int)(g % G), m = (int)(g / G); const int e = c % 128;
    float q = ldu(p, m, U_RT + c), k = ldu(p, m, U_RT + G + c);
    if (m < TL) {
        const int t = m % SEQ; const int half = e / 64, eh = e % 64, i = eh % 32; const float pos = half == 0 ? (float)(t / 64) : (float)(t % 64);
        const float ang = pos * powf(10000.0f, -(float)i / 32.0f); const float cs = cosf(ang), sn = sinf(ang);
        const int cp = eh < 32 ? c + 32 : c - 32;
        const float qp = ldu(p, m, U_RT + cp), kp = ldu(p, m, U_RT + G + cp);
        if (eh < 32) { q = q * cs - qp * sn; k = k * cs - kp * sn; } else { q = qp * sn + q * cs; k = kp * sn + k * cs; }
    }
    WSF(O_RQ)[g] = q; WSF(O_RK)[g] = k * 0.08838834764831845f;
}
DEV void st_rt_score(PREF p, int, long g) {
    const int j = (int)(g % 128), i = (int)((g / 128) % 128), h = (int)((g / 16384) % 4), ch = (int)(g / 65536);
    const float* q = WSF(O_RQ) + (size_t)(ch * 128 + i) * G + h * 128; const float* k = WSF(O_RK) + (size_t)(ch * 128 + j) * G + h * 128;
    float s = 0.f; for (int e = 0; e < 128; ++e) s += q[e] * k[e];
    WSF(O_SC)[g] = s;
}
constexpr long N_rt_score = (long)NCHUNK * 4 * 128 * 128;
DEV void st_rt_kv(PREF p, int l, long g) {
    const int e = (int)(g % 128), dd = (int)((g / 128) % 128), h = (int)((g / 16384) % 4), ch = (int)((g / 65536) % NCHUNK), d = (int)(g / (65536L * NCHUNK));
    const float lg = rt_lg(p, l, d, h); float s = 0.f;
    for (int j = 0; j < 128; ++j) { const int m = ch * 128 + j; const float dec = expf(lg * (float)(d == 0 ? 127 - j : j)); s += dec * WSF(O_RK)[(size_t)m * G + h * 128 + dd] * ldu(p, m, U_RT + 2 * G + h * 128 + e); }
    WSF(O_KV)[g] = s;
}
constexpr long N_rt_kv = 2L * N_rt_score;
DEV int rt_scan_chunk(int d, int b, int n) {
    if (n < NCH_C) return TL / 128 + b * NCH_C + (d == 0 ? n : NCH_C - 1 - n);
    const int q = n - NCH_C; return b * NCH_L + (d == 0 ? q : NCH_L - 1 - q);
}
DEV void st_rt_state(PREF p, int l, long g) {
    const int de = (int)(g % 16384), h = (int)((g / 16384) % 4), b = (int)((g / 65536) % NB), d = (int)(g / (65536L * NB));
    const float cdec = expf(128.0f * rt_lg(p, l, d, h)); float S = 0.f;
    for (int n = 0; n < NCH_C + NCH_L; ++n) { const size_t i = (((size_t)d * NCHUNK + rt_scan_chunk(d, b, n)) * 4 + h) * 16384 + de; WSF(O_SPREV)[i] = S; S = cdec * S + WSF(O_KV)[i]; }
}
constexpr long N_rt_state = 2L * NB * 4 * 16384;
DEV void st_rt_out(PREF p, int l, long g) {
    const int c = (int)(g % G), m = (int)(g / G); const int h = c / 128, e = c % 128, ch = m / 128, i = m % 128;
    const float lg0 = rt_lg(p, l, 0, h), lg1 = rt_lg(p, l, 1, h);
    const float* sc = WSF(O_SC) + (((size_t)ch * 4 + h) * 128 + i) * 128;
    float o = 0.f;
    for (int j = 0; j < 128; ++j) { const float w = j <= i ? expf(lg0 * (float)(i - j)) : expf(lg1 * (float)(j - i)); o += w * sc[j] * ldu(p, ch * 128 + j, U_RT + 2 * G + h * 128 + e); }
    const float* q = WSF(O_RQ) + (size_t)m * G + h * 128;
    const float* s0 = WSF(O_SPREV) + (((size_t)0 * NCHUNK + ch) * 4 + h) * 16384 + e; const float* s1 = WSF(O_SPREV) + (((size_t)1 * NCHUNK + ch) * 4 + h) * 16384 + e;
    float c0 = 0.f, c1 = 0.f; for (int dd = 0; dd < 128; ++dd) { c0 += q[dd] * s0[dd * 128]; c1 += q[dd] * s1[dd * 128]; }
    WSF(O_RO)[g] = o + expf(lg0 * (float)(i + 1)) * c0 + expf(lg1 * (float)(128 - i)) * c1;
}
DEV void st_rt_fin(PREF p, int l, long g) {
    const int c = (int)(g % G), m = (int)(g / G); if (l == 1 && m >= TL) return; const float* o = WSF(O_RO) + (size_t)m * G + (c / 128) * 128;
    float mean = 0.f; for (int i = 0; i < 128; ++i) mean += o[i]; mean *= (1.0f / 128.0f);
    float var = 0.f; for (int i = 0; i < 128; ++i) { const float dd = o[i] - mean; var += dd * dd; } var *= (1.0f / 128.0f);
    WSH(O_CAT)[(size_t)m * D + 3 * G + c] = f2bf((o[c % 128] - mean) / sqrtf(var + 1e-6f) * p.in[I_rt_gn_w][l * G + c] * siluf(ldu(p, m, U_RT + 3 * G + c)));
}

DEV int moe_ntok(int l) { return l == DEPTH - 1 ? TL : T; }
DEV void st_moe_fold(PREF p, int, long g) {
    const long nA = 2L * (NB + 1) * D * NE;
    if (g < nA) { const int e = (int)(g % NE), k = (int)((g / NE) % D), r = (int)((g / ((long)NE * D)) % (NB + 1)), l = (int)(g / ((long)NE * D * (NB + 1)));
        const float av = p.in[I_norm2_w][l * D + k] * (1.0f + modp(p, l, r, 4)[k]); const float v = av * p.in[I_moe_router_w][((size_t)l * D + k) * NE + e];
        WSF(O_RWA)[g] = v; const unsigned short hi = f2bf(v); const size_t o = (((size_t)(l * (NB + 1) + r) * 2) * NE + e) * D + k;
        WSH(O_RWAT)[o] = hi; WSH(O_RWAT)[o + (size_t)NE * D] = f2bf(v - bf2f(hi));
        if (e == 0) { WSF(O_MODA)[(size_t)(l * (NB + 1) + r) * D + k] = av; WSF(O_MODB)[(size_t)(l * (NB + 1) + r) * D + k] = modp(p, l, r, 3)[k]; } }
    else { g -= nA; if (g >= 2L * (NB + 1) * NE) return; const int e = (int)(g % NE), r = (int)((g / NE) % (NB + 1)), l = (int)(g / (NE * (NB + 1)));
        float s = p.in[I_moe_router_b][l * NE + e]; const float* sh = modp(p, l, r, 3); for (int k = 0; k < D; ++k) s += sh[k] * p.in[I_moe_router_w][((size_t)l * D + k) * NE + e];
        WSF(O_RCB)[g] = s; }
}
constexpr long N_moe_fold = 2L * (NB + 1) * D * NE + 2L * (NB + 1) * NE;
DEV void st_moe_logit(PREF p, int l, long g) {
    const int e = (int)(g % NE), m = (int)(g / NE); if (m >= moe_ntok(l)) return; const int r = mod_row(m);
    const float* rwa = WSF(O_RWA) + ((size_t)(l * (NB + 1) + r) * D) * NE + e; const float* x = WSF(O_X) + (size_t)m * D;
    float s = 0.f;
    for (int k = 0; k < D; k += 4) { const float4 xv = *(const float4*)(x + k); s += xv.x * rwa[(size_t)k * NE] + xv.y * rwa[(size_t)(k + 1) * NE] + xv.z * rwa[(size_t)(k + 2) * NE] + xv.w * rwa[(size_t)(k + 3) * NE]; }
    WSF(O_LOGITS)[g] = s / sqrtf(WSF(O_ROWSS)[m] * (1.0f / D) + 1e-6f) + WSF(O_RCB)[(l * (NB + 1) + r) * NE + e];
}
constexpr long N_moe_logit = (long)T * NE;
DEV int atomic_inc(int* a) {
#ifdef CPU_TEST
    return __sync_fetch_and_add(a, 1);
#else
    return atomicAdd(a, 1);
#endif
}
DEV void st_moe_topk(PREF p, int l, long g) {
    if (g < MAXSLOT) { WSI(O_SLOTTOK)[g] = 0; WSF(O_SLOTP)[g] = 0.f; }
    const int m = (int)g; if (m >= moe_ntok(l)) return;
    const float* lg = WSF(O_LOGITS) + (size_t)m * NE;
    int idx[4]; float val[4]; unsigned used = 0u;
#pragma unroll
    for (int k = 0; k < 4; ++k) { int bi = -1; float bv = 0.f; for (int e = 0; e < NE; ++e) { if (used & (1u << e)) continue; const float v = lg[e]; if (bi < 0 || v > bv) { bi = e; bv = v; } } idx[k] = bi; val[k] = bv; used |= 1u << bi; }
    float ex[4], sum = 0.f;
#pragma unroll
    for (int k = 0; k < 4; ++k) { ex[k] = expf(val[k] - val[0]); sum += ex[k]; }
#pragma unroll
    for (int k = 0; k < 4; ++k) { WSI(O_TOPE)[m * 4 + k] = idx[k]; WSF(O_TOPP)[m * 4 + k] = ex[k] / sum; WSI(O_TOPPOS)[m * 4 + k] = atomic_inc((int*)(p.ws + O_CTL) + CW_COUNTS + (l * NE + idx[k]) * CW_CSTR); }
}
constexpr long N_moe_topk = MAXSLOT > T ? MAXSLOT : T;
DEV void st_moe_slots(PREF p, int l, long g) {
    const int* cnt0 = (const int*)(p.ws + O_CTL) + CW_COUNTS + l * NE * CW_CSTR;
#define cnt(e_) cnt0[(e_) * CW_CSTR]
    if (g == 0) { int nt = 0; for (int e = 0; e < NE; ++e) { const int n = (cnt(e) + 255) / 256; for (int i = 0; i < n; ++i) WSI(O_TILEE)[nt + i] = e; nt += n; } WSI(O_TILEE)[MAXTILES] = nt; }
    const int m = (int)(g / 4); if (m >= moe_ntok(l)) return;
    const int e = WSI(O_TOPE)[g]; int base = 0; for (int i = 0; i < e; ++i) base += ((cnt(i) + 255) / 256) * 256;
    const int slot = base + WSI(O_TOPPOS)[g];
    WSI(O_SLOTTOK)[slot] = m; WSF(O_SLOTP)[slot] = WSF(O_TOPP)[g]; WSI(O_TOKSLOT)[g] = slot;
#undef cnt
}
constexpr long N_moe_slots = (long)T * 4;
DEV void st_moe_gather(PREF p, int, long g) {
    const int c8 = (int)(g % (D / 8)), slot = (int)(g / (D / 8)); if (slot >= WSI(O_TILEE)[MAXTILES] * 256) return;
    ((uint4*)WSH(O_AG))[g] = ((const uint4*)WSH(O_A1))[(size_t)WSI(O_SLOTTOK)[slot] * (D / 8) + c8];
}
constexpr long N_moe_gather = (long)MAXSLOT * (D / 8);
DEV void st_moe_comb(PREF p, int l, long g) {
    const int c = (int)(g % D), m = (int)(g / D); if (m >= moe_ntok(l)) return;
    float s = 0.f; for (int k = 0; k < 4; ++k) s += WSF(O_OSLOT)[(size_t)WSI(O_TOKSLOT)[m * 4 + k] * D + c];
    WSF(O_X)[g] += modp(p, l, mod_row(m), 5)[c] * s;
}
DEV void st_final(PREF p, int, long g) {
    const int c = (int)(g % D), m = (int)(g / D);
    p.out[g] = WSF(O_X)[g] / sqrtf(WSF(O_ROWSS)[m] * (1.0f / D) + 1e-6f) * p.in[I_final_norm_w][c];
}

#ifndef CPU_TEST
constexpr int LDS_WTAB = 147456 + 64;
__device__ __forceinline__ int hw_tid() {
    const unsigned phys = (unsigned)__builtin_amdgcn_s_getreg((5 << 11) | 4) & 63u;
    const int wv = __builtin_amdgcn_readfirstlane(((volatile __attribute__((address_space(3))) int*)(unsigned)LDS_WTAB)[phys]);
    int lane; asm volatile("v_mbcnt_lo_u32_b32 %0, -1, 0\n\tv_mbcnt_hi_u32_b32 %0, -1, %0" : "=v"(lane));
    return wv * 64 + lane;
}
__device__ __forceinline__ float lane_xor(float v, int mask, int lane) { return __builtin_bit_cast(float, __builtin_amdgcn_ds_bpermute(((lane ^ mask) & 63) << 2, __builtin_bit_cast(int, v))); }
__device__ __forceinline__ float lane_bcast(float v, int src) { return __builtin_bit_cast(float, __builtin_amdgcn_readlane(__builtin_bit_cast(int, v), src)); }
namespace pg8 {
#define PG8_LAS __attribute__((address_space(3)))
typedef unsigned short bf16_t;
typedef short bf16x8 __attribute__((ext_vector_type(8)));
typedef float f32x4 __attribute__((ext_vector_type(4)));
typedef unsigned u32x4 __attribute__((ext_vector_type(4)));
constexpr int BM = 256, BK = 64, HALF = 128, HTB = HALF * BK * 2  , STAGE_BYTES = 8 * HTB, NXCD = 8, WGM = 8;

__host__ __device__ __forceinline__ int lds_byte(int r, int c) { const int st = (r >> 4) * 2 + (c >> 5), rr = r & 15, cc = c & 31, ob = rr * 64 + cc * 2; return st * 1024 + (ob ^ (((ob >> 9) & 1) << 5)); }
__host__ __device__ __forceinline__ void stage_rc(int b, int& R, int& C) { const int st = b / 1024, sb = b % 1024, swz = sb ^ (((sb >> 9) & 1) << 5); R = (st >> 1) * 16 + swz / 64; C = (st & 1) * 32 + (swz % 64) / 2; }
__host__ __device__ __forceinline__ int perm32(int rho) { const int n = rho >> 4, i = rho & 15; return 8 * (i >> 2) + 4 * n + (i & 3); }
struct Unit { int pm, pn; };
struct Gemm { const bf16_t* A; const bf16_t* Bt; int M, N, K; const int* rowmap; };
struct StaticOrder {
    int nM, nN, nwg, G, c;
    __host__ __device__ void init(int M, int N, int G_, int c_) { nM = M / BM; nN = N / BM; nwg = nM * nN; G = G_; c = c_; }
    __host__ __device__ bool next(int i, Unit& u) const {
        const long L = (long)i * G + c; if (L >= nwg) return false;
        int wgid = (int)L; { const int q = nwg / NXCD, r = nwg % NXCD, xcd = wgid % NXCD, off = wgid / NXCD; wgid = (xcd < r ? xcd * (q + 1) : r * (q + 1) + (xcd - r) * q) + off; }
        const int nig = WGM * nN, gid = wgid / nig, fm = gid * WGM, gsz = (nM - fm) < WGM ? (nM - fm) : WGM;
        u.pm = fm + ((wgid % nig) % gsz); u.pn = (wgid % nig) / gsz; return true;
    }
    __device__ __forceinline__ void a_ready(const Unit&) const {}
    __device__ __forceinline__ void done(const Unit&) const {}
};
__device__ __forceinline__ unsigned cvt_pk_bf16(float lo, float hi) { unsigned r; asm volatile("v_cvt_pk_bf16_f32 %0, %1, %2" : "=v"(r) : "v"(lo), "v"(hi)); return r; }
template <class Epi, class Sched, bool STAMP = false>
__device__ __forceinline__ void gemm_phase(PG8_LAS unsigned char* lds, const Gemm g, const Sched& S, const Epi& E, unsigned long long* stamps) {
    int tid = hw_tid(); asm volatile("" : "+v"(tid)); const int wid = __builtin_amdgcn_readfirstlane(tid >> 6), lane = tid & 63, wr = wid >> 2, wc = wid & 3, fr = lane & 15, fq = lane >> 4;
    const int K = g.K, nt = K / BK;
    int ts_lo = 0, ts_hi = 0, nts = 0; const unsigned long long rt_entry = STAMP ? (unsigned long long)wall_clock64() : 0ull;
#define PG8_STAMP() do { if (STAMP && wid == 0 && nts < 64) { const unsigned long long _c = (unsigned long long)clock64(); \
        ts_lo = (lane == nts) ? (int)(unsigned)_c : ts_lo; ts_hi = (lane == nts) ? (int)(unsigned)(_c >> 32) : ts_hi; ++nts; } } while (0)
    PG8_STAMP();
    unsigned vA0[2], vA1[2], voffB[2];
#pragma unroll
    for (int i = 0; i < 2; ++i) { int R, C; stage_rc(tid * 16 + i * 8192, R, C); const int Rb = E.perm ? ((R & ~31) + perm32(R & 31)) : R; voffB[i] = (unsigned)(Rb * K + C) * 2u; }
#define PG8_AOFF(un) do { _Pragma("unroll") for (int _i = 0; _i < 2; ++_i) { int _R, _C; stage_rc(tid * 16 + _i * 8192, _R, _C); const int _r0 = (un).pm * BM + _R; \
        const unsigned _row0 = g.rowmap ? (unsigned)g.rowmap[_r0] : (unsigned)_r0, _row1 = g.rowmap ? (unsigned)g.rowmap[_r0 + HALF] : (unsigned)(_r0 + HALF); \
        vA0[_i] = (_row0 * (unsigned)K + (unsigned)_C) * 2u; vA1[_i] = (_row1 * (unsigned)K + (unsigned)_C) * 2u; } } while (0)
    const size_t kstep = (size_t)(BK * 2);
    const size_t hstep = (size_t)HALF * K * 2;
    const size_t tstep = 2 * hstep;
    const unsigned ldsw = (unsigned)wid * 1024u;
    const int aoff = lds_byte(wr * 64 + fr, fq * 8), boff = lds_byte(wc * 32 + fr, fq * 8);
#define PG8_SA(b, h) (((b) * 2 + (h)) * HTB)
#define PG8_SB(b, h) ((4 + (b) * 2 + (h)) * HTB)
#define PG8_STAGE(bufoff, gbase, voff) do { _Pragma("unroll") for (int _i = 0; _i < 2; ++_i) \
        __builtin_amdgcn_global_load_lds((const unsigned*)((const char*)(gbase) + (voff)[_i]), (PG8_LAS unsigned*)(lds + (bufoff) + ldsw + _i * 8192), 16, 0, 0); } while (0)
#define PG8_LDA(dst, b, h) do { _Pragma("unroll") for (int m = 0; m < 4; ++m) _Pragma("unroll") for (int k = 0; k < 2; ++k) dst[m][k] = *(const PG8_LAS bf16x8*)(lds + PG8_SA(b, h) + aoff + m * 2048 + k * 1024); } while (0)
#define PG8_LDB(dst, b, h) do { _Pragma("unroll") for (int n = 0; n < 2; ++n) _Pragma("unroll") for (int k = 0; k < 2; ++k) dst[n][k] = *(const PG8_LAS bf16x8*)(lds + PG8_SB(b, h) + boff + n * 2048 + k * 1024); } while (0)
#define PG8_MMA(ai, bj, At, Bt) do { __builtin_amdgcn_s_setprio(1); _Pragma("unroll") for (int m = 0; m < 4; ++m) _Pragma("unroll") for (int n = 0; n < 2; ++n) _Pragma("unroll") for (int k = 0; k < 2; ++k) \
        acc[ai][bj][m][n] = __builtin_amdgcn_mfma_f32_16x16x32_bf16(Bt[n][k], At[m][k], acc[ai][bj][m][n], 0, 0, 0); __builtin_amdgcn_s_setprio(0); } while (0)
#define PG8_WAIT_V(n) asm volatile("s_waitcnt vmcnt(" #n ")" ::: "memory")
#define PG8_WAIT_L(n) asm volatile("s_waitcnt lgkmcnt(" #n ")" ::: "memory")
#define PG8_BAR __builtin_amdgcn_s_barrier()
#define PG8_SCHED __builtin_amdgcn_sched_barrier(0)
    Unit cur, nxt; int ui = 0;
    if (!S.next(0, cur)) return;
    f32x4 acc[2][2][4][2];
#pragma unroll
    for (int a = 0; a < 2; ++a)
#pragma unroll
        for (int b = 0; b < 2; ++b)
#pragma unroll
            for (int m = 0; m < 4; ++m)
#pragma unroll
                for (int n = 0; n < 2; ++n) acc[a][b][m][n] = (f32x4){0.f, 0.f, 0.f, 0.f};
    bf16x8 At[4][2], B0[2][2], B1[2][2];
    const char* cA = (const char*)g.A; const char* cB = (const char*)g.Bt + (size_t)cur.pn * tstep;
    PG8_AOFF(cur);
    S.a_ready(cur);
    PG8_STAGE(PG8_SB(0, 0), cB, voffB); PG8_STAGE(PG8_SB(0, 1), cB + hstep, voffB); PG8_STAGE(PG8_SA(0, 0), cA, vA0); PG8_STAGE(PG8_SA(0, 1), cA, vA1);
    if (wr == 1) PG8_BAR;
    PG8_WAIT_V(2); PG8_BAR;
    PG8_STAGE(PG8_SB(1, 0), cB + kstep, voffB); PG8_STAGE(PG8_SA(1, 0), cA + kstep, vA0); PG8_STAGE(PG8_SB(1, 1), cB + hstep + kstep, voffB);
    PG8_WAIT_V(6); PG8_BAR;
    PG8_STAMP();
    for (;;) {
        const bool has_next = S.next(ui + 1, nxt);
        const char* nB = has_next ? (const char*)g.Bt + (size_t)nxt.pn * tstep : cB;
        for (int t = 0; t < nt; t += 2) {
            const bool last = (t == nt - 2);
            const char* a1 = cA + (size_t)(t + 1) * kstep;
            const char* a2 = cA + (last ? (size_t)0 : (size_t)(t + 2) * kstep); const char* b2 = last ? nB : cB + (size_t)(t + 2) * kstep;
            const char* a3 = a2 + kstep; const char* b3 = b2 + kstep;
            if (last && has_next) S.a_ready(nxt);
            PG8_LDB(B0, 0, 0); PG8_LDB(B1, 0, 1); PG8_SCHED; PG8_LDA(At, 0, 0); PG8_STAGE(PG8_SA(1, 1), a1, vA1);
            if (last && has_next) PG8_AOFF(nxt);
            PG8_WAIT_V(8); PG8_WAIT_L(0); PG8_BAR; PG8_MMA(0, 0, At, B0); PG8_MMA(0, 1, At, B1); PG8_BAR; PG8_SCHED;
            PG8_LDA(At, 0, 1); PG8_STAGE(PG8_SB(0, 0), b2, voffB); PG8_STAGE(PG8_SB(0, 1), b2 + hstep, voffB); PG8_STAGE(PG8_SA(0, 0), a2, vA0);
            PG8_WAIT_V(8); PG8_WAIT_L(0); PG8_BAR; PG8_MMA(1, 0, At, B0); PG8_MMA(1, 1, At, B1); PG8_BAR; PG8_SCHED;
            PG8_LDB(B0, 1, 0); PG8_LDB(B1, 1, 1); PG8_SCHED; PG8_LDA(At, 1, 0); PG8_STAGE(PG8_SA(0, 1), a2, vA1);
            PG8_WAIT_V(8); PG8_WAIT_L(0); PG8_BAR; PG8_MMA(0, 0, At, B0); PG8_MMA(0, 1, At, B1); PG8_BAR; PG8_SCHED;
            PG8_LDA(At, 1, 1); PG8_STAGE(PG8_SB(1, 0), b3, voffB); PG8_STAGE(PG8_SB(1, 1), b3 + hstep, voffB); PG8_STAGE(PG8_SA(1, 0), a3, vA0);
            PG8_WAIT_V(8); PG8_WAIT_L(0); PG8_BAR; PG8_MMA(1, 0, At, B0); PG8_MMA(1, 1, At, B1); PG8_BAR; PG8_SCHED;
        }
        PG8_STAMP();
        if (wr == 0) PG8_BAR;
        if constexpr (!Epi::AFTER_DRAIN) { E(acc, cur, wr, wc, fr, fq); S.done(cur); }
        PG8_STAMP();
        if (!has_next) break;
#pragma unroll
        for (int a = 0; a < 2; ++a)
#pragma unroll
            for (int b = 0; b < 2; ++b)
#pragma unroll
                for (int m = 0; m < 4; ++m)
#pragma unroll
                    for (int n = 0; n < 2; ++n) acc[a][b][m][n] = (f32x4){0.f, 0.f, 0.f, 0.f};
        cur = nxt; cB = nB; ++ui;
        if (wr == 1) PG8_BAR;
    }
    PG8_WAIT_V(0);
    PG8_BAR;
    if constexpr (Epi::AFTER_DRAIN) { E.fused(acc, cur, wr, wc, fr, fq, lds, wid, lane); S.done(cur); }
    PG8_STAMP();
    if (STAMP && wid == 0) { stamps[lane] = lane < nts ? (((unsigned long long)(unsigned)ts_hi << 32) | (unsigned)ts_lo) : 0ull;
        if (lane == 62) stamps[62] = rt_entry; if (lane == 63) stamps[63] = (unsigned long long)wall_clock64(); }
#undef PG8_STAMP
#undef PG8_SA
#undef PG8_SB
#undef PG8_STAGE
#undef PG8_AOFF
#undef PG8_LDA
#undef PG8_LDB
#undef PG8_MMA
#undef PG8_WAIT_V
#undef PG8_WAIT_L
#undef PG8_BAR
#undef PG8_SCHED
}
}

#define LAS __attribute__((address_space(3)))
#define XB_TMO      128
#define XB_XCNT(j)  (256  + 64 * (j))
#define XB_XSUB(j)  (1280 + 64 * (j))
#define XB_XGEN(j)  (2304 + 64 * (j))
#define XB_TOP      3328
#define XB_TOPGEN   3392
#define XCD_BAR_WORDS 3456
#define XB_SPIN_CAP (1u << 24)

__device__ __forceinline__ unsigned xb_ld(unsigned* p)              { return __hip_atomic_load(p, __ATOMIC_RELAXED, __HIP_MEMORY_SCOPE_AGENT); }
__device__ __forceinline__ unsigned xb_add(unsigned* p, unsigned v) { return __hip_atomic_fetch_add(p, v, __ATOMIC_RELAXED, __HIP_MEMORY_SCOPE_AGENT); }
__device__ __forceinline__ unsigned xb_xcc_id() { return (unsigned)__builtin_amdgcn_s_getreg((3 << 11) | 20) & 0xFu; }
#define XB_SPIN(cond, bar) do { unsigned _sp = 0; while (cond) { __builtin_amdgcn_s_sleep(1); \
    if ((++_sp & 255u) == 0u) { if (xb_ld(&(bar)[XB_TMO])) break; if (_sp > XB_SPIN_CAP) { atomicAdd(&(bar)[XB_TMO], 1u); break; } } } } while (0)

struct XcdBarrier {
    unsigned* bar; unsigned x;
    volatile LAS unsigned* st;
};

__device__ __forceinline__ XcdBarrier xcd_barrier_post(unsigned* bar, volatile LAS unsigned* st) {
    XcdBarrier b; b.bar = bar; b.x = xb_xcc_id(); b.st = st;
    if (hw_tid() == 0) (void)xb_add(&bar[XB_XCNT(b.x)], 1u);
    return b;
}
__device__ __forceinline__ void xcd_barrier_complete(unsigned* bar, unsigned x, unsigned& nloc, unsigned& nx) {
    const unsigned G = gridDim.x * gridDim.y * gridDim.z;
    unsigned sum, cnt, mine, sp = 0u;
    for (;;) {
        sum = 0u; cnt = 0u; mine = 0u;
#pragma unroll
        for (unsigned j = 0; j < 16; ++j) { const unsigned c = xb_ld(&bar[XB_XCNT(j)]); sum += c; cnt += (c > 0u) ? 1u : 0u; mine = (j == x) ? c : mine; }
        if (sum == G) break;
        __builtin_amdgcn_s_sleep(1);
        if ((++sp & 255u) == 0u) { if (xb_ld(&bar[XB_TMO])) break; if (sp > XB_SPIN_CAP) { atomicAdd(&bar[XB_TMO], 1u); break; } }
    }
    nloc = mine > 0u ? mine : 1u; nx = cnt > 0u ? cnt : 1u;
}

__device__ __forceinline__ void xcd_barrier(const XcdBarrier& b) {
    asm volatile("s_waitcnt vmcnt(0)" ::: "memory");
    __syncthreads();
    if (hw_tid() == 0) {
        unsigned* bar = b.bar;
        __builtin_amdgcn_s_waitcnt(0);
        unsigned nloc = b.st[0], nx = b.st[1];
        if (nloc == 0u) { xcd_barrier_complete(bar, b.x, nloc, nx); b.st[0] = nloc; b.st[1] = nx; }
        const unsigned old = xb_add(&bar[XB_XSUB(b.x)], 1u);
        const unsigned gen = old / nloc;
        if (old + 1u == (gen + 1u) * nloc) {
            __builtin_amdgcn_fence(__ATOMIC_RELEASE, "agent");
            asm volatile("s_waitcnt vmcnt(0)" ::: "memory");
            const unsigned og = xb_add(&bar[XB_TOP], 1u);
            const unsigned tg = og / nx;
            if (og + 1u == (tg + 1u) * nx) xb_add(&bar[XB_TOPGEN], 1u);
            else XB_SPIN(xb_ld(&bar[XB_TOPGEN]) == tg, bar);
            __builtin_amdgcn_fence(__ATOMIC_ACQUIRE, "agent");
            xb_add(&bar[XB_XGEN(b.x)], 1u);
            asm volatile("s_waitcnt vmcnt(0)" ::: "memory");
        } else {
            XB_SPIN(xb_ld(&bar[XB_XGEN(b.x)]) == gen, bar);
            __builtin_amdgcn_fence(__ATOMIC_ACQUIRE, "agent");
            asm volatile("s_waitcnt vmcnt(0)" ::: "memory");
        }
    }
    __syncthreads();
}

namespace pg8 {
struct MoeOrder {
    const int* tile_e; int ntiles, G, c;
    __device__ __forceinline__ bool next(int i, Unit& u) const { const long L = (long)i * G + c; if (L >= (long)ntiles * 8) return false; u.pm = (int)(L >> 3); u.pn = tile_e[u.pm] * 8 + (int)(L & 7); return true; }
    __device__ __forceinline__ void a_ready(const Unit&) const {}
    __device__ __forceinline__ void done(const Unit&) const {}
};
struct EpiU {
    static constexpr bool PERM = true, AFTER_DRAIN = false;
    bf16_t* O; int ldc;
    __device__ __forceinline__ void operator()(const f32x4 (&acc)[2][2][4][2], const Unit& u, int wr, int wc, int fr, int fq) const {
        const int row0 = u.pm * BM + wr * 64 + fr, col0 = u.pn * BM + wc * 32 + 8 * fq;
#pragma unroll
        for (int ai = 0; ai < 2; ++ai)
#pragma unroll
            for (int m = 0; m < 4; ++m) { bf16_t* rowp = O + (size_t)(row0 + ai * HALF + m * 16) * ldc + col0;
#pragma unroll
                for (int bj = 0; bj < 2; ++bj) { const f32x4 v0 = acc[ai][bj][m][0], v1 = acc[ai][bj][m][1];
                    u32x4 w; w.x = cvt_pk_bf16(v0[0], v0[1]); w.y = cvt_pk_bf16(v0[2], v0[3]); w.z = cvt_pk_bf16(v1[0], v1[1]); w.w = cvt_pk_bf16(v1[2], v1[3]);
                    *(u32x4*)(rowp + bj * HALF) = w; } }
    }
};
struct EpiRes {
    static constexpr bool PERM = false, AFTER_DRAIN = false;
    float* X; const float* gate;
    __device__ __forceinline__ void operator()(const f32x4 (&acc)[2][2][4][2], const Unit& u, int wr, int wc, int fr, int fq) const {
        const int row0 = u.pm * BM + wr * 64 + fr, col0 = u.pn * BM + wc * 32 + 4 * fq;
#pragma unroll
        for (int ai = 0; ai < 2; ++ai)
#pragma unroll
            for (int m = 0; m < 4; ++m) { const int row = row0 + ai * HALF + m * 16; float* rowp = X + (size_t)row * D + col0; const float* gp = gate + (size_t)mod_row(row) * 12288 + col0;
#pragma unroll
                for (int bj = 0; bj < 2; ++bj)
#pragma unroll
                    for (int n = 0; n < 2; ++n) { const f32x4 gv = *(const f32x4*)(gp + bj * HALF + n * 16); f32x4* xp = (f32x4*)(rowp + bj * HALF + n * 16); *xp = *xp + gv * acc[ai][bj][m][n]; } }
    }
};
struct EpiAct {
    static constexpr bool PERM = true, AFTER_DRAIN = false;
    bf16_t* O; const float* bgu;
    __device__ __forceinline__ void operator()(const f32x4 (&acc)[2][2][4][2], const Unit& u, int wr, int wc, int fr, int fq) const {
        const int e = u.pn >> 3, pnl = u.pn & 7; const int row0 = u.pm * BM + wr * 64 + fr, j0 = wc * 32 + 8 * fq;
        const float* bg = bgu + (size_t)e * 2048 + pnl * 128 + j0;
        f32x4 bglu[2], blin[2];
#pragma unroll
        for (int n = 0; n < 2; ++n) { bglu[n] = *(const f32x4*)(bg + 4 * n); blin[n] = *(const f32x4*)(bg + 1024 + 4 * n); }
#pragma unroll
        for (int ai = 0; ai < 2; ++ai)
#pragma unroll
            for (int m = 0; m < 4; ++m) { bf16_t* rowp = O + (size_t)(row0 + ai * HALF + m * 16) * FE + pnl * 128 + j0;
                float r[8];
#pragma unroll
                for (int n = 0; n < 2; ++n)
#pragma unroll
                    for (int q = 0; q < 4; ++q) { float glu = acc[ai][0][m][n][q] + bglu[n][q], lin = acc[ai][1][m][n][q] + blin[n][q];
                        glu = fminf(glu, 7.0f); lin = fminf(fmaxf(lin, -7.0f), 7.0f);
                        r[n * 4 + q] = glu * (1.0f / (1.0f + __expf(-1.702f * glu))) * (lin + 1.0f); }
                u32x4 w; w.x = cvt_pk_bf16(r[0], r[1]); w.y = cvt_pk_bf16(r[2], r[3]); w.z = cvt_pk_bf16(r[4], r[5]); w.w = cvt_pk_bf16(r[6], r[7]);
                *(u32x4*)rowp = w; }
    }
};
struct EpiDown {
    static constexpr bool PERM = true, AFTER_DRAIN = false;
    bf16_t* O; const float* bdn; const float* prob;
    __device__ __forceinline__ void operator()(const f32x4 (&acc)[2][2][4][2], const Unit& u, int wr, int wc, int fr, int fq) const {
        const int e = u.pn >> 3, pnl = u.pn & 7; const int row0 = u.pm * BM + wr * 64 + fr, col0 = pnl * BM + wc * 32 + 8 * fq;
        f32x4 bv[2][2];
#pragma unroll
        for (int bj = 0; bj < 2; ++bj)
#pragma unroll
            for (int n = 0; n < 2; ++n) bv[bj][n] = *(const f32x4*)(bdn + (size_t)e * D + col0 + bj * HALF + 4 * n);
#pragma unroll
        for (int ai = 0; ai < 2; ++ai)
#pragma unroll
            for (int m = 0; m < 4; ++m) { const int row = row0 + ai * HALF + m * 16; bf16_t* rowp = O + (size_t)row * D + col0; const float pr = prob[row];
#pragma unroll
                for (int bj = 0; bj < 2; ++bj) { const f32x4 v0 = (acc[ai][bj][m][0] + bv[bj][0]) * pr, v1 = (acc[ai][bj][m][1] + bv[bj][1]) * pr;
                    u32x4 w; w.x = cvt_pk_bf16(v0[0], v0[1]); w.y = cvt_pk_bf16(v0[2], v0[3]); w.z = cvt_pk_bf16(v1[0], v1[1]); w.w = cvt_pk_bf16(v1[2], v1[3]);
                    *(u32x4*)(rowp + bj * HALF) = w; } }
    }
};

struct OrderAll {
    StaticOrder so; const int* tile_e; int ntiles, G, c, moe;
    __device__ __forceinline__ bool next(int i, Unit& u) const {
        if (!moe) return so.next(i, u);
        const long L = (long)i * G + c; if (L >= (long)ntiles * 8) return false; u.pm = (int)(L >> 3); u.pn = tile_e[u.pm] * 8 + (int)(L & 7); return true; }
    __device__ __forceinline__ void a_ready(const Unit&) const {}
    __device__ __forceinline__ void done(const Unit&) const {}
};
struct EpiAll {
    static constexpr bool AFTER_DRAIN = false;
    int mode; bool perm; void* O; const float* a1; const float* a2; int ldc;
    __device__ __forceinline__ void operator()(const f32x4 (&acc)[2][2][4][2], const Unit& u, int wr, int wc, int fr, int fq) const {
        asm volatile("" : "+v"(fr), "+v"(fq));
        if (mode == 0) { EpiU e{(bf16_t*)O, ldc}; e(acc, u, wr, wc, fr, fq); }
        else if (mode == 1) { EpiRes e{(float*)O, a1}; e(acc, u, wr, wc, fr, fq); }
        else if (mode == 2) { EpiAct e{(bf16_t*)O, a1}; e(acc, u, wr, wc, fr, fq); }
        else { EpiDown e{(bf16_t*)O, a1, a2}; e(acc, u, wr, wc, fr, fq); }
    }
};
}


__device__ __forceinline__ float fsigm(float x) { return __builtin_amdgcn_rcpf(1.0f + __expf(-x)); }
constexpr int NTHREADS = 512;
typedef short bf16x8_t __attribute__((ext_vector_type(8)));
typedef float f32x16_t __attribute__((ext_vector_type(16)));
typedef float f32x4_t __attribute__((ext_vector_type(4)));
typedef unsigned u32x4_t __attribute__((ext_vector_type(4)));
typedef unsigned u32x2_t __attribute__((ext_vector_type(2)));
constexpr int HY_PAD = 512, HY_ZS = SEQ + 2 * HY_PAD;
constexpr int HYL_TR = 0, HYL_Z0 = 65536, HYL_Z1 = HYL_Z0 + NB * HY_ZS * 2, HYL_END = HYL_Z1 + NB * HY_ZS * 2;
static_assert(SEQ == 4096 && NB == 4, "hyena unit geometry");
__device__ __forceinline__ void hy_unit(PREF p, int l, int c, LAS unsigned char* L) {
    int tid = hw_tid(); asm volatile("" : "+v"(tid)); const int lane = tid & 63, w = __builtin_amdgcn_readfirstlane(tid >> 6);
    LAS unsigned short* TR = (LAS unsigned short*)(L + HYL_TR);
    LAS unsigned short* Z0 = (LAS unsigned short*)(L + HYL_Z0);
    LAS unsigned short* Z1 = (LAS unsigned short*)(L + HYL_Z1);
    const unsigned short* ZT = WSH(O_ZT);
    __syncthreads();
    {   const u32x4_t* tg0 = (const u32x4_t*)(WSH(O_TRB) + ((size_t)(l * 2 + 0) * 512 + c) * 8192); const u32x4_t* tg1 = (const u32x4_t*)(WSH(O_TRB) + ((size_t)(l * 2 + 1) * 512 + c) * 8192);
        for (int i = tid; i < 1024; i += NTHREADS) { ((LAS u32x4_t*)TR)[i] = tg0[i]; ((LAS u32x4_t*)TR)[2048 + i] = tg1[i]; }
        for (int i = tid; i < 2 * 4096; i += NTHREADS) { const int o2 = i >> 12, q = i & 4095;
            const unsigned short* src = WSH(O_TRB) + ((size_t)(l * 2 + o2) * 512 + c) * 8192; const unsigned lo = src[2 * q + 1], hi = q < 4095 ? src[2 * q + 2] : 0u;
            ((LAS unsigned*)TR)[o2 * 8192 + 4096 + q] = lo | (hi << 16); }
        const u32x4_t zero = {0u, 0u, 0u, 0u};
        for (int i = tid; i < 2 * NB * 2 * 64; i += NTHREADS) { const int q = i & 63, side = (i >> 6) & 1, b = (i >> 7) % NB, buf = i / (128 * NB);
            ((LAS u32x4_t*)((buf ? Z1 : Z0) + b * HY_ZS + (side ? HY_PAD + SEQ : 0)))[q] = zero; }
        for (int i = tid; i < NB * (SEQ / 8); i += NTHREADS) { const int b = i / (SEQ / 8), q = i % (SEQ / 8);
            ((LAS u32x4_t*)(Z0 + b * HY_ZS + HY_PAD))[q] = ((const u32x4_t*)(ZT + ((size_t)(0 * NB + b) * 512 + c) * SEQ))[q]; }
    }
    __syncthreads();
    const int i16 = lane & 15, g = lane >> 4, bb = i16 >> 2, isub = i16 & 3;
#pragma unroll 1
    for (int o = 0; o < 2; ++o) {
        LAS unsigned short* Zin = o == 0 ? Z0 : Z1;
        LAS unsigned short* TRo = TR + o * 16384;
        f32x4_t acc[4][2];
#pragma unroll
        for (int ct = 0; ct < 4; ++ct) { acc[ct][0] = (f32x4_t){0.f, 0.f, 0.f, 0.f}; acc[ct][1] = (f32x4_t){0.f, 0.f, 0.f, 0.f}; }
        const int d_lo = 16 * w - 127, d_hi = 16 * w + 15;
        const int y0 = 4095 - 32 * d_lo - i16 + 8 * g, par = y0 & 1;
        LAS unsigned short* ya = TRo + par * 8192 + (y0 - par);
        LAS unsigned short* zb = Zin + bb * HY_ZS + HY_PAD + (16 * w + isub - d_lo) * 32 + 8 * g;
        bf16x8_t r1[4], r2[4], r3[4];
#pragma unroll
        for (int j = 0; j < 4; ++j) { r1[j] = *(LAS bf16x8_t*)(zb + 1 * 128 - 32 * j); r2[j] = *(LAS bf16x8_t*)(zb + 2 * 128 - 32 * j); r3[j] = *(LAS bf16x8_t*)(zb + 3 * 128 - 32 * j); }
#pragma unroll 1
        for (int d = d_lo; d + 3 <= d_hi; d += 4) {
#pragma unroll
            for (int j = 0; j < 4; ++j, ya -= 32, zb -= 32) {
                u32x4_t a0u, a1u;
#pragma unroll
                for (int k = 0; k < 4; ++k) { a0u[k] = ((volatile LAS unsigned*)ya)[k]; a1u[k] = ((volatile LAS unsigned*)ya)[k - 8]; }
                const bf16x8_t a0 = __builtin_bit_cast(bf16x8_t, a0u), a1 = __builtin_bit_cast(bf16x8_t, a1u);
                const bf16x8_t nb = *(LAS bf16x8_t*)(zb);
                acc[0][0] = __builtin_amdgcn_mfma_f32_16x16x32_bf16(a0, nb, acc[0][0], 0, 0, 0); acc[0][1] = __builtin_amdgcn_mfma_f32_16x16x32_bf16(a1, nb, acc[0][1], 0, 0, 0);
                acc[1][0] = __builtin_amdgcn_mfma_f32_16x16x32_bf16(a0, r1[j], acc[1][0], 0, 0, 0); acc[1][1] = __builtin_amdgcn_mfma_f32_16x16x32_bf16(a1, r1[j], acc[1][1], 0, 0, 0);
                acc[2][0] = __builtin_amdgcn_mfma_f32_16x16x32_bf16(a0, r2[j], acc[2][0], 0, 0, 0); acc[2][1] = __builtin_amdgcn_mfma_f32_16x16x32_bf16(a1, r2[j], acc[2][1], 0, 0, 0);
                acc[3][0] = __builtin_amdgcn_mfma_f32_16x16x32_bf16(a0, r3[j], acc[3][0], 0, 0, 0); acc[3][1] = __builtin_amdgcn_mfma_f32_16x16x32_bf16(a1, r3[j], acc[3][1], 0, 0, 0);
                r3[j] = r2[j]; r2[j] = r1[j]; r1[j] = nb; }
        }
#pragma unroll 1
        for (int d = d_lo + 4 * ((d_hi - d_lo + 1) / 4); d <= d_hi; ++d, ya -= 32, zb -= 32) {
            u32x4_t a0u, a1u;
#pragma unroll
            for (int k = 0; k < 4; ++k) { a0u[k] = ((volatile LAS unsigned*)ya)[k]; a1u[k] = ((volatile LAS unsigned*)ya)[k - 8]; }
            const bf16x8_t a0 = __builtin_bit_cast(bf16x8_t, a0u), a1 = __builtin_bit_cast(bf16x8_t, a1u);
#pragma unroll
            for (int ct = 0; ct < 4; ++ct) { const bf16x8_t bf = *(LAS bf16x8_t*)(zb + ct * 128);
                acc[ct][0] = __builtin_amdgcn_mfma_f32_16x16x32_bf16(a0, bf, acc[ct][0], 0, 0, 0);
                acc[ct][1] = __builtin_amdgcn_mfma_f32_16x16x32_bf16(a1, bf, acc[ct][1], 0, 0, 0); }
        }
        const float bias = p.in[I_hy_bias][l * 1024 + o * 512 + c];
        const unsigned short* gate = ZT + ((size_t)((o + 1) * NB + bb) * 512 + c) * SEQ;
#pragma unroll 1
        for (int ct = 0; ct < 4; ++ct) {
#pragma unroll
            for (int hh = 0; hh < 2; ++hh) {
                const int t4 = (16 * w + 4 * ct + isub) * 32 + 16 * hh + 4 * g;
                const u32x2_t zi = *(LAS u32x2_t*)(Zin + bb * HY_ZS + HY_PAD + t4); const u32x2_t gt = *(const u32x2_t*)(gate + t4);
                float r[4];
#pragma unroll
                for (int q = 0; q < 4; ++q) { const unsigned zw = q < 2 ? zi.x : zi.y, gw = q < 2 ? gt.x : gt.y;
                    const float zv = bf2f((unsigned short)((q & 1) ? (zw >> 16) : (zw & 0xffffu))), gv = bf2f((unsigned short)((q & 1) ? (gw >> 16) : (gw & 0xffffu)));
                    r[q] = gv * (acc[0][hh][q] + bias * zv); }
                if (o == 0) { u32x2_t ov; ov.x = (unsigned)f2bf(r[0]) | ((unsigned)f2bf(r[1]) << 16); ov.y = (unsigned)f2bf(r[2]) | ((unsigned)f2bf(r[3]) << 16); *(LAS u32x2_t*)(Z1 + bb * HY_ZS + HY_PAD + t4) = ov; }
                else { unsigned short* cp = WSH(O_CAT) + (size_t)(bb * SEQ + t4) * D + c;
#pragma unroll
                    for (int q = 0; q < 4; ++q) cp[(size_t)q * D] = f2bf(r[q]); }
            }
            acc[0][0] = acc[1][0]; acc[0][1] = acc[1][1]; acc[1][0] = acc[2][0]; acc[1][1] = acc[2][1]; acc[2][0] = acc[3][0]; acc[2][1] = acc[3][1];
        }
        __syncthreads();
    }
}
__device__ __forceinline__ void hy_units(PREF p, int l, LAS unsigned char* L, int b0, int nb) { int bl = blockIdx.x; asm volatile("" : "+s"(bl)); bl -= b0; if (bl < 0 || bl >= nb) return; for (int c = bl; c < 512; c += nb) hy_unit(p, l, c, L); }


__device__ __forceinline__ unsigned pk_bf16(float a, float b) { return (unsigned)f2bf(a) | ((unsigned)f2bf(b) << 16); }

__device__ __forceinline__ void cvt_item(const float* W, int K, int N, unsigned short* WT, int item, int permute_gu, LAS float* scr, int lane) {
    const int nblk = N / 32, kb = item / nblk, nb = item % nblk, k0 = 64 * kb, n0 = 32 * nb;
#pragma unroll 8
    for (int i = 0; i < 32; ++i) { const int kk = 2 * i + (lane >> 5); scr[kk * 33 + (lane & 31)] = W[(size_t)(k0 + kk) * N + n0 + (lane & 31)]; }
    asm volatile("s_waitcnt lgkmcnt(0)" ::: "memory");
    int nd0 = n0; if (permute_gu) { const int bj = n0 / 1024, r = n0 % 1024; nd0 = (r / 128) * 256 + bj * 128 + r % 128; }
    const int c = lane & 7;
#pragma unroll
    for (int j = 0; j < 4; ++j) { const int n = (lane >> 3) + 8 * j; const LAS float* sp = scr + (8 * c) * 33 + n;
        u32x4_t o; o.x = pk_bf16(sp[0 * 33], sp[1 * 33]); o.y = pk_bf16(sp[2 * 33], sp[3 * 33]); o.z = pk_bf16(sp[4 * 33], sp[5 * 33]); o.w = pk_bf16(sp[6 * 33], sp[7 * 33]);
        *(u32x4_t*)(WT + (size_t)(nd0 + n) * K + k0 + 8 * c) = o; }
    asm volatile("s_waitcnt lgkmcnt(0)" ::: "memory");
}
constexpr int CVT_IN = (D / 64) * (DIN / 32), CVT_OUT = (D / 64) * (D / 32), CVT_GU = (D / 64) * (2048 / 32), CVT_DN = (FE / 64) * (D / 32);
constexpr int CVT_PRO = 2 * CVT_IN + 2 * CVT_OUT, CVT_NIT = CVT_PRO + 2 * NE * CVT_GU + 2 * NE * CVT_DN;
__device__ __forceinline__ void cvt_all(PREF p, LAS unsigned char* L, int it_lo, int it_hi, int b0, int nb) {
    int tid = hw_tid(), bl = blockIdx.x; asm volatile("" : "+v"(tid), "+s"(bl)); bl -= b0; if (bl < 0 || bl >= nb) return; const int lane = tid & 63, w = __builtin_amdgcn_readfirstlane(tid >> 6);
    LAS float* scr = (LAS float*)(L + w * 8704);
    constexpr int I_IN = (D / 64) * (DIN / 32), I_OUT = (D / 64) * (D / 32), I_GU = (D / 64) * (2048 / 32), I_DN = (FE / 64) * (D / 32);
    constexpr int NIT = 2 * I_IN + 2 * I_OUT + 2 * NE * I_GU + 2 * NE * I_DN;
    static_assert(NIT == CVT_NIT, "cvt item count");
    for (int it = it_lo + bl * 8 + w; it < it_hi; it += nb * 8) {
        int r = it;
        if (r < 2 * I_IN) { const int l = r / I_IN; cvt_item(p.in[I_w_in] + (size_t)l * D * DIN, D, DIN, WSH(O_WIN) + (size_t)l * DIN * D, r % I_IN, 0, scr, lane); continue; } r -= 2 * I_IN;
        if (r < 2 * I_OUT) { const int l = r / I_OUT; cvt_item(p.in[I_w_out] + (size_t)l * D * D, D, D, WSH(O_WOUT) + (size_t)l * D * D, r % I_OUT, 0, scr, lane); continue; } r -= 2 * I_OUT;
        if (r < 2 * NE * I_GU) { const int le = r / I_GU; cvt_item(p.in[I_moe_w_gu] + (size_t)le * D * 2048, D, 2048, WSH(O_WGU) + (size_t)le * 2048 * D, r % I_GU, 1, scr, lane); continue; } r -= 2 * NE * I_GU;
        { const int le = r / I_DN; cvt_item(p.in[I_moe_w_dn] + (size_t)le * FE * D, FE, D, WSH(O_WDN) + (size_t)le * D * FE, r % I_DN, 0, scr, lane); }
    }
}


constexpr int RGL_WT = 0, RGL_XC = 128 * 72 * 2, RGL_XCF = RGL_XC + 64 * 72 * 2, RGL_AA = RGL_XCF + 64 * 64 * 4, RGL_BB = RGL_AA + 64 * 64 * 4, RGL_END = RGL_BB + 64 * 64 * 4;
__device__ __forceinline__ void rg_load_x(PREF p, int d, int b, int h, int tile, int pos, int c8, bf16x8_t (&xin)[4]) {
    const int m = scan_tok(d, b, tile * 64 + pos);
#pragma unroll
    for (int j = 0; j < 4; ++j) { const int pm = tok_prev(m, d, 3 - j); xin[j] = (bf16x8_t){0, 0, 0, 0, 0, 0, 0, 0};
        if (pm >= 0) xin[j] = *(const bf16x8_t*)(WSH(O_U) + (size_t)pm * DIN + U_RG + h * 64 + c8 * 8); }
}
__device__ __forceinline__ void rg_unit(PREF p, int l, int u, LAS unsigned char* L) {
    int tid = hw_tid(); asm volatile("" : "+v"(tid)); const int lane = tid & 63, w = __builtin_amdgcn_readfirstlane(tid >> 6), n = lane & 15, kg = lane >> 4;
    const int h = u % 8, b = (u / 8) % NB, d = u / (8 * NB), ld = l * 2 + d;
    LAS unsigned short* WT = (LAS unsigned short*)(L + RGL_WT); LAS unsigned short* XC = (LAS unsigned short*)(L + RGL_XC);
    LAS float* XCF = (LAS float*)(L + RGL_XCF); LAS float* AA = (LAS float*)(L + RGL_AA); LAS float* BB = (LAS float*)(L + RGL_BB);
    __syncthreads();
    {   const float* wa = p.in[I_rg_wa] + ((size_t)ld * 8 + h) * 4096; const float* wx = p.in[I_rg_wx] + ((size_t)ld * 8 + h) * 4096;
        for (int e = tid; e < 8192; e += NTHREADS) { const int j = e & 63, i = (e >> 6) & 63, g = e >> 12; WT[(g * 64 + j) * 72 + i] = f2bf((g ? wx : wa)[i * 64 + j]); } }
    const int pos = tid >> 3, c8 = tid & 7;
    float cw[4][8], cb[8];
#pragma unroll
    for (int j = 0; j < 4; ++j)
#pragma unroll
        for (int i = 0; i < 8; ++i) cw[j][i] = p.in[I_rg_conv_w][((size_t)ld * 4 + j) * G + h * 64 + c8 * 8 + i];
#pragma unroll
    for (int i = 0; i < 8; ++i) cb[i] = p.in[I_rg_conv_b][ld * G + h * 64 + c8 * 8 + i];
    const int mt = w & 3, jp = w >> 2;
    float ba[2], bx[2], sl[2];
#pragma unroll
    for (int t = 0; t < 2; ++t) { const int c = h * 64 + 16 * (2 * jp + t) + n; ba[t] = p.in[I_rg_ba][ld * G + c]; bx[t] = p.in[I_rg_bx][ld * G + c]; sl[t] = -8.0f * fast_softplus(-p.in[I_rg_lambda][ld * G + c]); }
    float hst = 0.f;
    bf16x8_t xin[4]; rg_load_x(p, d, b, h, 0, pos, c8, xin);
#pragma unroll 1
    for (int tile = 0; tile < SCANL / 64; ++tile) {
        __syncthreads();
        {   float acc[8];
#pragma unroll
            for (int i = 0; i < 8; ++i) acc[i] = cb[i];
#pragma unroll
            for (int j = 0; j < 4; ++j) {
#pragma unroll
                for (int i = 0; i < 8; ++i) acc[i] += cw[j][i] * bf2f((unsigned short)xin[j][i]); }
            if (tile + 1 < SCANL / 64) rg_load_x(p, d, b, h, tile + 1, pos, c8, xin);
            u32x4_t o = {pk_bf16(acc[0], acc[1]), pk_bf16(acc[2], acc[3]), pk_bf16(acc[4], acc[5]), pk_bf16(acc[6], acc[7])};
            *(LAS u32x4_t*)(XC + pos * 72 + c8 * 8) = o;
            *(LAS f32x4_t*)(XCF + pos * 64 + c8 * 8) = (f32x4_t){acc[0], acc[1], acc[2], acc[3]}; *(LAS f32x4_t*)(XCF + pos * 64 + c8 * 8 + 4) = (f32x4_t){acc[4], acc[5], acc[6], acc[7]};
        }
        __syncthreads();
        f32x4_t ga[2], gx[2];
#pragma unroll
        for (int t = 0; t < 2; ++t) { ga[t] = (f32x4_t){0.f, 0.f, 0.f, 0.f}; gx[t] = ga[t]; }
#pragma unroll
        for (int ks = 0; ks < 2; ++ks) { const bf16x8_t xa = *(LAS bf16x8_t*)(XC + (16 * mt + n) * 72 + ks * 32 + 8 * kg);
#pragma unroll
            for (int t = 0; t < 2; ++t) { const int jt = 2 * jp + t;
                ga[t] = __builtin_amdgcn_mfma_f32_16x16x32_bf16(xa, *(LAS bf16x8_t*)(WT + (16 * jt + n) * 72 + ks * 32 + 8 * kg), ga[t], 0, 0, 0);
                gx[t] = __builtin_amdgcn_mfma_f32_16x16x32_bf16(xa, *(LAS bf16x8_t*)(WT + (64 + 16 * jt + n) * 72 + ks * 32 + 8 * kg), gx[t], 0, 0, 0); } }
#pragma unroll
        for (int t = 0; t < 2; ++t)
#pragma unroll
            for (int q = 0; q < 4; ++q) { const int ps = 16 * mt + 4 * kg + q, j = 16 * (2 * jp + t) + n;
                const float r = fsigm(ga[t][q] + ba[t]), ig = fsigm(gx[t][q] + bx[t]); const float av = __expf(sl[t] * r);
                AA[ps * 64 + j] = av; BB[ps * 64 + j] = __builtin_sqrtf(fmaxf(1.0f - av * av, 0.0f)) * (ig * XCF[ps * 64 + j]); }
        __syncthreads();
        if (w == 0) {
#pragma unroll 8
            for (int ps = 0; ps < 64; ++ps) { hst = AA[ps * 64 + lane] * hst + BB[ps * 64 + lane];
                WSF(O_RGH)[((size_t)d * T + scan_tok(d, b, tile * 64 + ps)) * G + h * 64 + lane] = hst; }
        }
    }
}
__device__ __forceinline__ void rg_units(PREF p, int l, LAS unsigned char* L) { int bl = blockIdx.x; asm volatile("" : "+s"(bl)); for (int u = bl; u < 2 * NB * 8; u += gridDim.x) rg_unit(p, l, u, L); }

constexpr int RT_LD = 136;
constexpr int RTL_Q = 0, RTL_K = 128 * RT_LD * 2, RTL_VT = 2 * RTL_K, RTL_KT = 3 * RTL_K, RTL_END = 4 * RTL_K;
static_assert(RTL_END <= 147456, "retention LDS map");
__device__ __forceinline__ void rt_unit_a(PREF p, int l, int u, LAS unsigned char* L) {
    int tid = hw_tid(); asm volatile("" : "+v"(tid)); const int lane = tid & 63, w = __builtin_amdgcn_readfirstlane(tid >> 6);
    const int ch = u >> 2, h = u & 3, m0 = ch * 128, n = lane & 15, kg = lane >> 4;
    LAS unsigned short* Ql = (LAS unsigned short*)(L + RTL_Q); LAS unsigned short* Kl = (LAS unsigned short*)(L + RTL_K);
    LAS unsigned short* VTl = (LAS unsigned short*)(L + RTL_VT); LAS unsigned short* KTl = (LAS unsigned short*)(L + RTL_KT);
    const float lg0 = rt_lg(p, l, 0, h) * 1.4426950408889634f, lg1 = rt_lg(p, l, 1, h) * 1.4426950408889634f;
    __syncthreads();
    {   const int row = tid >> 2, sl = tid & 3, m = m0 + row; const unsigned short* ub = WSH(O_U) + (size_t)m * DIN + U_RT + h * 128;
        const bool lat = m < TL; const int t = m % SEQ; const float pos = (sl < 2) ? (float)(t / 64) : (float)(t % 64);
        const int partner = sl ^ 1;
#pragma unroll
        for (int c8 = 0; c8 < 4; ++c8) {
            float qo[8], ko[8];
#pragma unroll
            for (int j = 0; j < 8; ++j) { const int i = c8 * 8 + j;
                float q = bf2f(ub[sl * 32 + i]), k = bf2f(ub[G + sl * 32 + i]);
                if (lat) { const float qp = bf2f(ub[partner * 32 + i]), kp = bf2f(ub[G + partner * 32 + i]);
                    float sn, cs; sincosf(pos * exp2f(-(float)i * (13.287712379549449f / 32.0f)), &sn, &cs);
                    if ((sl & 1) == 0) { q = q * cs - qp * sn; k = k * cs - kp * sn; } else { q = qp * sn + q * cs; k = kp * sn + k * cs; } }
                qo[j] = q; ko[j] = k * 0.08838834764831845f; }
            const u32x4_t qv = {pk_bf16(qo[0], qo[1]), pk_bf16(qo[2], qo[3]), pk_bf16(qo[4], qo[5]), pk_bf16(qo[6], qo[7])}, kv = {pk_bf16(ko[0], ko[1]), pk_bf16(ko[2], ko[3]), pk_bf16(ko[4], ko[5]), pk_bf16(ko[6], ko[7])};
            *(LAS u32x4_t*)(Ql + row * RT_LD + sl * 32 + c8 * 8) = qv; *(LAS u32x4_t*)(Kl + row * RT_LD + sl * 32 + c8 * 8) = kv;
            *(u32x4_t*)(WSH(O_RQB) + (size_t)m * G + h * 128 + sl * 32 + c8 * 8) = qv;
        }
#pragma unroll 8
        for (int i = 0; i < 32; ++i) VTl[(sl * 32 + i) * RT_LD + row] = ub[2 * G + sl * 32 + i];
    }
    __syncthreads();
    f32x4_t st[8];
#pragma unroll
    for (int t = 0; t < 8; ++t) st[t] = (f32x4_t){0.f, 0.f, 0.f, 0.f};
#pragma unroll
    for (int ks = 0; ks < 4; ++ks) { const bf16x8_t bq = *(LAS bf16x8_t*)(Ql + (16 * w + n) * RT_LD + ks * 32 + 8 * kg);
#pragma unroll
        for (int t = 0; t < 8; ++t) st[t] = __builtin_amdgcn_mfma_f32_16x16x32_bf16(*(LAS bf16x8_t*)(Kl + (16 * t + n) * RT_LD + ks * 32 + 8 * kg), bq, st[t], 0, 0, 0); }
    bf16x8_t pa[4];
    {   const int i = 16 * w + n;
#pragma unroll
        for (int s2 = 0; s2 < 4; ++s2) { unsigned pk[4];
#pragma unroll
            for (int hh = 0; hh < 2; ++hh) { const int t = 2 * s2 + hh; float v[4];
#pragma unroll
                for (int q = 0; q < 4; ++q) { const int j = 16 * t + 4 * kg + q; const float wgt = j <= i ? exp2f(lg0 * (float)(i - j)) : exp2f(lg1 * (float)(j - i)); v[q] = st[t][q] * wgt; }
                pk[hh * 2] = pk_bf16(v[0], v[1]); pk[hh * 2 + 1] = pk_bf16(v[2], v[3]); }
            u32x4_t x = {pk[0], pk[1], pk[2], pk[3]}; pa[s2] = __builtin_bit_cast(bf16x8_t, x); }
    }
#pragma unroll
    for (int et = 0; et < 8; ++et) { f32x4_t o = {0.f, 0.f, 0.f, 0.f};
#pragma unroll
        for (int s2 = 0; s2 < 4; ++s2) { const LAS unsigned short* vp = VTl + (16 * et + n) * RT_LD + 32 * s2 + 4 * kg;
            const u32x2_t lo = *(LAS u32x2_t*)vp, hi = *(LAS u32x2_t*)(vp + 16); u32x4_t x = {lo.x, lo.y, hi.x, hi.y};
            o = __builtin_amdgcn_mfma_f32_16x16x32_bf16(pa[s2], __builtin_bit_cast(bf16x8_t, x), o, 0, 0, 0); }
#pragma unroll
        for (int q = 0; q < 4; ++q) WSF(O_RO)[(size_t)(m0 + 16 * w + 4 * kg + q) * G + h * 128 + 16 * et + n] = o[q]; }
#pragma unroll 1
    for (int d = 0; d < 2; ++d) {
        __syncthreads();
        {   const int row = tid >> 2, sl = tid & 3; const float dec = exp2f((d == 0 ? lg0 : lg1) * (float)(d == 0 ? 127 - row : row));
#pragma unroll 8
            for (int i = 0; i < 32; ++i) KTl[(sl * 32 + i) * RT_LD + row] = f2bf(bf2f(Kl[row * RT_LD + sl * 32 + i]) * dec); }
        __syncthreads();
        float* kvo = WSF(O_KV) + (((size_t)d * NCHUNK + ch) * 4 + h) * 16384;
#pragma unroll 1
        for (int dt = 0; dt < 8; ++dt) { f32x4_t o = {0.f, 0.f, 0.f, 0.f};
#pragma unroll
            for (int ks = 0; ks < 4; ++ks)
                o = __builtin_amdgcn_mfma_f32_16x16x32_bf16(*(LAS bf16x8_t*)(VTl + (16 * w + n) * RT_LD + ks * 32 + 8 * kg), *(LAS bf16x8_t*)(KTl + (16 * dt + n) * RT_LD + ks * 32 + 8 * kg), o, 0, 0, 0);
#pragma unroll
            for (int q = 0; q < 4; ++q) kvo[(size_t)(16 * w + 4 * kg + q) * 128 + 16 * dt + n] = o[q]; }
    }
}
__device__ __forceinline__ void rt_units_a(PREF p, int l, LAS unsigned char* L, int b0, int nb) { int bl = blockIdx.x; asm volatile("" : "+s"(bl)); bl -= b0; if (bl < 0 || bl >= nb) return; for (int u = bl; u < NCHUNK * 4; u += nb) rt_unit_a(p, l, u, L); }
__device__ __forceinline__ void rt_unit_c(PREF p, int l, int u, LAS unsigned char* L) {
    int tid = hw_tid(); asm volatile("" : "+v"(tid)); const int lane = tid & 63, w = __builtin_amdgcn_readfirstlane(tid >> 6);
    const int ch = u >> 2, h = u & 3, m0 = ch * 128, n = lane & 15, kg = lane >> 4;
    if (l == DEPTH - 1 && m0 >= TL) return;
    const float lg0 = rt_lg(p, l, 0, h) * 1.4426950408889634f, lg1 = rt_lg(p, l, 1, h) * 1.4426950408889634f;
    bf16x8_t qa[4];
#pragma unroll
    for (int ks = 0; ks < 4; ++ks) qa[ks] = *(const bf16x8_t*)(WSH(O_RQB) + (size_t)(m0 + 16 * w + n) * G + h * 128 + ks * 32 + 8 * kg);
    f32x4_t o[8];
#pragma unroll
    for (int et = 0; et < 8; ++et) {
        f32x4_t c0 = {0.f, 0.f, 0.f, 0.f}, c1 = c0;
        const float* s0 = WSF(O_SPREV) + (((size_t)0 * NCHUNK + ch) * 4 + h) * 16384 + (size_t)(16 * et + n) * 128; const float* s1 = s0 + (size_t)NCHUNK * 4 * 16384;
#pragma unroll
        for (int ks = 0; ks < 4; ++ks) { const f32x4_t a0 = *(const f32x4_t*)(s0 + ks * 32 + 8 * kg), a1 = *(const f32x4_t*)(s0 + ks * 32 + 8 * kg + 4), b0 = *(const f32x4_t*)(s1 + ks * 32 + 8 * kg), b1 = *(const f32x4_t*)(s1 + ks * 32 + 8 * kg + 4);
            u32x4_t x0 = {pk_bf16(a0[0], a0[1]), pk_bf16(a0[2], a0[3]), pk_bf16(a1[0], a1[1]), pk_bf16(a1[2], a1[3])}, x1 = {pk_bf16(b0[0], b0[1]), pk_bf16(b0[2], b0[3]), pk_bf16(b1[0], b1[1]), pk_bf16(b1[2], b1[3])};
            c0 = __builtin_amdgcn_mfma_f32_16x16x32_bf16(qa[ks], __builtin_bit_cast(bf16x8_t, x0), c0, 0, 0, 0);
            c1 = __builtin_amdgcn_mfma_f32_16x16x32_bf16(qa[ks], __builtin_bit_cast(bf16x8_t, x1), c1, 0, 0, 0); }
#pragma unroll
        for (int q = 0; q < 4; ++q) { const int i = 16 * w + 4 * kg + q;
            o[et][q] = WSF(O_RO)[(size_t)(m0 + i) * G + h * 128 + 16 * et + n] + exp2f(lg0 * (float)(i + 1)) * c0[q] + exp2f(lg1 * (float)(128 - i)) * c1[q]; }
    }
#pragma unroll
    for (int q = 0; q < 4; ++q) {
        float sm = 0.f;
#pragma unroll
        for (int et = 0; et < 8; ++et) sm += o[et][q];
#pragma unroll
        for (int off = 1; off < 16; off <<= 1) sm += lane_xor(sm, off, lane);
        const float mean = sm * (1.0f / 128.0f); float vs = 0.f;
#pragma unroll
        for (int et = 0; et < 8; ++et) { const float dd = o[et][q] - mean; vs += dd * dd; }
#pragma unroll
        for (int off = 1; off < 16; off <<= 1) vs += lane_xor(vs, off, lane);
        const float rstd = 1.0f / sqrtf(vs * (1.0f / 128.0f) + 1e-6f); const int m = m0 + 16 * w + 4 * kg + q;
#pragma unroll
        for (int et = 0; et < 8; ++et) { const int c = h * 128 + 16 * et + n;
            WSH(O_CAT)[(size_t)m * D + 3 * G + c] = f2bf((o[et][q] - mean) * rstd * p.in[I_rt_gn_w][l * G + c] * siluf(ldu(p, m, U_RT + 3 * G + c))); }
    }
}
__device__ __forceinline__ void rt_units_c(PREF p, int l, LAS unsigned char* L) { int bl = blockIdx.x; asm volatile("" : "+s"(bl)); for (int u = bl; u < NCHUNK * 4; u += gridDim.x) rt_unit_c(p, l, u, L); }


__device__ __forceinline__ float wave_sum64(float v, int lane) {
#pragma unroll
    for (int off = 1; off < 64; off <<= 1) v += lane_xor(v, off, lane);
    return v;
}
__device__ __forceinline__ void norm1_rows(PREF p, int l) {
    int tid = hw_tid(), bl = blockIdx.x; asm volatile("" : "+v"(tid), "+s"(bl)); const int lane = tid & 63, w = __builtin_amdgcn_readfirstlane(tid >> 6);
    const int nrows = l == DEPTH ? TL : T;
#pragma unroll 1
    for (int m = bl * 8 + w; m < nrows; m += (int)gridDim.x * 8) {
        float* xr = WSF(O_X) + (size_t)m * D; const int r = mod_row(m);
        f32x4_t x[8];
#pragma unroll
        for (int j = 0; j < 8; ++j) x[j] = *(const f32x4_t*)(xr + 256 * j + 4 * lane);
        if (l > 0 && m < moe_ntok(l - 1)) {
            const float* g5 = modp(p, l - 1, r, 5); const int* ts = WSI(O_TOKSLOT) + m * 4;
            const unsigned short* o0 = WSH(O_OSLOT) + (size_t)ts[0] * D, *o1 = WSH(O_OSLOT) + (size_t)ts[1] * D, *o2 = WSH(O_OSLOT) + (size_t)ts[2] * D, *o3 = WSH(O_OSLOT) + (size_t)ts[3] * D;
#pragma unroll
            for (int j = 0; j < 8; ++j) { const int c = 256 * j + 4 * lane;
                const u32x2_t r0 = *(const u32x2_t*)(o0 + c), r1 = *(const u32x2_t*)(o1 + c), r2 = *(const u32x2_t*)(o2 + c), r3 = *(const u32x2_t*)(o3 + c);
                f32x4_t sm;
                sm[0] = (bf2f((unsigned short)(r0.x & 0xffffu)) + bf2f((unsigned short)(r1.x & 0xffffu))) + (bf2f((unsigned short)(r2.x & 0xffffu)) + bf2f((unsigned short)(r3.x & 0xffffu)));
                sm[1] = (bf2f((unsigned short)(r0.x >> 16)) + bf2f((unsigned short)(r1.x >> 16))) + (bf2f((unsigned short)(r2.x >> 16)) + bf2f((unsigned short)(r3.x >> 16)));
                sm[2] = (bf2f((unsigned short)(r0.y & 0xffffu)) + bf2f((unsigned short)(r1.y & 0xffffu))) + (bf2f((unsigned short)(r2.y & 0xffffu)) + bf2f((unsigned short)(r3.y & 0xffffu)));
                sm[3] = (bf2f((unsigned short)(r0.y >> 16)) + bf2f((unsigned short)(r1.y >> 16))) + (bf2f((unsigned short)(r2.y >> 16)) + bf2f((unsigned short)(r3.y >> 16)));
                x[j] = x[j] + *(const f32x4_t*)(g5 + c) * sm; *(f32x4_t*)(xr + c) = x[j]; }
        }
        float ss = 0.f;
#pragma unroll
        for (int j = 0; j < 8; ++j) ss += (x[j][0] * x[j][0] + x[j][1] * x[j][1]) + (x[j][2] * x[j][2] + x[j][3] * x[j][3]);
        ss = wave_sum64(ss, lane); const float rinv = 1.0f / sqrtf(ss * (1.0f / D) + 1e-6f);
        if (l == DEPTH) {
#pragma unroll
            for (int j = 0; j < 8; ++j) { const int c = 256 * j + 4 * lane; *(f32x4_t*)(p.out + (size_t)m * D + c) = x[j] * rinv * *(const f32x4_t*)(p.in[I_final_norm_w] + c); }
        } else {
            const float* nw = p.in[I_norm1_w] + l * D; const float* sh = modp(p, l, r, 0); const float* sc = modp(p, l, r, 1);
#pragma unroll
            for (int j = 0; j < 8; ++j) { const int c = 256 * j + 4 * lane; const f32x4_t v = x[j] * rinv * *(const f32x4_t*)(nw + c) * (*(const f32x4_t*)(sc + c) + 1.0f) + *(const f32x4_t*)(sh + c);
                u32x2_t o; o.x = pk_bf16(v[0], v[1]); o.y = pk_bf16(v[2], v[3]); *(u32x2_t*)(WSH(O_A1) + (size_t)m * D + c) = o; }
        }
    }
}
__device__ __forceinline__ void norm2_tiles(PREF p, int l, LAS unsigned char* L) {
    int tid = hw_tid(), bl = blockIdx.x; asm volatile("" : "+v"(tid), "+s"(bl)); const int lane = tid & 63, w = __builtin_amdgcn_readfirstlane(tid >> 6), n = lane & 15, kg = lane >> 4;
    LAS float* Lg = (LAS float*)(L + w * 2304);
    const int ntile = moe_ntok(l) / 16;
#pragma unroll 1
    for (int wt = bl * 8 + w; wt < ntile; wt += (int)gridDim.x * 8) {
        const int m0 = wt * 16, r = mod_row(m0); const float* xr = WSF(O_X) + (size_t)(m0 + n) * D + 8 * kg;
        const unsigned short* bh = WSH(O_RWAT) + ((size_t)(l * (NB + 1) + r) * 2) * NE * D + (size_t)n * D + 8 * kg; const unsigned short* blo = bh + (size_t)NE * D;
        f32x4_t a0 = {0.f, 0.f, 0.f, 0.f}, a1 = a0; float ss = 0.f;
#pragma unroll 4
        for (int ks = 0; ks < 64; ++ks) {
            const f32x4_t xa = *(const f32x4_t*)(xr + ks * 32), xb = *(const f32x4_t*)(xr + ks * 32 + 4);
            ss += (xa[0] * xa[0] + xa[1] * xa[1]) + (xa[2] * xa[2] + xa[3] * xa[3]) + (xb[0] * xb[0] + xb[1] * xb[1]) + (xb[2] * xb[2] + xb[3] * xb[3]);
            unsigned short h[8]; unsigned hp[4], lp[4];
#pragma unroll
            for (int j = 0; j < 4; ++j) h[j] = f2bf(xa[j]);
#pragma unroll
            for (int j = 0; j < 4; ++j) h[4 + j] = f2bf(xb[j]);
#pragma unroll
            for (int j = 0; j < 2; ++j) { hp[j] = (unsigned)h[2 * j] | ((unsigned)h[2 * j + 1] << 16); lp[j] = pk_bf16(xa[2 * j] - bf2f(h[2 * j]), xa[2 * j + 1] - bf2f(h[2 * j + 1]));
                hp[2 + j] = (unsigned)h[4 + 2 * j] | ((unsigned)h[5 + 2 * j] << 16); lp[2 + j] = pk_bf16(xb[2 * j] - bf2f(h[4 + 2 * j]), xb[2 * j + 1] - bf2f(h[5 + 2 * j])); }
            u32x4_t hx = {hp[0], hp[1], hp[2], hp[3]}, lx = {lp[0], lp[1], lp[2], lp[3]}; const bf16x8_t xh = __builtin_bit_cast(bf16x8_t, hx), xl = __builtin_bit_cast(bf16x8_t, lx);
            const bf16x8_t w0h = *(const bf16x8_t*)(bh + ks * 32), w1h = *(const bf16x8_t*)(bh + (size_t)16 * D + ks * 32), w0l = *(const bf16x8_t*)(blo + ks * 32), w1l = *(const bf16x8_t*)(blo + (size_t)16 * D + ks * 32);
            a0 = __builtin_amdgcn_mfma_f32_16x16x32_bf16(xh, w0h, a0, 0, 0, 0); a1 = __builtin_amdgcn_mfma_f32_16x16x32_bf16(xh, w1h, a1, 0, 0, 0);
            a0 = __builtin_amdgcn_mfma_f32_16x16x32_bf16(xl, w0h, a0, 0, 0, 0); a1 = __builtin_amdgcn_mfma_f32_16x16x32_bf16(xl, w1h, a1, 0, 0, 0);
            a0 = __builtin_amdgcn_mfma_f32_16x16x32_bf16(xh, w0l, a0, 0, 0, 0); a1 = __builtin_amdgcn_mfma_f32_16x16x32_bf16(xh, w1l, a1, 0, 0, 0);
        }
        ss += lane_xor(ss, 16, lane); ss += lane_xor(ss, 32, lane);
        const float rinv = 1.0f / sqrtf(ss * (1.0f / D) + 1e-6f);
        if (kg == 0) WSF(O_ROWSS)[m0 + n] = ss;
#pragma unroll
        for (int q = 0; q < 4; ++q) { Lg[(4 * kg + q) * 36 + n] = a0[q]; Lg[(4 * kg + q) * 36 + 16 + n] = a1[q]; }
        asm volatile("s_waitcnt lgkmcnt(0)" ::: "memory");
        if (lane < 16) {
            const int m = m0 + lane; const float* cb = WSF(O_RCB) + (l * (NB + 1) + r) * NE; float lg[NE];
#pragma unroll
            for (int e = 0; e < NE; ++e) lg[e] = Lg[lane * 36 + e] * rinv + cb[e];
            int idx[4]; float val[4]; unsigned used = 0u;
#pragma unroll
            for (int k = 0; k < 4; ++k) { int bi = 0; float bv = -3.0e38f;
#pragma unroll
                for (int e = 0; e < NE; ++e) { const bool ok = !((used >> e) & 1u) && lg[e] > bv; bi = ok ? e : bi; bv = ok ? lg[e] : bv; }
                idx[k] = bi; val[k] = bv; used |= 1u << bi; }
            float ex[4], sum = 0.f;
#pragma unroll
            for (int k = 0; k < 4; ++k) { ex[k] = expf(val[k] - val[0]); sum += ex[k]; }
#pragma unroll
            for (int k = 0; k < 4; ++k) { WSI(O_TOPE)[m * 4 + k] = idx[k]; WSF(O_TOPP)[m * 4 + k] = ex[k] / sum; WSI(O_TOPPOS)[m * 4 + k] = atomicAdd((int*)(p.ws + O_CTL) + CW_COUNTS + (l * NE + idx[k]) * CW_CSTR, 1); }
        }
        asm volatile("s_waitcnt lgkmcnt(0)" ::: "memory");
    }
}

__device__ __forceinline__ void norm2_rows(PREF p, int l) {
    int tid = hw_tid(), bl = blockIdx.x; asm volatile("" : "+v"(tid), "+s"(bl)); const int lane = tid & 63, w = __builtin_amdgcn_readfirstlane(tid >> 6);
    const int nrows = moe_ntok(l);
#pragma unroll 1
    for (int m = bl * 8 + w; m < nrows; m += (int)gridDim.x * 8) {
        const float* xr = WSF(O_X) + (size_t)m * D; const int r = mod_row(m);
        f32x4_t x[8]; float ss = 0.f;
#pragma unroll
        for (int j = 0; j < 8; ++j) { x[j] = *(const f32x4_t*)(xr + 256 * j + 4 * lane); ss += (x[j][0] * x[j][0] + x[j][1] * x[j][1]) + (x[j][2] * x[j][2] + x[j][3] * x[j][3]); }
        ss = wave_sum64(ss, lane); const float rinv = 1.0f / sqrtf(ss * (1.0f / D) + 1e-6f);
        const float* ma = WSF(O_MODA) + (size_t)(l * (NB + 1) + r) * D; const float* mb = WSF(O_MODB) + (size_t)(l * (NB + 1) + r) * D;
#pragma unroll
        for (int j = 0; j < 8; ++j) { const int c = 256 * j + 4 * lane; const f32x4_t v = x[j] * rinv * *(const f32x4_t*)(ma + c) + *(const f32x4_t*)(mb + c);
            u32x2_t o; o.x = pk_bf16(v[0], v[1]); o.y = pk_bf16(v[2], v[3]); *(u32x2_t*)(WSH(O_A1) + (size_t)m * D + c) = o; }
    }
}
DEV_GPU void st_slot_init(PREF p, int, long g) { WSI(O_SLOTTOK)[g] = 0; WSF(O_SLOTP)[g] = 0.f; }


__device__ __forceinline__ void hy_mlp_rows(PREF p) {
    int tid = hw_tid(), bl = blockIdx.x; asm volatile("" : "+v"(tid), "+s"(bl)); const int lane = tid & 63, w = __builtin_amdgcn_readfirstlane(tid >> 6);
#pragma unroll 1
    for (int pos = bl * 8 + w; pos < 3 * SEQ; pos += (int)gridDim.x * 8) {
        const int n = pos % SEQ, vi = pos / SEQ; const int L = hv_len(vi), l = hv_layer(vi); if (n >= L) continue;
        const float fq = p.in[I_hy_f_freq][l * 64 + lane];
        float z;
        {   const int i = lane < 17 ? lane - 1 : lane - 17; const float fr = 1e-4f + (float)i * ((15.0f - 1e-4f) / 15.0f); const float ang = (6.283185307179586f / (float)L) * (float)n * fr;
            z = lane == 0 ? (float)n / (float)(L - 1) : (lane < 17 ? cosf(ang) : -sinf(ang)); }
        float s1 = p.in[I_hy_f_b1][l * 64 + lane]; const float* w1 = p.in[I_hy_f_w1] + l * 33 * 64 + lane;
#pragma unroll
        for (int i = 0; i < 33; ++i) s1 += lane_bcast(z, i) * w1[i * 64];
        const float a = sinf(fq * s1);
        float s2 = p.in[I_hy_f_b2][l * 64 + lane]; const float* w2 = p.in[I_hy_f_w2] + l * 64 * 64 + lane;
#pragma unroll
        for (int i = 0; i < 64; ++i) s2 += lane_bcast(a, i) * w2[i * 64];
        const float b = sinf(fq * s2);
        float s3 = p.in[I_hy_f_b3][l * 64 + lane]; const float* w3 = p.in[I_hy_f_w3] + l * 64 * 64 + lane;
#pragma unroll
        for (int i = 0; i < 64; ++i) s3 += lane_bcast(b, i) * w3[i * 64];
        { const float h3 = sinf(fq * s3); WSF(O_HYA)[((size_t)vi * SEQ + n) * 64 + lane] = h3; WSH(O_HYAB)[((size_t)vi * SEQ + n) * 64 + lane] = f2bf(h3); }
    }
}


DEV_GPU void st_w4t(PREF p, int, long g) { const int i = (int)(g % 64), col = (int)((g / 64) % 2048), l = (int)(g / (64 * 2048)); WSH(O_W4T)[g] = f2bf(p.in[I_hy_f_w4][((size_t)l * 64 + i) * 2048 + col]); }
constexpr long N_w4t = 2L * 2048 * 64;
__device__ __forceinline__ void hy_raw_units(PREF p) {
    int tid = hw_tid(), bl = blockIdx.x; asm volatile("" : "+v"(tid), "+s"(bl)); const int lane = tid & 63, w = __builtin_amdgcn_readfirstlane(tid >> 6), n = lane & 15, kg = lane >> 4;
    const float dmin = -3.0701134573253944f, dmax = -15.350567286626973f;
    constexpr int NU = (2 * (SEQ / 16) + CTX / 16) * 8;
#pragma unroll 1
    for (int u = bl * 8 + w; u < NU; u += (int)gridDim.x * 8) {
        const int cb = u & 7, nt = u >> 3; const int vi = nt < SEQ / 16 ? 0 : (nt < 2 * (SEQ / 16) ? 1 : 2); const int n0 = (nt - (vi == 0 ? 0 : (vi == 1 ? SEQ / 16 : 2 * (SEQ / 16)))) * 16;
        const int L = hv_len(vi), l = hv_layer(vi);
        const unsigned short* hb = WSH(O_HYAB) + ((size_t)vi * SEQ + n0 + n) * 64 + 8 * kg; const bf16x8_t b0 = *(const bf16x8_t*)hb, b1 = *(const bf16x8_t*)(hb + 32);
        const float tn = (float)(n0 + n) / (float)(L - 1);
#pragma unroll 4
        for (int ct = 0; ct < 16; ++ct) { const int col0 = cb * 256 + ct * 16; const unsigned short* wa = WSH(O_W4T) + ((size_t)l * 2048 + col0 + n) * 64 + 8 * kg;
            f32x4_t acc = {0.f, 0.f, 0.f, 0.f};
            acc = __builtin_amdgcn_mfma_f32_16x16x32_bf16(*(const bf16x8_t*)wa, b0, acc, 0, 0, 0); acc = __builtin_amdgcn_mfma_f32_16x16x32_bf16(*(const bf16x8_t*)(wa + 32), b1, acc, 0, 0, 0);
#pragma unroll
            for (int q = 0; q < 4; ++q) { const int col = col0 + 4 * kg + q; const float delta = fabsf(dmin + (float)(col % 512) * ((dmax - dmin) / 511.0f));
                WSF(O_TAPS)[((size_t)vi * 2048 + col) * SEQ + n0 + n] = acc[q] * __expf(-tn * delta); } }
    }
}

constexpr int RWH_LD = 168;
__device__ __forceinline__ void rw_hidden_store(LAS unsigned short* Hl, int col, int kg, const f32x4_t v) {
#pragma unroll
    for (int q = 0; q < 4; ++q) Hl[(4 * kg + q) * RWH_LD + col] = f2bf(v[q]);
}
__device__ __forceinline__ void rw_prep1(PREF p, int l, LAS unsigned char* L, int b0, int nb) {
    int tid = hw_tid(), bl = blockIdx.x; asm volatile("" : "+v"(tid), "+s"(bl)); bl -= b0; if (bl < 0 || bl >= nb) return; const int lane = tid & 63, w = __builtin_amdgcn_readfirstlane(tid >> 6), n = lane & 15, kg = lane >> 4;
    LAS unsigned short* Hl = (LAS unsigned short*)(L + w * (16 * RWH_LD * 2));
    const unsigned short* W1T = WSH(O_LW1T) + (size_t)l * 160 * 512; const unsigned short* G2T = WSH(O_LG2T) + (size_t)l * 512 * 128; const unsigned short* V2T = WSH(O_LV2T) + (size_t)l * 512 * 32;
#pragma unroll 1
    for (int wt = bl * 8 + w; wt < T / 16; wt += nb * 8) {
        const int m0 = wt * 16;
        bf16x8_t za[16];
#pragma unroll
        for (int ks = 0; ks < 16; ++ks) za[ks] = *(const bf16x8_t*)(WSH(O_U) + (size_t)(m0 + n) * DIN + U_RW + 3 * G + ks * 32 + 8 * kg);
#pragma unroll 1
        for (int nt = (l == 0 ? 2 : 0); nt < 10; ++nt) { f32x4_t acc = {0.f, 0.f, 0.f, 0.f};
#pragma unroll
            for (int ks = 0; ks < 16; ++ks) acc = __builtin_amdgcn_mfma_f32_16x16x32_bf16(za[ks], *(const bf16x8_t*)(W1T + (size_t)(16 * nt + n) * 512 + ks * 32 + 8 * kg), acc, 0, 0, 0);
            if (nt >= 2) {
#pragma unroll
                for (int q = 0; q < 4; ++q) acc[q] = 1.0f / (1.0f + __expf(-acc[q])); }
            rw_hidden_store(Hl, 16 * nt + n, kg, acc); }
        asm volatile("s_waitcnt lgkmcnt(0)" ::: "memory");
        bf16x8_t hg[4], hv;
#pragma unroll
        for (int ks = 0; ks < 4; ++ks) hg[ks] = *(LAS bf16x8_t*)(Hl + n * RWH_LD + 32 + ks * 32 + 8 * kg);
        hv = *(LAS bf16x8_t*)(Hl + n * RWH_LD + 8 * kg);
#pragma unroll 1
        for (int ct = 0; ct < 32; ++ct) { f32x4_t ag = {0.f, 0.f, 0.f, 0.f}, av = ag; const int cr = 16 * ct + n;
#pragma unroll
            for (int ks = 0; ks < 4; ++ks) ag = __builtin_amdgcn_mfma_f32_16x16x32_bf16(*(const bf16x8_t*)(G2T + (size_t)cr * 128 + ks * 32 + 8 * kg), hg[ks], ag, 0, 0, 0);
            if (l > 0) av = __builtin_amdgcn_mfma_f32_16x16x32_bf16(*(const bf16x8_t*)(V2T + (size_t)cr * 32 + 8 * kg), hv, av, 0, 0, 0);
            const int m = m0 + n, c = 16 * ct + 4 * kg; const size_t o = (size_t)m * G + c;
            const u32x2_t vraw = *(const u32x2_t*)(WSH(O_U) + (size_t)m * DIN + U_RW + 2 * G + c);
            f32x4_t v = {bf2f((unsigned short)(vraw.x & 0xffffu)), bf2f((unsigned short)(vraw.x >> 16)), bf2f((unsigned short)(vraw.y & 0xffffu)), bf2f((unsigned short)(vraw.y >> 16))};
            if (l == 0) *(f32x4_t*)(WSF(O_VFIRST) + o) = v;
            else { const f32x4_t vf = *(const f32x4_t*)(WSF(O_VFIRST) + o), v0 = *(const f32x4_t*)(p.in[I_rw_v0] + (l - 1) * G + c);
#pragma unroll
                for (int q = 0; q < 4; ++q) v[q] = v[q] + (vf[q] - v[q]) * fsigm(v0[q] + av[q]); }
            *(f32x4_t*)(WSF(O_RWV) + o) = v; *(f32x4_t*)(WSF(O_RWG) + o) = ag; }
        asm volatile("s_waitcnt lgkmcnt(0)" ::: "memory");
    }
}
__device__ __forceinline__ void rw_prep2a(PREF p, int l, int b0, int nb) {
    int tid = hw_tid(), bl = blockIdx.x; asm volatile("" : "+v"(tid), "+s"(bl)); const int lane = tid & 63, w = __builtin_amdgcn_readfirstlane(tid >> 6), n = lane & 15, kg = lane >> 4;
    bl -= b0; if (bl < 0 || bl >= nb) return;
#pragma unroll 1
    for (int un = bl * 8 + w; un < 4 * (T / 16); un += nb * 8) {
        const int nh = un & 1, wt = un >> 1, d = wt / (T / 16), m0 = (wt % (T / 16)) * 16, ld = l * 2 + d;
        const unsigned short* WA1T = WSH(O_LWA1T) + (size_t)ld * 2 * 128 * 512 + (size_t)nh * 64 * 512;
        f32x4_t hacc[4];
#pragma unroll
        for (int nt = 0; nt < 4; ++nt) hacc[nt] = (f32x4_t){0.f, 0.f, 0.f, 0.f};
#pragma unroll 1
        for (int half = 0; half < 2; ++half) {
            const int m = m0 + n, src = half == 0 ? m : tok_prev(m, d, 1); const int srow = src >= 0 ? src : m;
            bf16x8_t za[16];
#pragma unroll
            for (int ks = 0; ks < 16; ++ks) { za[ks] = *(const bf16x8_t*)(WSH(O_U) + (size_t)srow * DIN + U_RW + 3 * G + ks * 32 + 8 * kg); if (src < 0) za[ks] = (bf16x8_t){0, 0, 0, 0, 0, 0, 0, 0}; }
            const unsigned short* Wh = WA1T + (size_t)half * 128 * 512;
#pragma unroll
            for (int nt = 0; nt < 4; ++nt)
#pragma unroll
                for (int ks = 0; ks < 16; ++ks) hacc[nt] = __builtin_amdgcn_mfma_f32_16x16x32_bf16(*(const bf16x8_t*)(Wh + (size_t)(16 * nt + n) * 512 + ks * 32 + 8 * kg), za[ks], hacc[nt], 0, 0, 0);
        }
        unsigned short* hrow = WSH(O_H2) + ((size_t)d * T + m0 + n) * 128 + 64 * nh + 4 * kg;
#pragma unroll
        for (int nt = 0; nt < 4; ++nt) { f32x4_t acc = hacc[nt];
            if (nh == 0) {
#pragma unroll
                for (int q = 0; q < 4; ++q) acc[q] = tanhf(acc[q]); }
            u32x2_t o; o.x = pk_bf16(acc[0], acc[1]); o.y = pk_bf16(acc[2], acc[3]); *(u32x2_t*)(hrow + 16 * nt) = o; }
    }
}
__device__ __forceinline__ void rw_prep2b(PREF p, int l) {
    int tid = hw_tid(), bl = blockIdx.x; asm volatile("" : "+v"(tid), "+s"(bl)); const int lane = tid & 63, w = __builtin_amdgcn_readfirstlane(tid >> 6), n = lane & 15, kg = lane >> 4;
#pragma unroll 1
    for (int un = bl * 8 + w; un < 2 * (T / 16) * 8; un += (int)gridDim.x * 8) {
        const int hh = un & 7, wt = un >> 3, d = wt / (T / 16), m0 = (wt % (T / 16)) * 16, ld = l * 2 + d;
        const unsigned short* W2T = WSH(O_LW2T) + (size_t)ld * 512 * 64; const unsigned short* A2T = WSH(O_LA2T) + (size_t)ld * 512 * 64; const float* mu = p.in[I_rw_mu] + (size_t)ld * 4 * G;
        const int m = m0 + n, pm = tok_prev(m, d, 1); const unsigned short* ur = WSH(O_U) + (size_t)m * DIN + U_RW; const unsigned short* up = WSH(O_U) + (size_t)(pm >= 0 ? pm : m) * DIN + U_RW;
        const float pz = pm >= 0 ? 1.0f : 0.0f;
        const unsigned short* hrow = WSH(O_H2) + ((size_t)d * T + m) * 128 + 8 * kg;
        bf16x8_t hw[2], ha[2];
#pragma unroll
        for (int ks = 0; ks < 2; ++ks) { hw[ks] = *(const bf16x8_t*)(hrow + ks * 32); ha[ks] = *(const bf16x8_t*)(hrow + 64 + ks * 32); }
        f32x4_t aw[4], aa[4], ksv[4]; float ss = 0.f;
#pragma unroll
        for (int j = 0; j < 4; ++j) { const int cr = 64 * hh + 16 * j + n, c = 64 * hh + 16 * j + 4 * kg; aw[j] = (f32x4_t){0.f, 0.f, 0.f, 0.f}; aa[j] = aw[j];
#pragma unroll
            for (int ks = 0; ks < 2; ++ks) { aw[j] = __builtin_amdgcn_mfma_f32_16x16x32_bf16(*(const bf16x8_t*)(W2T + (size_t)cr * 64 + ks * 32 + 8 * kg), hw[ks], aw[j], 0, 0, 0);
                aa[j] = __builtin_amdgcn_mfma_f32_16x16x32_bf16(*(const bf16x8_t*)(A2T + (size_t)cr * 64 + ks * 32 + 8 * kg), ha[ks], aa[j], 0, 0, 0); }
            const u32x2_t k0r = *(const u32x2_t*)(ur + G + c), kpr = *(const u32x2_t*)(up + G + c); const f32x4_t muk = *(const f32x4_t*)(mu + G + c), kkc = *(const f32x4_t*)(p.in[I_rw_k_k] + l * G + c);
            const f32x4_t k0 = {bf2f((unsigned short)(k0r.x & 0xffffu)), bf2f((unsigned short)(k0r.x >> 16)), bf2f((unsigned short)(k0r.y & 0xffffu)), bf2f((unsigned short)(k0r.y >> 16))};
            const f32x4_t kp = {bf2f((unsigned short)(kpr.x & 0xffffu)) * pz, bf2f((unsigned short)(kpr.x >> 16)) * pz, bf2f((unsigned short)(kpr.y & 0xffffu)) * pz, bf2f((unsigned short)(kpr.y >> 16)) * pz};
            ksv[j] = k0 + (kp - k0) * muk; const f32x4_t kr = ksv[j] * kkc; ss += (kr[0] * kr[0] + kr[1] * kr[1]) + (kr[2] * kr[2] + kr[3] * kr[3]); }
        ss += lane_xor(ss, 16, lane); ss += lane_xor(ss, 32, lane);
        const float inv = 1.0f / fmaxf(sqrtf(ss), 1e-12f);
#pragma unroll
        for (int j = 0; j < 4; ++j) { const int c = 64 * hh + 16 * j + 4 * kg; const size_t o = ((size_t)d * T + m) * G + c;
            const f32x4_t w0c = *(const f32x4_t*)(p.in[I_rw_w0] + ld * G + c), a0c = *(const f32x4_t*)(p.in[I_rw_a0] + ld * G + c), kac = *(const f32x4_t*)(p.in[I_rw_k_a] + l * G + c), kkc = *(const f32x4_t*)(p.in[I_rw_k_k] + l * G + c);
            const f32x4_t mur = *(const f32x4_t*)(mu + c), muv = *(const f32x4_t*)(mu + 2 * G + c);
            const u32x2_t r0r = *(const u32x2_t*)(ur + c), rpr = *(const u32x2_t*)(up + c);
            const f32x4_t r0 = {bf2f((unsigned short)(r0r.x & 0xffffu)), bf2f((unsigned short)(r0r.x >> 16)), bf2f((unsigned short)(r0r.y & 0xffffu)), bf2f((unsigned short)(r0r.y >> 16))};
            const f32x4_t rp = {bf2f((unsigned short)(rpr.x & 0xffffu)) * pz, bf2f((unsigned short)(rpr.x >> 16)) * pz, bf2f((unsigned short)(rpr.y & 0xffffu)) * pz, bf2f((unsigned short)(rpr.y >> 16)) * pz};
            const f32x4_t v0 = *(const f32x4_t*)(WSF(O_RWV) + (size_t)m * G + c), vp = *(const f32x4_t*)(WSF(O_RWV) + (size_t)(pm >= 0 ? pm : m) * G + c) * pz;
            f32x4_t av, dec;
#pragma unroll
            for (int q = 0; q < 4; ++q) { av[q] = fsigm(a0c[q] + aa[j][q]); dec[q] = __expf(-0.6065306597126334f * fsigm(w0c[q] + aw[j][q])); }
            const f32x4_t kk = ksv[j] * kkc * inv;
            *(f32x4_t*)(WSF(O_SR) + o) = r0 + (rp - r0) * mur; *(f32x4_t*)(WSF(O_SW) + o) = dec; *(f32x4_t*)(WSF(O_SV) + o) = v0 + (vp - v0) * muv;
            *(f32x4_t*)(WSF(O_SK) + o) = ksv[j] * ((av - 1.0f) * kac + 1.0f); *(f32x4_t*)(WSF(O_SKK) + o) = kk; *(f32x4_t*)(WSF(O_SKKA) + o) = kk * av; }
    }
}

constexpr int RCL_LD = 72;
constexpr int RCL_AT = 0, RCL_BH = 16 * RCL_LD * 2, RCL_KH = 2 * RCL_BH, RCL_RT = 3 * RCL_BH, RCL_ATT = 4 * RCL_BH  , RCL_NT = RCL_ATT + 64 * 24 * 2  ,
              RCL_TT = RCL_NT + 16 * 20 * 4  , RCL_MTT = RCL_TT + 16 * 40 * 2  , RCL_END = RCL_MTT + 16 * 24 * 2;
static_assert(RCL_END <= 16384, "rwkv chunk unit LDS per wave");
__device__ __forceinline__ void rwc_tasks(PREF p, LAS unsigned char* L) {
    int tid = hw_tid(), bl = blockIdx.x; asm volatile("" : "+v"(tid), "+s"(bl)); const int lane = tid & 63, w = __builtin_amdgcn_readfirstlane(tid >> 6), n = lane & 15, kg = lane >> 4;
    LAS unsigned char* Lw = L + w * 16384;
    LAS unsigned short* ATl = (LAS unsigned short*)(Lw + RCL_AT); LAS unsigned short* BHl = (LAS unsigned short*)(Lw + RCL_BH); LAS unsigned short* KHl = (LAS unsigned short*)(Lw + RCL_KH); LAS unsigned short* RTl = (LAS unsigned short*)(Lw + RCL_RT);
    LAS unsigned short* ATTl = (LAS unsigned short*)(Lw + RCL_ATT); LAS float* NTl = (LAS float*)(Lw + RCL_NT); LAS unsigned short* TTl = (LAS unsigned short*)(Lw + RCL_TT); LAS unsigned short* MTTl = (LAS unsigned short*)(Lw + RCL_MTT);
    const bf16x8_t zero8 = {0, 0, 0, 0, 0, 0, 0, 0};
#pragma unroll 1
    for (int task = bl * 8 + w; task < NTASK; task += (int)gridDim.x * 8) {
        const int ck = task % NCK, chain = task / NCK; int d, b, h; rw_chain_decode(chain, d, b, h);
        {   const int c = lane; float gam = 1.0f; float khv[16], bhv[16];
#pragma unroll
            for (int t = 0; t < RWC; ++t) { const size_t base = ((size_t)d * T + scan_tok(d, b, ck * RWC + t)) * G + h * 64 + c;
                const float at = WSF(O_SKK)[base] * gam; gam *= WSF(O_SW)[base]; const float inv = 1.0f / gam;
                bhv[t] = WSF(O_SKKA)[base] * inv; khv[t] = WSF(O_SK)[base] * inv; const float rt = WSF(O_SR)[base] * gam;
                ATl[t * RCL_LD + c] = f2bf(at); BHl[t * RCL_LD + c] = f2bf(bhv[t]); KHl[t * RCL_LD + c] = f2bf(khv[t]); RTl[t * RCL_LD + c] = f2bf(rt); ATTl[c * 24 + t] = f2bf(at);
                WSH(O_ORT)[(size_t)task * 1024 + t * 64 + c] = f2bf(rt);
                WSH(O_OVT)[(size_t)task * 1024 + c * 16 + t] = f2bf(WSF(O_SV)[base]); }
            WSF(O_CAGC)[(size_t)task * 64 + c] = gam;
            u32x4_t* dst = (u32x4_t*)(WSH(O_OKB) + (size_t)task * 2048 + c * 32);
#pragma unroll
            for (int i = 0; i < 2; ++i) { u32x4_t v, u;
#pragma unroll
                for (int j = 0; j < 4; ++j) { v[j] = pk_bf16(khv[8 * i + 2 * j] * gam, khv[8 * i + 2 * j + 1] * gam); u[j] = pk_bf16(-bhv[8 * i + 2 * j] * gam, -bhv[8 * i + 2 * j + 1] * gam); }
                dst[i] = v; dst[2 + i] = u; }
        }
        asm volatile("s_waitcnt lgkmcnt(0)" ::: "memory");
        f32x4_t nt = {0.f, 0.f, 0.f, 0.f}, mt = nt, qk = nt, qb = nt;
#pragma unroll
        for (int ks = 0; ks < 2; ++ks) { const bf16x8_t fa = *(LAS bf16x8_t*)(ATl + n * RCL_LD + ks * 32 + 8 * kg), fr = *(LAS bf16x8_t*)(RTl + n * RCL_LD + ks * 32 + 8 * kg);
            const bf16x8_t fb = *(LAS bf16x8_t*)(BHl + n * RCL_LD + ks * 32 + 8 * kg), fk = *(LAS bf16x8_t*)(KHl + n * RCL_LD + ks * 32 + 8 * kg);
            nt = __builtin_amdgcn_mfma_f32_16x16x32_bf16(fa, fb, nt, 0, 0, 0); mt = __builtin_amdgcn_mfma_f32_16x16x32_bf16(fa, fk, mt, 0, 0, 0);
            qk = __builtin_amdgcn_mfma_f32_16x16x32_bf16(fr, fk, qk, 0, 0, 0); qb = __builtin_amdgcn_mfma_f32_16x16x32_bf16(fr, fb, qb, 0, 0, 0); }
#pragma unroll
        for (int q = 0; q < 4; ++q) { const int t = 4 * kg + q; if (t <= n) { nt[q] = 0.f; mt[q] = 0.f; } if (t < n) { qk[q] = 0.f; qb[q] = 0.f; }
            NTl[t * 20 + n] = nt[q];
            WSH(O_OQKB)[(size_t)task * 512 + t * 32 + n] = f2bf(qk[q]); WSH(O_OQKB)[(size_t)task * 512 + t * 32 + 16 + n] = f2bf(-qb[q]); }
        { u32x2_t mv; mv.x = pk_bf16(mt[0], mt[1]); mv.y = pk_bf16(mt[2], mt[3]); *(LAS u32x2_t*)(MTTl + n * 24 + 4 * kg) = mv; }
        asm volatile("s_waitcnt lgkmcnt(0)" ::: "memory");
        {   float x[16];
#pragma unroll
            for (int t = 0; t < 16; ++t) { float sacc = (t == n) ? 1.0f : 0.0f;
#pragma unroll
                for (int j4 = 0; j4 < 4; ++j4) { if (4 * j4 < t) { const f32x4_t r4 = *(LAS f32x4_t*)(NTl + t * 20 + 4 * j4);
#pragma unroll
                        for (int jj = 0; jj < 4; ++jj) if (4 * j4 + jj < t) sacc -= r4[jj] * x[4 * j4 + jj]; } }
                x[t] = sacc; }
            if (kg == 0) {
#pragma unroll
                for (int t = 0; t < 16; ++t) { TTl[t * 40 + n] = f2bf(x[t]); TTl[t * 40 + 16 + n] = 0; } }
        }
        asm volatile("s_waitcnt lgkmcnt(0)" ::: "memory");
        {   const bf16x8_t ta = *(LAS bf16x8_t*)(TTl + n * 40 + 8 * kg);
#pragma unroll
            for (int ct = 0; ct < 4; ++ct) { const bf16x8_t bt = kg < 2 ? *(LAS bf16x8_t*)(ATTl + (16 * ct + n) * 24 + 8 * (kg & 1)) : zero8;
                f32x4_t w1 = {0.f, 0.f, 0.f, 0.f}; w1 = __builtin_amdgcn_mfma_f32_16x16x32_bf16(ta, bt, w1, 0, 0, 0);
#pragma unroll
                for (int q = 0; q < 4; ++q) WSH(O_OW1)[(size_t)task * 1024 + (4 * kg + q) * 64 + 16 * ct + n] = f2bf(w1[q]); }
            const bf16x8_t bm = kg < 2 ? *(LAS bf16x8_t*)(MTTl + n * 24 + 8 * (kg & 1)) : zero8;
            f32x4_t tm = {0.f, 0.f, 0.f, 0.f}; tm = __builtin_amdgcn_mfma_f32_16x16x32_bf16(ta, bm, tm, 0, 0, 0);
#pragma unroll
            for (int q = 0; q < 4; ++q) { WSH(O_OTM)[(size_t)task * 512 + (4 * kg + q) * 32 + n] = f2bf(tm[q]); WSH(O_OTM)[(size_t)task * 512 + (4 * kg + q) * 32 + 16 + n] = 0; }
        }
        asm volatile("s_waitcnt lgkmcnt(0)" ::: "memory");
    }
}
__device__ __forceinline__ void rw_out_rows(PREF p, int l) {
    int tid = hw_tid(), bl = blockIdx.x; asm volatile("" : "+v"(tid), "+s"(bl)); const int lane = tid & 63, w = __builtin_amdgcn_readfirstlane(tid >> 6);
    const int nrows = (l == DEPTH - 1 ? TL : T) * 8;
#pragma unroll 1
    for (int rh = bl * 8 + w; rh < nrows; rh += (int)gridDim.x * 8) {
        const int m = rh >> 3, h = rh & 7, c = h * 64 + lane; float tot = 0.f;
#pragma unroll
        for (int d = 0; d < 2; ++d) { const size_t o = ((size_t)d * T + m) * G + c;
            const float y = WSF(O_SY)[o], r = WSF(O_SR)[o], k = WSF(O_SK)[o], v = WSF(O_SV)[o];
            float s1 = y, s2 = y * y, s3 = r * k * p.in[I_rw_r_k][l * G + c];
#pragma unroll
            for (int off = 1; off < 64; off <<= 1) { s1 += lane_xor(s1, off, lane); s2 += lane_xor(s2, off, lane); s3 += lane_xor(s3, off, lane); }
            const float mean = s1 * (1.0f / 64.0f), dy = y - mean, var = fmaxf(s2 * (1.0f / 64.0f) - mean * mean, 0.0f), bon = s3;
            tot += dy / sqrtf(var + 64e-5f) * p.in[I_rw_ln_w][l * G + c] + p.in[I_rw_ln_b][l * G + c] + bon * v; }
        WSH(O_CAT)[(size_t)m * D + 2 * G + c] = f2bf(tot * WSF(O_RWG)[(size_t)m * G + c]);
    }
}

struct RwOps { bf16x8_t w1a, w1b, rta, rtb, tm, qkb, kb0, kb1, kb2, kb3, vt; f32x4_t gc0, gc1, gc2, gc3; };
__device__ __forceinline__ void rw_load_ops(PREF p, RwOps& o, size_t task, int q, int n, int kg) {
    const unsigned short* w1 = WSH(O_OW1) + task * 1024 + n * 64 + 8 * kg; const unsigned short* rt = WSH(O_ORT) + task * 1024 + n * 64 + 8 * kg;
    o.w1a = *(const bf16x8_t*)w1; o.w1b = *(const bf16x8_t*)(w1 + 32); o.rta = *(const bf16x8_t*)rt; o.rtb = *(const bf16x8_t*)(rt + 32);
    o.tm = *(const bf16x8_t*)(WSH(O_OTM) + task * 512 + n * 32 + 8 * kg); o.qkb = *(const bf16x8_t*)(WSH(O_OQKB) + task * 512 + n * 32 + 8 * kg);
    const unsigned short* kb = WSH(O_OKB) + task * 2048 + n * 32 + 8 * kg;
    o.kb0 = *(const bf16x8_t*)kb; o.kb1 = *(const bf16x8_t*)(kb + 512); o.kb2 = *(const bf16x8_t*)(kb + 1024); o.kb3 = *(const bf16x8_t*)(kb + 1536);
    o.vt = *(const bf16x8_t*)(WSH(O_OVT) + task * 1024 + (16 * q + n) * 16 + 8 * (kg & 1));
    const float* gc = WSF(O_CAGC) + task * 64 + 4 * kg;
    o.gc0 = *(const f32x4_t*)gc; o.gc1 = *(const f32x4_t*)(gc + 16); o.gc2 = *(const f32x4_t*)(gc + 32); o.gc3 = *(const f32x4_t*)(gc + 48);
}
__device__ __forceinline__ void rw_chain_unit(PREF p, int chain, LAS unsigned char* L) {
    int tid = hw_tid(); asm volatile("" : "+v"(tid)); const int lane = tid & 63, q = __builtin_amdgcn_readfirstlane(tid >> 6);
    if (q >= 4) return;
    int d, b, h; rw_chain_decode(chain, d, b, h);
    const int n = lane & 15, kg = lane >> 4;
    LAS unsigned short* Sl = (LAS unsigned short*)(L + q * 4096);
    LAS unsigned short* Ul = (LAS unsigned short*)(L + q * 4096 + 2304);
    f32x4_t s0 = {0.f, 0.f, 0.f, 0.f}, s1 = s0, s2 = s0, s3 = s0;
    const bf16x8_t zero8 = {0, 0, 0, 0, 0, 0, 0, 0};
    RwOps nx; rw_load_ops(p, nx, (size_t)chain * NCK, q, n, kg);
#pragma unroll 1
    for (int ck = 0; ck < NCK; ++ck) {
        const RwOps o = nx;
        if (ck + 1 < NCK) rw_load_ops(p, nx, (size_t)chain * NCK + ck + 1, q, n, kg);
        { u32x2_t w; w.x = pk_bf16(s0[0], s0[1]); w.y = pk_bf16(s0[2], s0[3]); *(LAS u32x2_t*)(Sl + n * 72 + 4 * kg) = w;
          w.x = pk_bf16(s1[0], s1[1]); w.y = pk_bf16(s1[2], s1[3]); *(LAS u32x2_t*)(Sl + n * 72 + 16 + 4 * kg) = w;
          w.x = pk_bf16(s2[0], s2[1]); w.y = pk_bf16(s2[2], s2[3]); *(LAS u32x2_t*)(Sl + n * 72 + 32 + 4 * kg) = w;
          w.x = pk_bf16(s3[0], s3[1]); w.y = pk_bf16(s3[2], s3[3]); *(LAS u32x2_t*)(Sl + n * 72 + 48 + 4 * kg) = w; }
        asm volatile("s_waitcnt lgkmcnt(0)" ::: "memory");
        const bf16x8_t bs0 = *(LAS bf16x8_t*)(Sl + n * 72 + 8 * kg), bs1 = *(LAS bf16x8_t*)(Sl + n * 72 + 32 + 8 * kg);
        const bf16x8_t bvlo = kg < 2 ? o.vt : zero8;
        f32x4_t ut = {0.f, 0.f, 0.f, 0.f};
        ut = __builtin_amdgcn_mfma_f32_16x16x32_bf16(o.w1a, bs0, ut, 0, 0, 0);
        ut = __builtin_amdgcn_mfma_f32_16x16x32_bf16(o.w1b, bs1, ut, 0, 0, 0);
        ut = __builtin_amdgcn_mfma_f32_16x16x32_bf16(o.tm, bvlo, ut, 0, 0, 0);
        { u32x2_t w; w.x = pk_bf16(ut[0], ut[1]); w.y = pk_bf16(ut[2], ut[3]); *(LAS u32x2_t*)(Ul + n * 24 + 4 * kg) = w; }
        asm volatile("s_waitcnt lgkmcnt(0)" ::: "memory");
        const bf16x8_t uf = *(LAS bf16x8_t*)(Ul + n * 24 + 8 * (kg & 1));
        const bf16x8_t bv = kg < 2 ? o.vt : uf;
        f32x4_t yt = {0.f, 0.f, 0.f, 0.f};
        yt = __builtin_amdgcn_mfma_f32_16x16x32_bf16(o.rta, bs0, yt, 0, 0, 0);
        yt = __builtin_amdgcn_mfma_f32_16x16x32_bf16(o.rtb, bs1, yt, 0, 0, 0);
        yt = __builtin_amdgcn_mfma_f32_16x16x32_bf16(o.qkb, bv, yt, 0, 0, 0);
#pragma unroll
        for (int qq = 0; qq < 4; ++qq) WSF(O_SY)[((size_t)d * T + scan_tok(d, b, ck * RWC + 4 * kg + qq)) * G + h * 64 + 16 * q + n] = yt[qq];
        s0 = s0 * o.gc0; s1 = s1 * o.gc1; s2 = s2 * o.gc2; s3 = s3 * o.gc3;
        s0 = __builtin_amdgcn_mfma_f32_16x16x32_bf16(o.kb0, bv, s0, 0, 0, 0);
        s1 = __builtin_amdgcn_mfma_f32_16x16x32_bf16(o.kb1, bv, s1, 0, 0, 0);
        s2 = __builtin_amdgcn_mfma_f32_16x16x32_bf16(o.kb2, bv, s2, 0, 0, 0);
        s3 = __builtin_amdgcn_mfma_f32_16x16x32_bf16(o.kb3, bv, s3, 0, 0, 0);
        asm volatile("s_waitcnt lgkmcnt(0)" ::: "memory");
    }
}
__device__ __forceinline__ void rw_chain_units(PREF p, LAS unsigned char* L) { int bl = blockIdx.x; asm volatile("" : "+s"(bl)); for (int ch = bl; ch < NCHAIN; ch += gridDim.x) rw_chain_unit(p, ch, L); }

constexpr int LDS_STAGE = 147456, LDS_MISC = LDS_STAGE, LDS_BYTES = LDS_STAGE + 512;
static_assert(LDS_WTAB == LDS_MISC + 64, "wave table address");
static_assert(HYL_END <= LDS_STAGE, "hyena LDS map");
typedef void (*stage_fn)(PREF, int, long);
template <stage_fn F> __device__ __forceinline__ void run_stage(PREF p, int l, long n, int b0 = 0, int nb = 0) {
    int tl = hw_tid(), bl = blockIdx.x; asm volatile("" : "+v"(tl), "+s"(bl));
    if (nb == 0) nb = (int)gridDim.x; bl -= b0; if (bl < 0 || bl >= nb) return;
    for (long g = (long)bl * NTHREADS + tl; g < n; g += (long)nb * NTHREADS) F(p, l, g);
}
constexpr int PRO_PH = 7, LAYER_PH = 35, FIN_PH = 2, NPHASES = PRO_PH + DEPTH * LAYER_PH + FIN_PH;

__global__ void __launch_bounds__(NTHREADS, 2) fwd_kernel(P p_arg) {
    const __attribute__((address_space(4))) P* kp = (const __attribute__((address_space(4))) P*)__builtin_amdgcn_kernarg_segment_ptr();
    extern __shared__ __attribute__((aligned(16))) unsigned char lds[];
    LAS unsigned char* L = (LAS unsigned char*)lds;
    volatile LAS unsigned* misc = (volatile LAS unsigned*)(L + LDS_MISC);
    if (threadIdx.x < 16) misc[threadIdx.x] = 0u;
    if ((threadIdx.x & 63) == 0) ((volatile LAS int*)(unsigned)LDS_WTAB)[(unsigned)__builtin_amdgcn_s_getreg((5 << 11) | 4) & 63u] = (int)(threadIdx.x >> 6);
    __syncthreads();
    (void)xcd_barrier_post((unsigned*)(kp->ws + O_CTL) + CW_BAR, misc);
    int ph = 0;
#define PHASE_BEGIN if (ph >= kp->lo && ph < kp->hi) { asm volatile("" : "+s"(kp)); PREF p = *kp;
#define PHASE_END if (ph + 1 < kp->hi) { XcdBarrier bar_; bar_.bar = (unsigned*)(kp->ws + O_CTL) + CW_BAR; bar_.x = xb_xcc_id(); bar_.st = (volatile LAS unsigned*)(L + LDS_MISC); xcd_barrier(bar_); } } ++ph;
#define STAGE(fn, l, n) run_stage<fn>(p, l, n)
#define STAGE_SUB(fn, l, n, b0, nb) run_stage<fn>(p, l, n, b0, nb)
    PHASE_BEGIN STAGE(st_copy_x, 0, N_copy_x); STAGE(st_ada_part, 0, N_ada_part); hy_mlp_rows(p); STAGE(st_w4t, 0, N_w4t); STAGE(st_lora_cvt, 0, N_lora_cvt); cvt_all(p, L, 0, CVT_NIT, 0, (int)gridDim.x); PHASE_END
    PHASE_BEGIN STAGE(st_ada_red, 0, N_ada_red); hy_raw_units(p); PHASE_END
    PHASE_BEGIN STAGE(st_hy_nrm1, 0, N_hy_nrm1); PHASE_END
    PHASE_BEGIN STAGE(st_hy_nrm, 0, N_hy_nrm); PHASE_END
    PHASE_BEGIN STAGE(st_hy_scale, 0, 2048L * SEQ); STAGE(st_hy_trb, 0, N_hy_trb); PHASE_END
    for (int l = 0; l < DEPTH; ++l) {
#pragma unroll 1
        for (int seg = 0; seg < 4; ++seg) {
            if (seg == 0) {
                PHASE_BEGIN if (l == 0) STAGE(st_moe_fold, 0, N_moe_fold); norm1_rows(p, l); PHASE_END
            } else if (seg == 1) {
                const int GB = (int)gridDim.x, RB = GB > 128 ? 64 : 0;
                PHASE_BEGIN rg_units(p, l, L); STAGE_SUB(st_hy_shortT, l, N_hy_shortT, RB, GB - RB); if (l == 0) STAGE_SUB(st_hy_short_ctx, l, N_hy_short_ctx, RB, GB - RB); rw_prep1(p, l, L, RB, GB - RB); rw_prep2a(p, l, RB, GB - RB); rt_units_a(p, l, L, RB, GB - RB); PHASE_END
                PHASE_BEGIN if (l == 0) STAGE(st_hy_conv0_ctx, l, N_hy_conv_c); rw_prep2b(p, l); STAGE(st_rt_state, l, N_rt_state); PHASE_END
                PHASE_BEGIN if (l == 0) STAGE(st_hy_conv1_ctx, l, N_hy_conv_c); STAGE(st_rg_out, l, N_mc); rt_units_c(p, l, L); rwc_tasks(p, L); PHASE_END
                PHASE_BEGIN rw_chain_units(p, L); hy_units(p, l, L, RB, GB - RB); PHASE_END
                PHASE_BEGIN rw_out_rows(p, l); PHASE_END
            } else if (seg == 2) {
                PHASE_BEGIN norm2_tiles(p, l, L); norm2_rows(p, l); STAGE(st_slot_init, l, MAXSLOT); PHASE_END
                PHASE_BEGIN STAGE(st_moe_slots, l, N_moe_slots); PHASE_END
            }
            PHASE_BEGIN {
                pg8::Gemm g; pg8::OrderAll S; pg8::EpiAll E; S.tile_e = WSI(O_TILEE); S.G = (int)gridDim.x; { int bl = blockIdx.x; asm volatile("" : "+s"(bl)); S.c = bl; } S.ntiles = 0; S.moe = seg >= 2; E.mode = seg; E.perm = (seg != 1); E.a2 = nullptr; E.ldc = DIN;
                if (seg == 0) { g = pg8::Gemm{WSH(O_A1), WSH(O_WIN) + (size_t)l * DIN * D, T, DIN, D, nullptr}; S.so.init(T, DIN, S.G, S.c); E.O = WSH(O_U); E.a1 = nullptr; }
                else if (seg == 1) { const int M = l == DEPTH - 1 ? TL : T; g = pg8::Gemm{WSH(O_CAT), WSH(O_WOUT) + (size_t)l * D * D, M, D, D, nullptr}; S.so.init(M, D, S.G, S.c); E.O = WSF(O_X); E.a1 = modp(p, l, 0, 2); }
                else if (seg == 2) { g = pg8::Gemm{WSH(O_A1), WSH(O_WGU) + (size_t)l * NE * 2048 * D, MAXSLOT, NE * 2048, D, WSI(O_SLOTTOK)}; S.so.init(256, 256, S.G, S.c); S.ntiles = WSI(O_TILEE)[MAXTILES]; E.O = WSH(O_ACT); E.a1 = p.in[I_moe_b_gu] + (size_t)l * NE * 2048; }
                else { g = pg8::Gemm{WSH(O_ACT), WSH(O_WDN) + (size_t)l * NE * D * FE, MAXSLOT, NE * D, FE, nullptr}; S.so.init(256, 256, S.G, S.c); S.ntiles = WSI(O_TILEE)[MAXTILES]; E.O = WSH(O_OSLOT); E.a1 = p.in[I_moe_b_dn] + (size_t)l * NE * D; E.a2 = WSF(O_SLOTP); }
                pg8::gemm_phase<pg8::EpiAll, pg8::OrderAll, false>(L, g, S, E, nullptr);
            } PHASE_END
        }
    }
    PHASE_BEGIN norm1_rows(p, DEPTH); PHASE_END
#undef PHASE_BEGIN
#undef PHASE_END
#undef STAGE
}

#ifndef MK_ONE_LAUNCH
#define MK_ONE_LAUNCH 1
#endif
extern "C" void kernel_launch(void* const* d_in, const int* in_sizes, int n_in, void* d_out, int out_size, void* d_ws, size_t ws_size, hipStream_t stream) {
    static int grid = 0;
    if (grid == 0) {
        if (n_in != N_IN || out_size != TL * D || ws_size < WS_END) { fprintf(stderr, "kernel_launch: unexpected shapes (n_in %d, out %d, ws %zu < %zu)\n", n_in, out_size, ws_size, (size_t)WS_END); grid = -1; return; }
        int dev = 0, cus = 0, per_cu = 0;
        if (hipGetDevice(&dev) != hipSuccess || hipDeviceGetAttribute(&cus, hipDeviceAttributeMultiprocessorCount, dev) != hipSuccess) { grid = -1; return; }
        if (hipFuncSetAttribute((const void*)fwd_kernel, hipFuncAttributeMaxDynamicSharedMemorySize, LDS_BYTES) != hipSuccess) { fprintf(stderr, "kernel_launch: hipFuncSetAttribute failed\n"); grid = -1; return; }
        if (hipOccupancyMaxActiveBlocksPerMultiprocessor(&per_cu, (const void*)fwd_kernel, NTHREADS, LDS_BYTES) != hipSuccess || per_cu < 1) fprintf(stderr, "kernel_launch: occupancy query says %d\n", per_cu);
        (void)hipGetLastError();
        grid = cus;
    }
    if (grid < 0) return;
    (void)hipMemsetAsync((char*)d_ws + O_CTL, 0, CTL_BYTES, stream);
    P p{};
    for (int i = 0; i < N_IN; ++i) p.in[i] = (const float*)d_in[i];
    p.out = (float*)d_out; p.ws = (unsigned char*)d_ws;
#if MK_ONE_LAUNCH
#ifdef PROBE_K
    p.lo = 0; p.hi = PROBE_K;
    hipLaunchKernelGGL(fwd_kernel, dim3(grid), dim3(NTHREADS), LDS_BYTES, stream, p);
    (void)hipMemsetAsync((char*)d_ws + O_CTL, 0, CTL_BYTES, stream);
#endif
    p.lo = 0; p.hi = NPHASES;
    hipLaunchKernelGGL(fwd_kernel, dim3(grid), dim3(NTHREADS), LDS_BYTES, stream, p);
#else
    for (int k = 0; k < NPHASES; ++k) { p.lo = k; p.hi = k + 1; hipLaunchKernelGGL(fwd_kernel, dim3(grid), dim3(NTHREADS), LDS_BYTES, stream, p); }
#endif
    const hipError_t le = hipPeekAtLastError();
    if (le != hipSuccess) fprintf(stderr, "kernel_launch: launch failed: %s\n", hipGetErrorName(le));
}
#endif
```
